# Optimizing an MI355X kernel written in HIP

```python
import math
import jax
import jax.numpy as jnp
from jax import lax
import numpy as np

D_MODEL = 1024
BATCH = 16
SEQ = 2048
DEPTH = 1

GRID_W = 64
CTX_LEN = 256
NORM_EPS = 1e-6

S5_WIDTH = 512
S5_GROUP = 16
S5_GROUPS = S5_WIDTH // S5_GROUP
S5_STATE = 64
DN_HEADS = 8
DN_HEAD_DIM = 128
DN_WIDTH = DN_HEADS * DN_HEAD_DIM
DN_CONV = 5
DN_CHUNK = 64
PEER_HEADS = 8
PEER_N_KEYS = 128
PEER_N_EXPERTS = PEER_N_KEYS ** 2
PEER_KEY_DIM = 128
PEER_TOPK = 16
PEER_CHUNK = 128

COL_U = 0
COL_K = COL_U + S5_WIDTH
COL_V = COL_K + DN_WIDTH
COL_AB = COL_V + DN_WIDTH
STATE_COLS = COL_AB + 4 * DN_HEADS
COL_Q = STATE_COLS
COL_Z = COL_Q + DN_WIDTH
COL_G5 = COL_Z + DN_WIDTH
COL_GD = COL_G5 + D_MODEL
IN_COLS = COL_GD + D_MODEL

kernel_name = "hybrid_s5_gdn_peer_flow_block"


def rmsnorm(x, w):
    xf = x.astype(jnp.float32)
    y = xf * lax.rsqrt(jnp.mean(xf * xf, axis=-1, keepdims=True) + NORM_EPS)
    return (y * w.astype(jnp.float32)).astype(x.dtype)


def modulate(x, gain, shift, scale):
    return rmsnorm(x, gain) * (1.0 + scale) + shift


def adaln(cvec, w_mod, b_mod, n):
    m = jax.nn.silu(cvec) @ w_mod[:, : n * D_MODEL] + b_mod[: n * D_MODEL]
    return [t[..., None, :] for t in jnp.split(m, n, axis=-1)]


def l2norm(t):
    return t * lax.rsqrt(jnp.sum(t * t, axis=-1, keepdims=True) + 1e-6)


def centred_dwconv(x, w):
    half = w.shape[0] // 2
    length = x.shape[-2]
    pad = [(0, 0)] * (x.ndim - 2) + [(half, half), (0, 0)]
    xp = jnp.pad(x, pad)
    return sum(w[j] * xp[..., j:j + length, :] for j in range(w.shape[0]))


def s5_scan(u, p, d, h0_re, h0_im):
    f32 = jnp.float32
    lam_re = p['s5_lam_re'][d].astype(f32)
    lam_im = p['s5_lam_im'][d].astype(f32)
    step = jnp.exp(p['s5_log_step'][d].astype(f32))[:, None]
    mag = jnp.exp(lam_re * step)
    ab_re, ab_im = mag * jnp.cos(lam_im * step), mag * jnp.sin(lam_im * step)
    den = lam_re * lam_re + lam_im * lam_im
    f_re = ((ab_re - 1.0) * lam_re + ab_im * lam_im) / den
    f_im = (ab_im * lam_re - (ab_re - 1.0) * lam_im) / den
    b_re = p['s5_b_re'][d].astype(f32)
    b_im = p['s5_b_im'][d].astype(f32)
    bb_re = f_re[..., None] * b_re - f_im[..., None] * b_im
    bb_im = f_re[..., None] * b_im + f_im[..., None] * b_re
    x_re = jnp.einsum('btgh,gph->btgp', u, bb_re)
    x_im = jnp.einsum('btgh,gph->btgp', u, bb_im)
    if h0_re is not None:
        x_re = x_re.at[:, 0].add(ab_re * h0_re - ab_im * h0_im)
        x_im = x_im.at[:, 0].add(ab_re * h0_im + ab_im * h0_re)
    t_len = u.shape[1]
    a_re = jnp.broadcast_to(ab_re, (1, t_len) + ab_re.shape)
    a_im = jnp.broadcast_to(ab_im, (1, t_len) + ab_im.shape)

    def combine(e1, e2):
        a1r, a1i, b1r, b1i = e1
        a2r, a2i, b2r, b2i = e2
        return (a2r * a1r - a2i * a1i, a2r * a1i + a2i * a1r,
                a2r * b1r - a2i * b1i + b2r, a2r * b1i + a2i * b1r + b2i)

    _, _, h_re, h_im = lax.associative_scan(combine, (a_re, a_im, x_re, x_im), axis=1)
    return h_re, h_im


def delta_rule_chunked(k, v, g, beta, s0, q):
    bsz, nh, t_len, dk = k.shape
    dv = v.shape[-1]
    n = t_len // DN_CHUNK

    def chunks(t):
        return t.reshape((bsz, nh, n, DN_CHUNK) + t.shape[3:])

    k, v, g, beta = chunks(k), chunks(v), chunks(g), chunks(beta)
    gc = jnp.cumsum(g, axis=-1)
    lower = np.tril(np.ones((DN_CHUNK, DN_CHUNK), dtype=bool))
    strict = np.tril(np.ones((DN_CHUNK, DN_CHUNK), dtype=bool), -1)
    diff = gc[..., :, None] - gc[..., None, :]
    decay = jnp.where(lower, jnp.exp(jnp.minimum(diff, 0.0)), 0.0)
    kb = k * beta[..., None]
    a = jnp.where(strict, jnp.einsum('bhncd,bhnsd->bhncs', kb, k) * decay, 0.0)
    eye = jnp.eye(DN_CHUNK, dtype=a.dtype)
    t_inv = lax.linalg.triangular_solve(a, jnp.broadcast_to(eye, a.shape), left_side=True,
                                        lower=True, unit_diagonal=True)
    u = jnp.einsum('bhncs,bhnsd->bhncd', t_inv, v * beta[..., None])
    w = jnp.einsum('bhncs,bhnsd->bhncd', t_inv, kb * jnp.exp(gc)[..., None])
    g_last = gc[..., -1]
    k_dec = k * jnp.exp(g_last[..., None] - gc)[..., None]
    if s0 is None:
        s0 = jnp.zeros((bsz, nh, dk, dv), jnp.float32)

    def front(t):
        return jnp.moveaxis(t, 2, 0)

    xs = [front(u), front(w), front(k_dec), front(g_last)]
    if q is not None:
        q = chunks(q)
        xs += [front(q * jnp.exp(gc)[..., None]),
               front(jnp.einsum('bhncd,bhnsd->bhncs', q, k) * decay)]

    def step(s, inp):
        u_i, w_i, kd_i, gl_i = inp[:4]
        v_new = u_i - jnp.einsum('bhcd,bhde->bhce', w_i, s)
        s_next = s * jnp.exp(gl_i)[..., None, None] + jnp.einsum('bhcd,bhce->bhde', kd_i, v_new)
        if len(inp) == 4:
            return s_next, None
        qd_i, at_i = inp[4:]
        o_i = jnp.einsum('bhcd,bhde->bhce', qd_i, s) + jnp.einsum('bhcs,bhse->bhce', at_i, v_new)
        return s_next, o_i

    s_fin, o = lax.scan(step, s0, tuple(xs))
    if q is None:
        return None, s_fin
    return jnp.moveaxis(o, 0, 2).reshape(bsz, nh, t_len, dv), s_fin


def token_mixers(h, p, init, rows, need_out):
    bsz, t_len, _ = h.shape
    f32 = jnp.float32
    w_in = p['w_in'] if need_out else p['w_in'][:, :STATE_COLS]
    proj = h @ w_in

    u = proj[..., COL_U:COL_K].astype(f32).reshape(bsz, t_len, S5_GROUPS, S5_GROUP)
    h0 = (None, None, None, None) if init is None else init['s5']
    sf_re, sf_im = s5_scan(u, p, 0, h0[0], h0[1])
    sb_re, sb_im = s5_scan(jnp.flip(u, 1), p, 1, h0[2], h0[3])
    s5_final = (sf_re[:, -1], sf_im[:, -1], sb_re[:, -1], sb_im[:, -1])

    if need_out:
        conv_in = jnp.concatenate([proj[..., COL_K:COL_AB], proj[..., COL_Q:COL_Z]], axis=-1)
        conv_w = p['dn_conv_w']
    else:
        conv_in = proj[..., COL_K:COL_AB]
        conv_w = p['dn_conv_w'][:, :2 * DN_WIDTH]
    if rows is None:
        conv_out = centred_dwconv(conv_in, conv_w)
    else:
        conv_out = centred_dwconv(conv_in.reshape(bsz, rows, GRID_W, -1), conv_w).reshape(bsz, t_len, -1)
    kvq = jax.nn.silu(conv_out).astype(f32)

    def heads(t):
        return t.reshape(bsz, t_len, DN_HEADS, DN_HEAD_DIM).transpose(0, 2, 1, 3)

    k = l2norm(heads(kvq[..., :DN_WIDTH]))
    v = heads(kvq[..., DN_WIDTH:2 * DN_WIDTH])
    q = l2norm(heads(kvq[..., 2 * DN_WIDTH:])) * (DN_HEAD_DIM ** -0.5) if need_out else None
    ab = proj[..., COL_AB:STATE_COLS].astype(f32).reshape(bsz, t_len, 4, DN_HEADS).transpose(2, 0, 3, 1)
    a_log = p['dn_a_log'].astype(f32)
    dt_bias = p['dn_dt_bias'].astype(f32)
    g_f = -jnp.exp(a_log[0])[:, None] * jax.nn.softplus(ab[0] + dt_bias[0][:, None])
    beta_f = jax.nn.sigmoid(ab[1])
    g_b = -jnp.exp(a_log[1])[:, None] * jax.nn.softplus(ab[2] + dt_bias[1][:, None])
    beta_b = jax.nn.sigmoid(ab[3])
    d0 = (None, None) if init is None else init['dn']

    def flipt(t):
        return None if t is None else jnp.flip(t, axis=2)

    o_f, dn_sf = delta_rule_chunked(k, v, g_f, beta_f, d0[0], q)
    o_b, dn_sb = delta_rule_chunked(flipt(k), flipt(v), flipt(g_b), flipt(beta_b), d0[1], flipt(q))
    states = {'s5': s5_final, 'dn': (dn_sf, dn_sb)}
    if not need_out:
        return None, states

    c_re = p['s5_c_re'].astype(f32)
    c_im = p['s5_c_im'].astype(f32)
    y_f = jnp.einsum('btgp,ghp->btgh', sf_re, c_re[0]) - jnp.einsum('btgp,ghp->btgh', sf_im, c_im[0])
    y_b = jnp.einsum('btgp,ghp->btgh', sb_re, c_re[1]) - jnp.einsum('btgp,ghp->btgh', sb_im, c_im[1])
    y5 = y_f + jnp.flip(y_b, 1) + p['s5_d'].astype(f32).reshape(S5_GROUPS, S5_GROUP) * u
    y5 = jax.nn.gelu(y5.reshape(bsz, t_len, S5_WIDTH)).astype(h.dtype)
    y5 = y5 * jax.nn.sigmoid(y5 @ p['s5_glu_w'] + p['s5_glu_b'])

    o = (o_f + jnp.flip(o_b, 2)).transpose(0, 2, 1, 3)
    z = proj[..., COL_Z:COL_G5].reshape(bsz, t_len, DN_HEADS, DN_HEAD_DIM)
    y_dn = (rmsnorm(o, p['dn_norm_w']).astype(h.dtype) * jax.nn.silu(z)).reshape(bsz, t_len, DN_WIDTH)

    gate5 = jax.nn.sigmoid(proj[..., COL_G5:COL_GD])
    gated = jax.nn.sigmoid(proj[..., COL_GD:IN_COLS])
    merged = gate5 * (y5 @ p['w_branch_s5']) + gated * (y_dn @ p['w_branch_dn'])
    return merged @ p['w_out'], states


def peer_ffn(h, p):
    bsz, t_len, d = h.shape
    n_tok = bsz * t_len
    hf = h.reshape(n_tok, d)
    q = (hf @ p['peer_w_q']).reshape(n_tok, PEER_HEADS, 2, PEER_KEY_DIM)
    s = jnp.einsum('nhjd,hjkd->nhjk', q, p['peer_sub_keys']).astype(jnp.float32)
    sv, si = lax.top_k(s, PEER_TOPK)
    cand = sv[..., 0, :, None] + sv[..., 1, None, :]
    cand_idx = si[..., 0, :, None] * PEER_N_KEYS + si[..., 1, None, :]
    top_v, top_pos = lax.top_k(cand.reshape(n_tok, PEER_HEADS, PEER_TOPK * PEER_TOPK), PEER_TOPK)
    idx = jnp.take_along_axis(cand_idx.reshape(n_tok, PEER_HEADS, PEER_TOPK * PEER_TOPK), top_pos, axis=-1)
    gate = jax.nn.softmax(top_v, axis=-1).astype(h.dtype)
    n_chunks = n_tok // PEER_CHUNK
    u_tab, v_tab = p['peer_u'], p['peer_v']

    def expert_block(args):
        hc, ic, gc = args
        act = jax.nn.gelu(jnp.einsum('cd,chkd->chk', hc, jnp.take(u_tab, ic, axis=0)))
        return jnp.einsum('chk,chkd->cd', act * gc, jnp.take(v_tab, ic, axis=0))

    out = lax.map(expert_block, (hf.reshape(n_chunks, PEER_CHUNK, d),
                                 idx.reshape(n_chunks, PEER_CHUNK, PEER_HEADS, PEER_TOPK),
                                 gate.reshape(n_chunks, PEER_CHUNK, PEER_HEADS, PEER_TOPK)))
    return out.reshape(bsz, t_len, d)


def hybrid_layer(x, ctx, c, c_ctx, p, rows, last):
    m_ctx = adaln(c_ctx, p['w_mod'], p['b_mod'], 2 if last else 6)
    hc = modulate(ctx, p['norm_pre_mix'], m_ctx[0], m_ctx[1])
    ctx_mix, ctx_states = token_mixers(hc, p, None, None, not last)
    if not last:
        ctx = ctx + m_ctx[2] * rmsnorm(ctx_mix, p['norm_post_mix'])
        hc2 = modulate(ctx, p['norm_pre_ffn'], m_ctx[3], m_ctx[4])
        ctx = ctx + m_ctx[5] * rmsnorm(peer_ffn(hc2, p), p['norm_post_ffn'])
    m = adaln(c, p['w_mod'], p['b_mod'], 6)
    hx = modulate(x, p['norm_pre_mix'], m[0], m[1])
    x_mix, _ = token_mixers(hx, p, ctx_states, rows, True)
    x = x + m[2] * rmsnorm(x_mix, p['norm_post_mix'])
    hx2 = modulate(x, p['norm_pre_ffn'], m[3], m[4])
    x = x + m[5] * rmsnorm(peer_ffn(hx2, p), p['norm_post_ffn'])
    return x, ctx


def setup_inputs(seed: int = 0) -> dict:
    key = jax.random.key(seed)
    ks = jax.random.split(key, 32)
    f32 = jnp.float32

    def nrm(k, shape, s):
        return s * jax.random.normal(k, shape, f32)

    L, D = DEPTH, D_MODEL
    G, P, H = S5_GROUPS, S5_STATE, S5_GROUP
    lam_im0 = jnp.pi * jnp.arange(P, dtype=f32)
    log_step = jax.random.uniform(ks[13], (L, 2, G), f32, math.log(1e-3), math.log(1e-1))
    a_log = jnp.log(jax.random.uniform(ks[22], (L, 2, DN_HEADS), f32, 1.0, 16.0))
    dt = jnp.exp(jax.random.uniform(ks[23], (L, 2, DN_HEADS), f32, math.log(1e-3), math.log(1e-1)))
    dt_bias = dt + jnp.log(-jnp.expm1(-dt))
    return {
        'x': nrm(ks[0], (BATCH, SEQ, D), 1.0),
        'c': nrm(ks[1], (BATCH, D), 1.0),
        'ctx': nrm(ks[2], (BATCH, CTX_LEN, D), 1.0),
        'c_ctx': nrm(ks[3], (D,), 1.0),
        'w_mod': nrm(ks[4], (L, D, 6 * D), 0.5 * D ** -0.5),
        'b_mod': nrm(ks[5], (L, 6 * D), 0.01),
        'norm_pre_mix': 1.0 + nrm(ks[6], (L, D), 0.02),
        'norm_post_mix': 1.0 + nrm(ks[7], (L, D), 0.02),
        'norm_pre_ffn': 1.0 + nrm(ks[8], (L, D), 0.02),
        'norm_post_ffn': 1.0 + nrm(ks[9], (L, D), 0.02),
        'w_in': nrm(ks[10], (L, D, IN_COLS), D ** -0.5),
        's5_lam_re': -0.5 + nrm(ks[11], (L, 2, G, P), 0.01),
        's5_lam_im': lam_im0 + nrm(ks[12], (L, 2, G, P), 0.01),
        's5_log_step': log_step,
        's5_b_re': nrm(ks[14], (L, 2, G, P, H), (2 * H) ** -0.5),
        's5_b_im': nrm(ks[15], (L, 2, G, P, H), (2 * H) ** -0.5),
        's5_c_re': nrm(ks[16], (L, 2, G, H, P), (2 * P) ** -0.5),
        's5_c_im': nrm(ks[17], (L, 2, G, H, P), (2 * P) ** -0.5),
        's5_d': nrm(ks[18], (L, S5_WIDTH), 0.5),
        's5_glu_w': nrm(ks[19], (L, S5_WIDTH, S5_WIDTH), S5_WIDTH ** -0.5),
        's5_glu_b': nrm(ks[20], (L, S5_WIDTH), 0.01),
        'dn_conv_w': nrm(ks[21], (L, DN_CONV, 3 * DN_WIDTH), DN_CONV ** -0.5),
        'dn_a_log': a_log,
        'dn_dt_bias': dt_bias,
        'dn_norm_w': 1.0 + nrm(ks[24], (L, DN_HEAD_DIM), 0.02),
        'w_branch_s5': nrm(ks[25], (L, S5_WIDTH, D), S5_WIDTH ** -0.5),
        'w_branch_dn': nrm(ks[26], (L, DN_WIDTH, D), DN_WIDTH ** -0.5),
        'w_out': nrm(ks[27], (L, D, D), D ** -0.5),
        'peer_w_q': nrm(ks[28], (L, D, PEER_HEADS * 2 * PEER_KEY_DIM), D ** -0.5),
        'peer_sub_keys': nrm(ks[29], (L, PEER_HEADS, 2, PEER_N_KEYS, PEER_KEY_DIM), PEER_KEY_DIM ** -0.5),
        'peer_u': nrm(ks[30], (L, PEER_N_EXPERTS, D), D ** -0.5),
        'peer_v': nrm(ks[31], (L, PEER_N_EXPERTS, D), (PEER_HEADS * PEER_TOPK) ** -0.5),
    }


def reference(x, c, ctx, c_ctx, w_mod, b_mod, norm_pre_mix, norm_post_mix, norm_pre_ffn,
              norm_post_ffn, w_in, s5_lam_re, s5_lam_im, s5_log_step, s5_b_re, s5_b_im,
              s5_c_re, s5_c_im, s5_d, s5_glu_w, s5_glu_b, dn_conv_w, dn_a_log, dn_dt_bias,
              dn_norm_w, w_branch_s5, w_branch_dn, w_out, peer_w_q, peer_sub_keys, peer_u, peer_v):
    rows = x.shape[1] // GRID_W
    for l in range(DEPTH):
        p = {
            'w_mod': w_mod[l], 'b_mod': b_mod[l],
            'norm_pre_mix': norm_pre_mix[l], 'norm_post_mix': norm_post_mix[l],
            'norm_pre_ffn': norm_pre_ffn[l], 'norm_post_ffn': norm_post_ffn[l],
            'w_in': w_in[l],
            's5_lam_re': s5_lam_re[l], 's5_lam_im': s5_lam_im[l], 's5_log_step': s5_log_step[l],
            's5_b_re': s5_b_re[l], 's5_b_im': s5_b_im[l], 's5_c_re': s5_c_re[l], 's5_c_im': s5_c_im[l],
            's5_d': s5_d[l], 's5_glu_w': s5_glu_w[l], 's5_glu_b': s5_glu_b[l],
            'dn_conv_w': dn_conv_w[l], 'dn_a_log': dn_a_log[l], 'dn_dt_bias': dn_dt_bias[l],
            'dn_norm_w': dn_norm_w[l],
            'w_branch_s5': w_branch_s5[l], 'w_branch_dn': w_branch_dn[l], 'w_out': w_out[l],
            'peer_w_q': peer_w_q[l], 'peer_sub_keys': peer_sub_keys[l],
            'peer_u': peer_u[l], 'peer_v': peer_v[l],
        }
        x, ctx = hybrid_layer(x, ctx, c, c_ctx, p, rows, l == DEPTH - 1)
    return x
```

```cpp
#include <hip/hip_runtime.h>
#include <hip/hip_bf16.h>
#include <hip/hip_cooperative_groups.h>
#include <cstdio>
namespace cg = cooperative_groups;

typedef unsigned short bf16_t;
using bf16x8 = __attribute__((ext_vector_type(8))) short;
using f32x4 = __attribute__((ext_vector_type(4))) float;

#define DEVI __device__ __forceinline__

constexpr int NB = 16, TL = 2048, DM = 1024, NT = NB * TL, TCX = 256, NC = NB * TCX;
constexpr int LD1 = 3584;
constexpr int LDC = 2560;
constexpr int LD2 = 3072;
constexpr int W1ROWS = 3712;
constexpr int NTHREADS = 512;
constexpr int LDS_BYTES = 139264;

constexpr size_t al256(size_t x) { return (x + 255) & ~(size_t)255; }
constexpr size_t OFF_WIN1 = 0;
constexpr size_t OFF_WIN2 = OFF_WIN1 + al256((size_t)W1ROWS * 1024 * 2);
constexpr size_t OFF_GLU  = OFF_WIN2 + al256((size_t)3072 * 1024 * 2);
constexpr size_t OFF_WB5  = OFF_GLU + al256((size_t)512 * 512 * 2);
constexpr size_t OFF_WBDN = OFF_WB5 + al256((size_t)1024 * 512 * 2);
constexpr size_t OFF_WOUT = OFF_WBDN + al256((size_t)1024 * 1024 * 2);
constexpr size_t OFF_WQ   = OFF_WOUT + al256((size_t)1024 * 1024 * 2);
constexpr size_t OFF_MOD  = OFF_WQ + al256((size_t)2048 * 1024 * 2);
constexpr size_t OFF_AB   = OFF_MOD + al256((size_t)17 * 6144 * 4);
constexpr size_t OFF_ABC  = OFF_AB + al256((size_t)NT * 32 * 4);
constexpr size_t OFF_S5ST = OFF_ABC + al256((size_t)NC * 32 * 4);
constexpr size_t OFF_DNST = OFF_S5ST + al256((size_t)NB * 32 * 2 * 64 * 2 * 4);
constexpr size_t OFF_PROJC = OFF_DNST + al256((size_t)NB * 8 * 2 * 128 * 128 * 4);
constexpr size_t OFF_CKV  = OFF_PROJC + al256((size_t)NC * LDC * 2);
constexpr size_t OFF_YF   = OFF_CKV + al256((size_t)NC * 2048 * 2);
constexpr size_t OFF_YB   = OFF_YF + al256((size_t)NT * 512 * 2);
constexpr size_t OFF_OF   = OFF_YB + al256((size_t)NT * 512 * 2);
constexpr size_t OFF_OB   = OFF_OF + al256((size_t)NT * 1024 * 2);
constexpr size_t OFF_PROJ1 = OFF_OB + al256((size_t)NT * 1024 * 2);
constexpr size_t WS_END   = OFF_PROJ1 + al256((size_t)NT * LD1 * 2);
constexpr size_t OFF_PROJ2 = OFF_PROJ1;
constexpr size_t OFF_X1   = OFF_PROJ1;
constexpr size_t OFF_HX2  = OFF_PROJ1 + al256((size_t)NT * 1024 * 4);
constexpr size_t OFF_Y5   = OFF_YF;
constexpr size_t OFF_Y5G  = OFF_YB;
constexpr size_t OFF_YDN  = OFF_OF;
constexpr size_t OFF_MERGED = OFF_OB;
constexpr size_t OFF_QP   = OFF_OF;
constexpr size_t OFF_IDX  = OFF_YF;
constexpr size_t OFF_GATE = OFF_YB;
static_assert(OFF_HX2 + (size_t)NT * 1024 * 2 <= WS_END, "alias overflow");
static_assert((size_t)NT * 128 * 4 <= (size_t)NT * 512 * 2, "idx alias");
constexpr size_t DO_HX = 0;
constexpr size_t DO_HC = (size_t)NT * 1024 * 2;

struct Params {
    const float* in[32];
    float* out;
    unsigned char* ws;
    int ph_lo, ph_hi;
};

DEVI float bf2f(bf16_t v) { return __uint_as_float(((unsigned)v) << 16); }
DEVI bf16_t f2bf(float f) {
    unsigned u = __float_as_uint(f);
    u += 0x7fffu + ((u >> 16) & 1u);
    return (bf16_t)(u >> 16);
}
DEVI unsigned pack2(float a, float b) { return (unsigned)f2bf(a) | ((unsigned)f2bf(b) << 16); }
DEVI float sigmoid_(float x) { return 1.f / (1.f + __expf(-x)); }
DEVI float silu_(float x) { return x / (1.f + __expf(-x)); }
DEVI float gelu_(float x) {
    float u = 0.7978845608028654f * (x + 0.044715f * x * x * x);
    return 0.5f * x * (1.f + tanhf(u));
}
DEVI float softplus_(float x) { return x > 20.f ? x : log1pf(__expf(x)); }
DEVI float wave_sum(float v) {
#pragma unroll
    for (int m = 32; m >= 1; m >>= 1) v += __shfl_xor(v, m);
    return v;
}
DEVI float wave_max(float v) {
#pragma unroll
    for (int m = 32; m >= 1; m >>= 1) v = fmaxf(v, __shfl_xor(v, m));
    return v;
}
DEVI float readlane_f(float v, int l) { return __int_as_float(__builtin_amdgcn_readlane(__float_as_int(v), l)); }

template <class Epi>
DEVI void gemm_tile(const bf16_t* A, int lda, const bf16_t* Bt, int ldb, int K, int m0, int n0,
                    unsigned char* lds, Epi epi) {
    constexpr int ST = 144;
    unsigned char* As = lds;
    unsigned char* Bs = lds + 128 * ST;
    const int tid = threadIdx.x, lane = tid & 63, w = tid >> 6, wm = w >> 2, wn = w & 3;
    f32x4 acc[4][2];
#pragma unroll
    for (int mi = 0; mi < 4; ++mi)
#pragma unroll
        for (int ni = 0; ni < 2; ++ni) acc[mi][ni] = (f32x4){0.f, 0.f, 0.f, 0.f};
    uint4 ra0, ra1, rb0, rb1;
    const int nk = K >> 6;
    const int lrow0 = tid >> 3, lkc = (tid & 7) * 8;
    const bf16_t* Ap = A + (size_t)(m0 + lrow0) * lda + lkc;
    const bf16_t* Bp = Bt + (size_t)(n0 + lrow0) * ldb + lkc;
    const size_t a64 = (size_t)64 * lda, b64 = (size_t)64 * ldb;
    ra0 = *(const uint4*)(Ap); ra1 = *(const uint4*)(Ap + a64);
    rb0 = *(const uint4*)(Bp); rb1 = *(const uint4*)(Bp + b64);
    for (int kt = 0; kt < nk; ++kt) {
        __syncthreads();
        *(uint4*)(As + lrow0 * ST + lkc * 2) = ra0;
        *(uint4*)(As + (lrow0 + 64) * ST + lkc * 2) = ra1;
        *(uint4*)(Bs + lrow0 * ST + lkc * 2) = rb0;
        *(uint4*)(Bs + (lrow0 + 64) * ST + lkc * 2) = rb1;
        __syncthreads();
        if (kt + 1 < nk) {
            const int ko = (kt + 1) * 64;
            ra0 = *(const uint4*)(Ap + ko); ra1 = *(const uint4*)(Ap + a64 + ko);
            rb0 = *(const uint4*)(Bp + ko); rb1 = *(const uint4*)(Bp + b64 + ko);
        }
#pragma unroll
        for (int ks = 0; ks < 2; ++ks) {
            bf16x8 af[4], bfr[2];
            const int kb = (ks * 32 + 8 * (lane >> 4)) * 2;
#pragma unroll
            for (int mi = 0; mi < 4; ++mi) af[mi] = *(const bf16x8*)(As + (wm * 64 + mi * 16 + (lane & 15)) * ST + kb);
#pragma unroll
            for (int ni = 0; ni < 2; ++ni) bfr[ni] = *(const bf16x8*)(Bs + (wn * 32 + ni * 16 + (lane & 15)) * ST + kb);
#pragma unroll
            for (int mi = 0; mi < 4; ++mi)
#pragma unroll
                for (int ni = 0; ni < 2; ++ni)
                    acc[mi][ni] = __builtin_amdgcn_mfma_f32_16x16x32_bf16(af[mi], bfr[ni], acc[mi][ni], 0, 0, 0);
        }
    }
#pragma unroll
    for (int mi = 0; mi < 4; ++mi)
#pragma unroll
        for (int ni = 0; ni < 2; ++ni)
#pragma unroll
            for (int r = 0; r < 4; ++r) {
                const int row = m0 + wm * 64 + mi * 16 + (lane >> 4) * 4 + r;
                const int col = n0 + wn * 32 + ni * 16 + (lane & 15);
                epi(row, col, acc[mi][ni][r]);
            }
    __syncthreads();
}

DEVI void phase_adaln(const Params& p, float* MOD, unsigned char* lds) {
    float* sc = (float*)lds;
    float* red = sc + 17 * 1024;
    const int tid = threadIdx.x;
    const float* c = p.in[1];
    const float* cctx = p.in[3];
    const float* w_mod = p.in[4];
    const float* b_mod = p.in[5];
    if ((int)blockIdx.x >= 192) return;
    for (int i = tid; i < 17 * 1024; i += NTHREADS) {
        int r = i >> 10, d = i & 1023;
        float v = r < 16 ? c[r * 1024 + d] : cctx[d];
        sc[i] = silu_(v);
    }
    __syncthreads();
    for (int item = blockIdx.x; item < 192; item += gridDim.x) {
        const int cc = tid & 31, kg = tid >> 5;
        const int col = item * 32 + cc;
        float acc[17];
#pragma unroll
        for (int r = 0; r < 17; ++r) acc[r] = 0.f;
        for (int k = kg * 64; k < kg * 64 + 64; ++k) {
            const float wv = w_mod[(size_t)k * 6144 + col];
#pragma unroll
            for (int r = 0; r < 17; ++r) acc[r] += sc[r * 1024 + k] * wv;
        }
#pragma unroll
        for (int r = 0; r < 17; ++r) red[(kg * 17 + r) * 32 + cc] = acc[r];
        __syncthreads();
        for (int o = tid; o < 17 * 32; o += NTHREADS) {
            const int r = o >> 5, c2 = o & 31;
            float s = b_mod[item * 32 + c2];
            for (int g = 0; g < 16; ++g) s += red[(g * 17 + r) * 32 + c2];
            MOD[r * 6144 + item * 32 + c2] = s;
        }
        __syncthreads();
    }
}

DEVI void conv_seg(const float* src, int K, int ldsrc, int col0, int ncols, bf16_t* dst, int drow0, unsigned char* lds, int vb, int nvb) {
    float* tile = (float*)lds;
    const int tid = threadIdx.x;
    const int ntn = (ncols + 63) >> 6, ntk = K >> 6;
    for (int t = vb; t < ntn * ntk; t += nvb) {
        const int tn = t / ntk, tk = t % ntk;
        const int n0 = tn * 64, k0 = tk * 64;
        __syncthreads();
#pragma unroll
        for (int i = 0; i < 2; ++i) {
            const int r = (tid >> 4) + 32 * i, c4 = (tid & 15) * 4;
            float4 v = make_float4(0.f, 0.f, 0.f, 0.f);
            if (n0 + c4 < ncols) v = *(const float4*)(src + (size_t)(k0 + r) * ldsrc + col0 + n0 + c4);
            tile[r * 65 + c4 + 0] = v.x; tile[r * 65 + c4 + 1] = v.y; tile[r * 65 + c4 + 2] = v.z; tile[r * 65 + c4 + 3] = v.w;
        }
        __syncthreads();
        {
            const int n = tid >> 3, kq = (tid & 7) * 8;
            if (n0 + n < ncols) {
                uint4 o;
                o.x = pack2(tile[(kq + 0) * 65 + n], tile[(kq + 1) * 65 + n]);
                o.y = pack2(tile[(kq + 2) * 65 + n], tile[(kq + 3) * 65 + n]);
                o.z = pack2(tile[(kq + 4) * 65 + n], tile[(kq + 5) * 65 + n]);
                o.w = pack2(tile[(kq + 6) * 65 + n], tile[(kq + 7) * 65 + n]);
                *(uint4*)(dst + (size_t)(drow0 + n0 + n) * K + k0 + kq) = o;
            }
        }
    }
    __syncthreads();
}

DEVI void phase_weights(const Params& p, unsigned char* lds) {
    unsigned char* ws = p.ws;
    bf16_t* WIN1 = (bf16_t*)(ws + OFF_WIN1);
    bf16_t* WIN2 = (bf16_t*)(ws + OFF_WIN2);
    const int nvb = gridDim.x;
    const int vb = ((int)blockIdx.x + nvb - 192 % nvb) % nvb;
    const float* w_in = p.in[10];
    conv_seg(w_in, 1024, 6688, 0, 2560, WIN1, 0, lds, vb, nvb);
    conv_seg(w_in, 1024, 6688, 2592, 1024, WIN1, 2560, lds, vb, nvb);
    conv_seg(w_in, 1024, 6688, 2560, 32, WIN1, 3584, lds, vb, nvb);
    conv_seg(w_in, 1024, 6688, 3616, 3072, WIN2, 0, lds, vb, nvb);
    conv_seg(p.in[19], 512, 512, 0, 512, (bf16_t*)(ws + OFF_GLU), 0, lds, vb, nvb);
    conv_seg(p.in[25], 512, 1024, 0, 1024, (bf16_t*)(ws + OFF_WB5), 0, lds, vb, nvb);
    conv_seg(p.in[26], 1024, 1024, 0, 1024, (bf16_t*)(ws + OFF_WBDN), 0, lds, vb, nvb);
    conv_seg(p.in[27], 1024, 1024, 0, 1024, (bf16_t*)(ws + OFF_WOUT), 0, lds, vb, nvb);
    conv_seg(p.in[28], 1024, 2048, 0, 2048, (bf16_t*)(ws + OFF_WQ), 0, lds, vb, nvb);
    {
        uint4* z = (uint4*)(WIN1 + (size_t)3616 * 1024);
        const int n16 = 96 * 1024 * 2 / 16;
        for (int i = blockIdx.x * NTHREADS + threadIdx.x; i < n16; i += gridDim.x * NTHREADS) z[i] = make_uint4(0, 0, 0, 0);
    }
}

DEVI void modulate_rows(const float* X, int nrows, int rows_per_batch, const float* gain, const float* shift0, const float* scale0,
                        int bstride, bf16_t* OUT) {
    const int lane = threadIdx.x & 63, w = threadIdx.x >> 6;
    for (int row = blockIdx.x * 8 + w; row < nrows; row += gridDim.x * 8) {
        const float* xr = X + (size_t)row * 1024;
        float4 v[4];
        float ss = 0.f;
#pragma unroll
        for (int i = 0; i < 4; ++i) {
            v[i] = *(const float4*)(xr + lane * 4 + 256 * i);
            ss += v[i].x * v[i].x + v[i].y * v[i].y + v[i].z * v[i].z + v[i].w * v[i].w;
        }
        ss = wave_sum(ss);
        const float r = rsqrtf(ss * (1.f / 1024.f) + 1e-6f);
        const int b = row / rows_per_batch;
        const float* sh = shift0 + (size_t)b * bstride;
        const float* scl = scale0 + (size_t)b * bstride;
#pragma unroll
        for (int i = 0; i < 4; ++i) {
            const int d = lane * 4 + 256 * i;
            const float4 g = *(const float4*)(gain + d);
            const float4 s = *(const float4*)(scl + d);
            const float4 h = *(const float4*)(sh + d);
            uint2 o;
            o.x = pack2(v[i].x * r * g.x * (1.f + s.x) + h.x, v[i].y * r * g.y * (1.f + s.y) + h.y);
            o.y = pack2(v[i].z * r * g.z * (1.f + s.z) + h.z, v[i].w * r * g.w * (1.f + s.w) + h.w);
            *(uint2*)(OUT + (size_t)row * 1024 + d) = o;
        }
    }
}

DEVI void conv_tile(const bf16_t* src, int lds_src, int tok0, bool lo_ok, bool hi_ok, int scol,
                    bf16_t* dst, int ld_dst, int dcol, const float* cw, int wch, bool do_norm, float oscale, unsigned char* lds) {
    float* tile = (float*)lds;
    const int tid = threadIdx.x;
    __syncthreads();
    for (int c = tid; c < 68 * 16; c += NTHREADS) {
        const int r = c >> 4, ch = (c & 15) * 8;
        const int trow = r - 2;
        const bool ok = (trow >= 0 && trow < 64) || (trow < 0 && lo_ok) || (trow >= 64 && hi_ok);
        uint4 v = make_uint4(0, 0, 0, 0);
        if (ok) v = *(const uint4*)(src + (size_t)(tok0 + trow) * lds_src + scol + ch);
        float* t = tile + r * 128 + ch;
        t[0] = __uint_as_float(v.x << 16); t[1] = __uint_as_float(v.x & 0xffff0000u);
        t[2] = __uint_as_float(v.y << 16); t[3] = __uint_as_float(v.y & 0xffff0000u);
        t[4] = __uint_as_float(v.z << 16); t[5] = __uint_as_float(v.z & 0xffff0000u);
        t[6] = __uint_as_float(v.w << 16); t[7] = __uint_as_float(v.w & 0xffff0000u);
    }
    __syncthreads();
    const int cg8 = (tid & 15) * 8, tq = tid >> 4;
    float wv[5][8];
#pragma unroll
    for (int j = 0; j < 5; ++j)
#pragma unroll
        for (int c = 0; c < 8; ++c) wv[j][c] = cw[j * 3072 + wch + cg8 + c];
#pragma unroll
    for (int h = 0; h < 2; ++h) {
        const int t = tq + 32 * h;
        float o[8];
        float ss = 0.f;
#pragma unroll
        for (int c = 0; c < 8; ++c) {
            float a = 0.f;
#pragma unroll
            for (int j = 0; j < 5; ++j) a += wv[j][c] * tile[(t + j) * 128 + cg8 + c];
            a = silu_(a);
            o[c] = a;
            ss += a * a;
        }
        float sc = oscale;
        if (do_norm) {
            ss += __shfl_xor(ss, 1); ss += __shfl_xor(ss, 2); ss += __shfl_xor(ss, 4); ss += __shfl_xor(ss, 8);
            sc = rsqrtf(ss + 1e-6f) * oscale;
        }
        uint4 ov;
        ov.x = pack2(o[0] * sc, o[1] * sc); ov.y = pack2(o[2] * sc, o[3] * sc);
        ov.z = pack2(o[4] * sc, o[5] * sc); ov.w = pack2(o[6] * sc, o[7] * sc);
        *(uint4*)(dst + (size_t)(tok0 + t) * ld_dst + dcol + cg8) = ov;
    }
    __syncthreads();
}

DEVI void s5_seq(const Params& p, const bf16_t* U, int ldu, int tokbase, int Tlen, int b, int g, int dir,
                 const float* h0, float* hout, bf16_t* Y, float* ldsY  ) {
    const int lane = threadIdx.x & 63;
    const int dg = dir * 32 + g;
    const float step = expf(p.in[13][dg]);
    const float lr = p.in[11][dg * 64 + lane], li = p.in[12][dg * 64 + lane];
    const float mag = expf(lr * step);
    const float ar = mag * cosf(li * step), ai = mag * sinf(li * step);
    const float den = lr * lr + li * li;
    const float fr = ((ar - 1.f) * lr + ai * li) / den;
    const float fi = (ai * lr - (ar - 1.f) * li) / den;
    float Bre[16], Bim[16], Cre[16], Cim[16];
#pragma unroll
    for (int h = 0; h < 16; ++h) {
        const float br = p.in[14][(dg * 64 + lane) * 16 + h], bi = p.in[15][(dg * 64 + lane) * 16 + h];
        Bre[h] = fr * br - fi * bi;
        Bim[h] = fr * bi + fi * br;
        Cre[h] = p.in[16][(dg * 16 + h) * 64 + lane];
        Cim[h] = p.in[17][(dg * 16 + h) * 64 + lane];
    }
    float hr = 0.f, hi = 0.f;
    if (h0) { hr = h0[lane]; hi = h0[64 + lane]; }
    const int nch = Tlen >> 6;
    const bool b0 = lane & 1, b1 = lane & 2, b2 = lane & 4, b3 = lane & 8;
    const int hmap = ((lane & 1) << 3) | ((lane & 2) << 1) | ((lane & 4) >> 1) | ((lane & 8) >> 3);
    for (int ci = 0; ci < nch; ++ci) {
        const int ch = dir ? (nch - 1 - ci) : ci;
        const int tok = tokbase + ch * 64 + lane;
        float uf[16];
        {
            const uint4 v0 = *(const uint4*)(U + (size_t)tok * ldu + g * 16);
            const uint4 v1 = *(const uint4*)(U + (size_t)tok * ldu + g * 16 + 8);
            uf[0] = __uint_as_float(v0.x << 16); uf[1] = __uint_as_float(v0.x & 0xffff0000u);
            uf[2] = __uint_as_float(v0.y << 16); uf[3] = __uint_as_float(v0.y & 0xffff0000u);
            uf[4] = __uint_as_float(v0.z << 16); uf[5] = __uint_as_float(v0.z & 0xffff0000u);
            uf[6] = __uint_as_float(v0.w << 16); uf[7] = __uint_as_float(v0.w & 0xffff0000u);
            uf[8] = __uint_as_float(v1.x << 16); uf[9] = __uint_as_float(v1.x & 0xffff0000u);
            uf[10] = __uint_as_float(v1.y << 16); uf[11] = __uint_as_float(v1.y & 0xffff0000u);
            uf[12] = __uint_as_float(v1.z << 16); uf[13] = __uint_as_float(v1.z & 0xffff0000u);
            uf[14] = __uint_as_float(v1.w << 16); uf[15] = __uint_as_float(v1.w & 0xffff0000u);
        }
        for (int s = 0; s < 64; ++s) {
            const int t = dir ? (63 - s) : s;
            float xr = 0.f, xi = 0.f;
#pragma unroll
            for (int h = 0; h < 16; ++h) {
                const float uu = readlane_f(uf[h], t);
                xr += Bre[h] * uu;
                xi += Bim[h] * uu;
            }
            const float nhr = ar * hr - ai * hi + xr;
            const float nhi = ar * hi + ai * hr + xi;
            hr = nhr; hi = nhi;
            if (Y) {
                float v[16];
#pragma unroll
                for (int h = 0; h < 16; ++h) v[h] = Cre[h] * hr - Cim[h] * hi;
                float w8[8], w4[4], w2[2];
#pragma unroll
                for (int i = 0; i < 8; ++i) { const float snd = b0 ? v[i] : v[i + 8]; const float kp = b0 ? v[i + 8] : v[i]; w8[i] = kp + __shfl_xor(snd, 1); }
#pragma unroll
                for (int i = 0; i < 4; ++i) { const float snd = b1 ? w8[i] : w8[i + 4]; const float kp = b1 ? w8[i + 4] : w8[i]; w4[i] = kp + __shfl_xor(snd, 2); }
#pragma unroll
                for (int i = 0; i < 2; ++i) { const float snd = b2 ? w4[i] : w4[i + 2]; const float kp = b2 ? w4[i + 2] : w4[i]; w2[i] = kp + __shfl_xor(snd, 4); }
                float w1;
                { const float snd = b3 ? w2[0] : w2[1]; const float kp = b3 ? w2[1] : w2[0]; w1 = kp + __shfl_xor(snd, 8); }
                w1 += __shfl_xor(w1, 16);
                w1 += __shfl_xor(w1, 32);
                if (lane < 16) ldsY[t * 17 + hmap] = w1;
            }
        }
        if (Y) {
            uint4 o0, o1;
            float y[16];
#pragma unroll
            for (int h = 0; h < 16; ++h) {
                y[h] = ldsY[lane * 17 + h];
                if (dir == 0) y[h] += p.in[18][g * 16 + h] * uf[h];
            }
            o0.x = pack2(y[0], y[1]); o0.y = pack2(y[2], y[3]); o0.z = pack2(y[4], y[5]); o0.w = pack2(y[6], y[7]);
            o1.x = pack2(y[8], y[9]); o1.y = pack2(y[10], y[11]); o1.z = pack2(y[12], y[13]); o1.w = pack2(y[14], y[15]);
            *(uint4*)(Y + (size_t)tok * 512 + g * 16) = o0;
            *(uint4*)(Y + (size_t)tok * 512 + g * 16 + 8) = o1;
        }
    }
    if (hout) { hout[lane] = hr; hout[64 + lane] = hi; }
}

DEVI void dn_seq(const Params& p, const bf16_t* Kp, const bf16_t* Vp, const bf16_t* Qp, int ld, const float* AB, int tokbase, int Tlen,
                 int head, int dir, const float* S0, float* Sout, bf16_t* O, unsigned char* lds) {
    float* lk = (float*)lds;
    float* lq = lk + 128;
    float* lv = lq + 128;
    float* lsc = lv + 128;
    float* red = lsc + 4;
    float* red2 = red + 512;
    const int tid = threadIdx.x, j = tid & 127, ib = tid >> 7;
    float S[32];
    if (S0) {
#pragma unroll
        for (int ii = 0; ii < 32; ++ii) S[ii] = S0[(size_t)(ib * 32 + ii) * 128 + j];
    } else {
#pragma unroll
        for (int ii = 0; ii < 32; ++ii) S[ii] = 0.f;
    }
    const float aexp = expf(p.in[22][dir * 8 + head]);
    const float dtb = p.in[23][dir * 8 + head];
    auto fetch = [&](int step) -> float {
        const int t = dir ? (Tlen - 1 - step) : step;
        const size_t tok = (size_t)(tokbase + t);
        float r = 0.f;
        if (tid < 128) r = bf2f(Kp[tok * ld + tid]);
        else if (tid < 256) { if (Qp) r = bf2f(Qp[tok * ld + (tid - 128)]); }
        else if (tid < 384) r = bf2f(Vp[tok * ld + (tid - 256)]);
        else if (tid == 384) r = AB[tok * 32 + (2 * dir) * 8 + head];
        else if (tid == 385) r = AB[tok * 32 + (2 * dir + 1) * 8 + head];
        return r;
    };
    float nxt = fetch(0);
    __syncthreads();
    for (int step = 0; step < Tlen; ++step) {
        if (tid < 384) lk[tid] = nxt;
        else if (tid == 384) lsc[0] = __expf(-aexp * softplus_(nxt + dtb));
        else if (tid == 385) lsc[1] = sigmoid_(nxt);
        __syncthreads();
        if (step + 1 < Tlen) nxt = fetch(step + 1);
        const float a = lsc[0], beta = lsc[1];
        float part = 0.f;
#pragma unroll
        for (int ii = 0; ii < 32; ++ii) part += lk[ib * 32 + ii] * S[ii];
        red[ib * 128 + j] = part;
        __syncthreads();
        const float kS = red[j] + red[128 + j] + red[256 + j] + red[384 + j];
        const float vn = beta * (lv[j] - a * kS);
#pragma unroll
        for (int ii = 0; ii < 32; ++ii) S[ii] = a * S[ii] + lk[ib * 32 + ii] * vn;
        if (O) {
            float po = 0.f;
#pragma unroll
            for (int ii = 0; ii < 32; ++ii) po += lq[ib * 32 + ii] * S[ii];
            red2[ib * 128 + j] = po;
            __syncthreads();
            if (ib == 0) {
                const int t = dir ? (Tlen - 1 - step) : step;
                O[(size_t)(tokbase + t) * 1024 + head * 128 + j] = f2bf(red2[j] + red2[128 + j] + red2[256 + j] + red2[384 + j]);
            }
        }
        __syncthreads();
    }
    if (Sout) {
#pragma unroll
        for (int ii = 0; ii < 32; ++ii) Sout[(size_t)(ib * 32 + ii) * 128 + j] = S[ii];
    }
}

DEVI void phase_topk(const Params& p, const bf16_t* QP, int* IDX, float* GATE, unsigned char* lds) {
    float* keys = (float*)lds;
    const int tid = threadIdx.x, lane = tid & 63, w = tid >> 6;
    const int nb = gridDim.x;
    const int head = blockIdx.x & 7;
    const int bsub = blockIdx.x >> 3, nsub = (nb + 7 - head) / 8;
    const float* sk = p.in[29] + (size_t)head * 2 * 128 * 128;
    for (int i = tid; i < 2 * 128 * 128; i += NTHREADS) {
        const int jk = i >> 7, d = i & 127;
        keys[jk * 129 + d] = sk[i];
    }
    __syncthreads();
    for (int tok = bsub * 8 + w; tok < NT; tok += nsub * 8) {
        const bf16_t* qrow = QP + (size_t)tok * 2048 + head * 256;
        float mysv[2]; int mysi[2];
        mysv[0] = mysv[1] = 0.f; mysi[0] = mysi[1] = 0;
#pragma unroll
        for (int jj = 0; jj < 2; ++jj) {
            const unsigned qq = *(const unsigned*)(qrow + jj * 128 + 2 * lane);
            const float q0 = __uint_as_float(qq << 16), q1 = __uint_as_float(qq & 0xffff0000u);
            const float* k0 = keys + (jj * 128 + lane) * 129;
            const float* k1 = keys + (jj * 128 + lane + 64) * 129;
            float s0 = 0.f, s1 = 0.f;
#pragma unroll 4
            for (int dd = 0; dd < 64; ++dd) {
                const float a0 = readlane_f(q0, dd), a1 = readlane_f(q1, dd);
                s0 += a0 * k0[2 * dd] + a1 * k0[2 * dd + 1];
                s1 += a0 * k1[2 * dd] + a1 * k1[2 * dd + 1];
            }
            float pk0 = __uint_as_float((__float_as_uint(s0) & 0xffffff80u) | (unsigned)lane);
            float pk1 = __uint_as_float((__float_as_uint(s1) & 0xffffff80u) | (unsigned)(lane + 64));
#pragma unroll 1
            for (int r = 0; r < 16; ++r) {
                const float m = wave_max(fmaxf(pk0, pk1));
                if (pk0 == m) pk0 = -INFINITY;
                if (pk1 == m) pk1 = -INFINITY;
                if (lane == r) { mysv[jj] = __uint_as_float(__float_as_uint(m) & 0xffffff80u); mysi[jj] = (int)(__float_as_uint(m) & 127u); }
            }
        }
        float cd[4];
#pragma unroll
        for (int i = 0; i < 4; ++i) {
            const int c = lane + 64 * i;
            const float va = __shfl(mysv[0], c >> 4), vb = __shfl(mysv[1], c & 15);
            cd[i] = __uint_as_float((__float_as_uint(va + vb) & 0xffffff00u) | (unsigned)c);
        }
        float myv = 0.f; int myc = 0;
#pragma unroll 1
        for (int r = 0; r < 16; ++r) {
            const float m = wave_max(fmaxf(fmaxf(cd[0], cd[1]), fmaxf(cd[2], cd[3])));
#pragma unroll
            for (int i = 0; i < 4; ++i) if (cd[i] == m) cd[i] = -INFINITY;
            if (lane == r) myc = (int)(__float_as_uint(m) & 255u);
        }
        {
            const float va = __shfl(mysv[0], myc >> 4), vb = __shfl(mysv[1], myc & 15);
            myv = va + vb;
            const int i0 = __shfl(mysi[0], myc >> 4), i1 = __shfl(mysi[1], myc & 15);
            float vm = lane < 16 ? myv : -INFINITY;
            const float mx = wave_max(vm);
            const float e = lane < 16 ? __expf(myv - mx) : 0.f;
            const float se = wave_sum(e);
            if (lane < 16) {
                IDX[(size_t)tok * 128 + head * 16 + lane] = i0 * 128 + i1;
                GATE[(size_t)tok * 128 + head * 16 + lane] = e / se;
            }
        }
    }
}

DEVI void phase_peer(const Params& p, const bf16_t* HX2, const int* IDX, const float* GATE, const float* X1, const float* MOD, float* OUT) {
    const int lane = threadIdx.x & 63, w = threadIdx.x >> 6;
    const float* ut = p.in[30];
    const float* vt = p.in[31];
    for (int tok = blockIdx.x * 8 + w; tok < NT; tok += gridDim.x * 8) {
        float h[16], acc[16];
#pragma unroll
        for (int i = 0; i < 4; ++i) {
            const uint2 v = *(const uint2*)(HX2 + (size_t)tok * 1024 + lane * 4 + 256 * i);
            h[4 * i + 0] = __uint_as_float(v.x << 16); h[4 * i + 1] = __uint_as_float(v.x & 0xffff0000u);
            h[4 * i + 2] = __uint_as_float(v.y << 16); h[4 * i + 3] = __uint_as_float(v.y & 0xffff0000u);
            acc[4 * i] = acc[4 * i + 1] = acc[4 * i + 2] = acc[4 * i + 3] = 0.f;
        }
        const int id0 = IDX[(size_t)tok * 128 + lane], id1 = IDX[(size_t)tok * 128 + 64 + lane];
        const float g0 = GATE[(size_t)tok * 128 + lane], g1 = GATE[(size_t)tok * 128 + 64 + lane];
        for (int e = 0; e < 128; e += 2) {
            int ia, ib; float ga, gb;
            if (e < 64) { ia = __builtin_amdgcn_readlane(id0, e); ib = __builtin_amdgcn_readlane(id0, e + 1); ga = readlane_f(g0, e); gb = readlane_f(g0, e + 1); }
            else { ia = __builtin_amdgcn_readlane(id1, e - 64); ib = __builtin_amdgcn_readlane(id1, e - 63); ga = readlane_f(g1, e - 64); gb = readlane_f(g1, e - 63); }
            const float* ua = ut + (size_t)ia * 1024 + lane * 4;
            const float* ub = ut + (size_t)ib * 1024 + lane * 4;
            const float* va = vt + (size_t)ia * 1024 + lane * 4;
            const float* vb = vt + (size_t)ib * 1024 + lane * 4;
            float4 xa[4], xb[4], ya[4], yb[4];
#pragma unroll
            for (int i = 0; i < 4; ++i) { xa[i] = *(const float4*)(ua + 256 * i); xb[i] = *(const float4*)(ub + 256 * i); }
#pragma unroll
            for (int i = 0; i < 4; ++i) { ya[i] = *(const float4*)(va + 256 * i); yb[i] = *(const float4*)(vb + 256 * i); }
            float da = 0.f, db = 0.f;
#pragma unroll
            for (int i = 0; i < 4; ++i) {
                da += xa[i].x * h[4 * i] + xa[i].y * h[4 * i + 1] + xa[i].z * h[4 * i + 2] + xa[i].w * h[4 * i + 3];
                db += xb[i].x * h[4 * i] + xb[i].y * h[4 * i + 1] + xb[i].z * h[4 * i + 2] + xb[i].w * h[4 * i + 3];
            }
            da = wave_sum(da); db = wave_sum(db);
            const float wa = gelu_(da) * ga, wb = gelu_(db) * gb;
#pragma unroll
            for (int i = 0; i < 4; ++i) {
                acc[4 * i + 0] += wa * ya[i].x + wb * yb[i].x;
                acc[4 * i + 1] += wa * ya[i].y + wb * yb[i].y;
                acc[4 * i + 2] += wa * ya[i].z + wb * yb[i].z;
                acc[4 * i + 3] += wa * ya[i].w + wb * yb[i].w;
            }
        }
        float ss = 0.f;
#pragma unroll
        for (int i = 0; i < 16; ++i) ss += acc[i] * acc[i];
        ss = wave_sum(ss);
        const float r = rsqrtf(ss * (1.f / 1024.f) + 1e-6f);
        const int b = tok / TL;
        const float* gate2 = MOD + (size_t)b * 6144 + 5 * 1024;
        const float* nw = p.in[9];
#pragma unroll
        for (int i = 0; i < 4; ++i) {
            const int d = lane * 4 + 256 * i;
            const float4 x1 = *(const float4*)(X1 + (size_t)tok * 1024 + d);
            const float4 g = *(const float4*)(gate2 + d);
            const float4 nwv = *(const float4*)(nw + d);
            float4 o;
            o.x = x1.x + g.x * acc[4 * i + 0] * r * nwv.x;
            o.y = x1.y + g.y * acc[4 * i + 1] * r * nwv.y;
            o.z = x1.z + g.z * acc[4 * i + 2] * r * nwv.z;
            o.w = x1.w + g.w * acc[4 * i + 3] * r * nwv.w;
            *(float4*)(OUT + (size_t)tok * 1024 + d) = o;
        }
    }
}

__global__ void __launch_bounds__(NTHREADS) mega(Params p) {
    extern __shared__ __attribute__((aligned(16))) unsigned char lds[];
    cg::grid_group grid = cg::this_grid();
    unsigned char* ws = p.ws;
    const int tid = threadIdx.x, lane = tid & 63, w = tid >> 6;
    const int nb = gridDim.x, bid = blockIdx.x;
    float* MOD = (float*)(ws + OFF_MOD);
    bf16_t* HX = (bf16_t*)((unsigned char*)p.out + DO_HX);
    bf16_t* HC = (bf16_t*)((unsigned char*)p.out + DO_HC);
    bf16_t* PROJ1 = (bf16_t*)(ws + OFF_PROJ1);
    bf16_t* PROJC = (bf16_t*)(ws + OFF_PROJC);
    bf16_t* CKV = (bf16_t*)(ws + OFF_CKV);
    float* AB = (float*)(ws + OFF_AB);
    float* ABC = (float*)(ws + OFF_ABC);
    float* S5ST = (float*)(ws + OFF_S5ST);
    float* DNST = (float*)(ws + OFF_DNST);
    bf16_t* YF = (bf16_t*)(ws + OFF_YF);
    bf16_t* YB = (bf16_t*)(ws + OFF_YB);
    bf16_t* OF = (bf16_t*)(ws + OFF_OF);
    bf16_t* OB = (bf16_t*)(ws + OFF_OB);
    const bf16_t* WIN1 = (const bf16_t*)(ws + OFF_WIN1);
    const bf16_t* WIN2 = (const bf16_t*)(ws + OFF_WIN2);

#define IN(k) (p.ph_lo <= (k) && (k) < p.ph_hi)
#define SEAM(k) do { if ((k) + 1 < p.ph_hi) grid.sync(); } while (0)

    if (IN(0)) {
        phase_adaln(p, MOD, lds);
        __syncthreads();
        phase_weights(p, lds);
        SEAM(0);
    }
    if (IN(1)) {
        modulate_rows(p.in[0], NT, TL, p.in[6], MOD, MOD + 1024, 6144, HX);
        modulate_rows(p.in[2], NC, TCX, p.in[6], MOD + 16 * 6144, MOD + 16 * 6144 + 1024, 0, HC);
        SEAM(1);
    }
    if (IN(2)) {
        const int ntl = 256 * 29, ntc = 32 * 21;
        for (int t = bid; t < ntl + ntc; t += nb) {
            if (t < ntl) {
                const int m = t / 29, n = t % 29;
                gemm_tile(HX, 1024, WIN1, 1024, 1024, m * 128, n * 128, lds, [=](int row, int col, float v) {
                    if (col < LD1) PROJ1[(size_t)row * LD1 + col] = f2bf(v);
                    else if (col < LD1 + 32) AB[(size_t)row * 32 + (col - LD1)] = v;
                });
            } else {
                const int tt = t - ntl;
                const int m = tt / 21, n = tt % 21;
                const int nrow = n < 20 ? n * 128 : 3584;
                gemm_tile(HC, 1024, WIN1, 1024, 1024, m * 128, nrow, lds, [=](int row, int col, float v) {
                    if (col < LDC) PROJC[(size_t)row * LDC + col] = f2bf(v);
                    else if (col >= 3584 && col < 3584 + 32) ABC[(size_t)row * 32 + (col - 3584)] = v;
                });
            }
        }
        SEAM(2);
    }
    if (IN(3)) {
        const float* cw = p.in[21];
        const int nlat = NB * 32 * 3 * 8, nctx = NB * 4 * 2 * 8;
        for (int it = bid; it < nlat + nctx; it += nb) {
            if (it < nlat) {
                const int head = it & 7, type = (it >> 3) % 3, br = it / 24;
                const int scol = (type == 0 ? 512 : (type == 1 ? 1536 : 2560)) + head * 128;
                conv_tile(PROJ1, LD1, br * 64, false, false, scol, PROJ1, LD1, scol, cw, type * 1024 + head * 128,
                          type != 1, type == 2 ? 0.08838834764831845f : 1.f, lds);
            } else {
                const int i2 = it - nlat;
                const int head = i2 & 7, type = (i2 >> 3) & 1, bt = i2 >> 4;
                const int tt = bt & 3;
                const int scol = (type == 0 ? 512 : 1536) + head * 128;
                conv_tile(PROJC, LDC, bt * 64, tt > 0, tt < 3, scol, CKV, 2048, type * 1024 + head * 128, cw, type * 1024 + head * 128,
                          type == 0, 1.f, lds);
            }
        }
        SEAM(3);
    }
    if (IN(4)) {
        for (int u = bid; u < 256; u += nb) {
            const int dir = u & 1, head = (u >> 1) & 7, b = u >> 4;
            dn_seq(p, CKV + head * 128, CKV + 1024 + head * 128, nullptr, 2048, ABC, b * TCX, TCX, head, dir, nullptr,
                   DNST + (size_t)u * 128 * 128, nullptr, lds);
        }
        for (int u = bid * 8 + w; u < 1024; u += nb * 8) {
            const int dir = u & 1, g = (u >> 1) & 31, b = u >> 6;
            s5_seq(p, PROJC, LDC, b * TCX, TCX, b, g, dir, nullptr, S5ST + (size_t)u * 128, nullptr, nullptr);
        }
        SEAM(4);
    }
    if (IN(5)) {
        for (int u = bid; u < 256; u += nb) {
            const int dir = u & 1, head = (u >> 1) & 7, b = u >> 4;
            dn_seq(p, PROJ1 + 512 + head * 128, PROJ1 + 1536 + head * 128, PROJ1 + 2560 + head * 128, LD1, AB, b * TL, TL, head, dir,
                   DNST + (size_t)u * 128 * 128, nullptr, dir ? OB : OF, lds);
        }
        __syncthreads();
        for (int u = bid * 8 + w; u < 1024; u += nb * 8) {
            const int dir = u & 1, g = (u >> 1) & 31, b = u >> 6;
            s5_seq(p, PROJ1, LD1, b * TL, TL, b, g, dir, S5ST + (size_t)u * 128, nullptr, dir ? YB : YF, (float*)lds + w * (64 * 17));
        }
        SEAM(5);
    }
    bf16_t* PROJ2 = (bf16_t*)(ws + OFF_PROJ2);
    bf16_t* Y5 = (bf16_t*)(ws + OFF_Y5);
    if (IN(6)) {
        for (int t = bid; t < 256 * 24; t += nb) {
            const int m = t / 24, n = t % 24;
            gemm_tile(HX, 1024, WIN2, 1024, 1024, m * 128, n * 128, lds, [=](int row, int col, float v) {
                PROJ2[(size_t)row * LD2 + col] = f2bf(v);
            });
        }
        for (size_t i = (size_t)bid * NTHREADS + tid; i < (size_t)NT * 512 / 2; i += (size_t)nb * NTHREADS) {
            const unsigned a = ((const unsigned*)YF)[i], b2 = ((const unsigned*)YB)[i];
            const float y0 = __uint_as_float(a << 16) + __uint_as_float(b2 << 16);
            const float y1 = __uint_as_float(a & 0xffff0000u) + __uint_as_float(b2 & 0xffff0000u);
            ((unsigned*)Y5)[i] = pack2(gelu_(y0), gelu_(y1));
        }
        SEAM(6);
    }
    bf16_t* Y5G = (bf16_t*)(ws + OFF_Y5G);
    bf16_t* YDN = (bf16_t*)(ws + OFF_YDN);
    if (IN(7)) {
        const bf16_t* GLUW = (const bf16_t*)(ws + OFF_GLU);
        const float* glub = p.in[20];
        for (int t = bid; t < 256 * 4; t += nb) {
            const int m = t / 4, n = t % 4;
            gemm_tile(Y5, 512, GLUW, 512, 512, m * 128, n * 128, lds, [=](int row, int col, float v) {
                const float y = bf2f(Y5[(size_t)row * 512 + col]);
                Y5G[(size_t)row * 512 + col] = f2bf(y * sigmoid_(v + glub[col]));
            });
        }
        const float* dnw = p.in[24];
        for (int tok = bid * 8 + w; tok < NT; tok += nb * 8) {
#pragma unroll
            for (int i = 0; i < 2; ++i) {
                const int col = i * 512 + lane * 8;
                const uint4 a = *(const uint4*)(OF + (size_t)tok * 1024 + col);
                const uint4 b2 = *(const uint4*)(OB + (size_t)tok * 1024 + col);
                const uint4 zz = *(const uint4*)(PROJ2 + (size_t)tok * LD2 + col);
                float o[8], z[8];
                o[0] = __uint_as_float(a.x << 16) + __uint_as_float(b2.x << 16); o[1] = __uint_as_float(a.x & 0xffff0000u) + __uint_as_float(b2.x & 0xffff0000u);
                o[2] = __uint_as_float(a.y << 16) + __uint_as_float(b2.y << 16); o[3] = __uint_as_float(a.y & 0xffff0000u) + __uint_as_float(b2.y & 0xffff0000u);
                o[4] = __uint_as_float(a.z << 16) + __uint_as_float(b2.z << 16); o[5] = __uint_as_float(a.z & 0xffff0000u) + __uint_as_float(b2.z & 0xffff0000u);
                o[6] = __uint_as_float(a.w << 16) + __uint_as_float(b2.w << 16); o[7] = __uint_as_float(a.w & 0xffff0000u) + __uint_as_float(b2.w & 0xffff0000u);
                z[0] = __uint_as_float(zz.x << 16); z[1] = __uint_as_float(zz.x & 0xffff0000u);
                z[2] = __uint_as_float(zz.y << 16); z[3] = __uint_as_float(zz.y & 0xffff0000u);
                z[4] = __uint_as_float(zz.z << 16); z[5] = __uint_as_float(zz.z & 0xffff0000u);
                z[6] = __uint_as_float(zz.w << 16); z[7] = __uint_as_float(zz.w & 0xffff0000u);
                float ss = 0.f;
#pragma unroll
                for (int c = 0; c < 8; ++c) ss += o[c] * o[c];
                ss += __shfl_xor(ss, 1); ss += __shfl_xor(ss, 2); ss += __shfl_xor(ss, 4); ss += __shfl_xor(ss, 8);
                const float r = rsqrtf(ss * (1.f / 128.f) + 1e-6f);
                float y[8];
#pragma unroll
                for (int c = 0; c < 8; ++c) y[c] = o[c] * r * dnw[(lane & 15) * 8 + c] * silu_(z[c]);
                uint4 ov;
                ov.x = pack2(y[0], y[1]); ov.y = pack2(y[2], y[3]); ov.z = pack2(y[4], y[5]); ov.w = pack2(y[6], y[7]);
                *(uint4*)(YDN + (size_t)tok * 1024 + col) = ov;
            }
        }
        SEAM(7);
    }
    bf16_t* MERGED = (bf16_t*)(ws + OFF_MERGED);
    if (IN(8)) {
        const bf16_t* WB5 = (const bf16_t*)(ws + OFF_WB5);
        const bf16_t* WBDN = (const bf16_t*)(ws + OFF_WBDN);
        for (int t = bid; t < 256 * 8; t += nb) {
            const int m = t / 8, n = t % 8;
            gemm_tile(Y5G, 512, WB5, 512, 512, m * 128, n * 128, lds, [=](int row, int col, float v) {
                const float g5 = bf2f(PROJ2[(size_t)row * LD2 + 1024 + col]);
                MERGED[(size_t)row * 1024 + col] = f2bf(sigmoid_(g5) * v);
            });
            gemm_tile(YDN, 1024, WBDN, 1024, 1024, m * 128, n * 128, lds, [=](int row, int col, float v) {
                const float gd = bf2f(PROJ2[(size_t)row * LD2 + 2048 + col]);
                const float prev = bf2f(MERGED[(size_t)row * 1024 + col]);
                MERGED[(size_t)row * 1024 + col] = f2bf(prev + sigmoid_(gd) * v);
            });
        }
        SEAM(8);
    }
    float* XMIX = p.out;
    if (IN(9)) {
        const bf16_t* WOUT = (const bf16_t*)(ws + OFF_WOUT);
        for (int t = bid; t < 256 * 8; t += nb) {
            const int m = t / 8, n = t % 8;
            gemm_tile(MERGED, 1024, WOUT, 1024, 1024, m * 128, n * 128, lds, [=](int row, int col, float v) {
                XMIX[(size_t)row * 1024 + col] = v;
            });
        }
        SEAM(9);
    }
    float* X1 = (float*)(ws + OFF_X1);
    bf16_t* HX2 = (bf16_t*)(ws + OFF_HX2);
    if (IN(10)) {
        const float* x = p.in[0];
        const float* npm = p.in[7];
        const float* npf = p.in[8];
        for (int row = bid * 8 + w; row < NT; row += nb * 8) {
            const int b = row / TL;
            const float* mb = MOD + (size_t)b * 6144;
            float4 xm[4];
            float ss = 0.f;
#pragma unroll
            for (int i = 0; i < 4; ++i) {
                xm[i] = *(const float4*)(XMIX + (size_t)row * 1024 + lane * 4 + 256 * i);
                ss += xm[i].x * xm[i].x + xm[i].y * xm[i].y + xm[i].z * xm[i].z + xm[i].w * xm[i].w;
            }
            ss = wave_sum(ss);
            const float r = rsqrtf(ss * (1.f / 1024.f) + 1e-6f);
            float4 x1[4];
            float s2 = 0.f;
#pragma unroll
            for (int i = 0; i < 4; ++i) {
                const int d = lane * 4 + 256 * i;
                const float4 xv = *(const float4*)(x + (size_t)row * 1024 + d);
                const float4 g = *(const float4*)(mb + 2 * 1024 + d);
                const float4 nw = *(const float4*)(npm + d);
                x1[i].x = xv.x + g.x * xm[i].x * r * nw.x;
                x1[i].y = xv.y + g.y * xm[i].y * r * nw.y;
                x1[i].z = xv.z + g.z * xm[i].z * r * nw.z;
                x1[i].w = xv.w + g.w * xm[i].w * r * nw.w;
                s2 += x1[i].x * x1[i].x + x1[i].y * x1[i].y + x1[i].z * x1[i].z + x1[i].w * x1[i].w;
                *(float4*)(X1 + (size_t)row * 1024 + d) = x1[i];
            }
            s2 = wave_sum(s2);
            const float r2 = rsqrtf(s2 * (1.f / 1024.f) + 1e-6f);
#pragma unroll
            for (int i = 0; i < 4; ++i) {
                const int d = lane * 4 + 256 * i;
                const float4 gn = *(const float4*)(npf + d);
                const float4 sh = *(const float4*)(mb + 3 * 1024 + d);
                const float4 scl = *(const float4*)(mb + 4 * 1024 + d);
                uint2 o;
                o.x = pack2(x1[i].x * r2 * gn.x * (1.f + scl.x) + sh.x, x1[i].y * r2 * gn.y * (1.f + scl.y) + sh.y);
                o.y = pack2(x1[i].z * r2 * gn.z * (1.f + scl.z) + sh.z, x1[i].w * r2 * gn.w * (1.f + scl.w) + sh.w);
                *(uint2*)(HX2 + (size_t)row * 1024 + d) = o;
            }
        }
        SEAM(10);
    }
    bf16_t* QP = (bf16_t*)(ws + OFF_QP);
    if (IN(11)) {
        const bf16_t* WQ = (const bf16_t*)(ws + OFF_WQ);
        for (int t = bid; t < 256 * 16; t += nb) {
            const int m = t / 16, n = t % 16;
            gemm_tile(HX2, 1024, WQ, 1024, 1024, m * 128, n * 128, lds, [=](int row, int col, float v) {
                QP[(size_t)row * 2048 + col] = f2bf(v);
            });
        }
        SEAM(11);
    }
    int* IDX = (int*)(ws + OFF_IDX);
    float* GATE = (float*)(ws + OFF_GATE);
    if (IN(12)) {
        phase_topk(p, QP, IDX, GATE, lds);
        SEAM(12);
    }
    if (IN(13)) {
        phase_peer(p, HX2, IDX, GATE, X1, MOD, p.out);
    }
}

constexpr int NPHASES = 14;

extern "C" void kernel_launch(void* const* d_in, const int* in_sizes, int n_in, void* d_out, int out_size, void* d_ws, size_t ws_size,
                              hipStream_t stream) {
    static int grid_blocks = 0;
    if (grid_blocks == 0) {
        if (n_in != 32 || ws_size < WS_END || out_size != NT * DM) {
            fprintf(stderr, "kernel_launch: unexpected sizes n_in=%d ws=%zu (need %zu) out=%d\n", n_in, ws_size, (size_t)WS_END, out_size);
            grid_blocks = -1;
            return;
        }
        int dev = 0, cus = 0, per_cu = 0;
        hipGetDevice(&dev);
        hipDeviceGetAttribute(&cus, hipDeviceAttributeMultiprocessorCount, dev);
        hipFuncSetAttribute((const void*)mega, hipFuncAttributeMaxDynamicSharedMemorySize, LDS_BYTES);
        hipOccupancyMaxActiveBlocksPerMultiprocessor(&per_cu, (const void*)mega, NTHREADS, LDS_BYTES);
        if (per_cu < 1) { fprintf(stderr, "kernel_launch: occupancy query says %d blocks/CU\n", per_cu); per_cu = 1; }
        grid_blocks = cus;
        fprintf(stderr, "kernel_launch: cus=%d per_cu=%d grid=%d ws=%zu need=%zu\n", cus, per_cu, grid_blocks, ws_size, (size_t)WS_END);
    }
    if (grid_blocks < 0) return;
    Params p{};
    for (int i = 0; i < 32; ++i) p.in[i] = (const float*)d_in[i];
    p.out = (float*)d_out;
    p.ws = (unsigned char*)d_ws;
    p.ph_lo = 0; p.ph_hi = NPHASES;
    void* args[] = {&p};
    hipError_t e = hipLaunchCooperativeKernel((const void*)mega, dim3(grid_blocks), dim3(NTHREADS), args, LDS_BYTES, stream);
    if (e != hipSuccess) fprintf(stderr, "cooperative launch failed: %s (grid %d)\n", hipGetErrorString(e), grid_blocks);
}
```

```cpp
#include <hip/hip_runtime.h>
#include <hip/hip_bf16.h>
#include <hip/hip_cooperative_groups.h>
#include <cstdio>
namespace cg = cooperative_groups;

typedef unsigned short bf16_t;
using bf16x8 = __attribute__((ext_vector_type(8))) short;
using f32x4 = __attribute__((ext_vector_type(4))) float;
typedef __bf16 bf16x2_t __attribute__((ext_vector_type(2)));
using f32x16 = __attribute__((ext_vector_type(16))) float;

#define DEVI __device__ __forceinline__

constexpr int NB = 16, TL = 2048, DM = 1024, NT = NB * TL, TCX = 256, NC = NB * TCX;
constexpr int LD1 = 3584;
constexpr int LDC = 2560;
constexpr int LD2 = 3072;
constexpr int W1ROWS = 3712;
constexpr int NTHREADS = 512;
constexpr int LDS_BYTES = 139264;

constexpr size_t al256(size_t x) { return (x + 255) & ~(size_t)255; }
constexpr size_t OFF_WIN1 = 0;
constexpr size_t OFF_WIN2 = OFF_WIN1 + al256((size_t)W1ROWS * 1024 * 2);
constexpr size_t OFF_GLU  = OFF_WIN2 + al256((size_t)3072 * 1024 * 2);
constexpr size_t OFF_WB5  = OFF_GLU + al256((size_t)512 * 512 * 2);
constexpr size_t OFF_WBDN = OFF_WB5 + al256((size_t)1024 * 512 * 2);
constexpr size_t OFF_WOUT = OFF_WBDN + al256((size_t)1024 * 1024 * 2);
constexpr size_t OFF_WQ   = OFF_WOUT + al256((size_t)1024 * 1024 * 2);
constexpr size_t OFF_MOD  = OFF_WQ + al256((size_t)2048 * 1024 * 2);
constexpr size_t OFF_AB   = OFF_MOD + al256((size_t)17 * 6144 * 4);
constexpr size_t OFF_ABC  = OFF_AB + al256((size_t)NT * 32 * 4);
constexpr size_t OFF_S5ST = OFF_ABC + al256((size_t)NC * 32 * 4);
constexpr size_t OFF_DNST = OFF_S5ST + al256((size_t)NB * 32 * 2 * 64 * 2 * 4);
constexpr size_t OFF_PROJC = OFF_DNST + al256((size_t)NB * 8 * 2 * 128 * 128 * 4);
constexpr size_t OFF_CKV  = OFF_PROJC + al256((size_t)NC * LDC * 2);
constexpr size_t OFF_YF   = OFF_CKV + al256((size_t)NC * 2048 * 2);
constexpr size_t OFF_YB   = OFF_YF + al256((size_t)NT * 512 * 2);
constexpr size_t OFF_OF   = OFF_YB + al256((size_t)NT * 512 * 2);
constexpr size_t OFF_OB   = OFF_OF + al256((size_t)NT * 1024 * 2);
constexpr size_t OFF_PROJ1 = OFF_OB + al256((size_t)NT * 1024 * 2);
constexpr size_t WS_END   = OFF_PROJ1 + al256((size_t)NT * LD1 * 2);
constexpr size_t OFF_PROJ2 = OFF_PROJ1;
constexpr size_t OFF_X1   = OFF_PROJ1;
constexpr size_t OFF_HX2  = OFF_PROJ1 + al256((size_t)NT * 1024 * 4);
constexpr size_t OFF_Y5   = OFF_YF;
constexpr size_t OFF_Y5G  = OFF_YB;
constexpr size_t OFF_YDN  = OFF_OF;
constexpr size_t OFF_MERGED = OFF_OB;
constexpr size_t OFF_QP   = OFF_OF;
constexpr size_t OFF_IDX  = OFF_YF;
constexpr size_t OFF_GATE = OFF_YB;
constexpr size_t OFF_UT   = OFF_PROJ1 + (size_t)NT * LD2 * 2;
constexpr size_t OFF_VT   = OFF_PROJC;
static_assert(OFF_HX2 + (size_t)NT * 1024 * 2 <= OFF_UT, "alias overflow");
static_assert(OFF_UT + (size_t)16384 * 1024 * 2 <= WS_END, "UT overflow");
static_assert(OFF_VT + (size_t)16384 * 1024 * 2 <= OFF_YF, "VT overflow");
static_assert((size_t)NT * 128 * 4 <= (size_t)NT * 512 * 2, "idx alias");
constexpr size_t DO_HX = 0;
constexpr size_t DO_HC = (size_t)NT * 1024 * 2;

struct Params {
    const float* in[32];
    float* out;
    unsigned char* ws;
    int ph_lo, ph_hi;
};

DEVI float bf2f(bf16_t v) { return __uint_as_float(((unsigned)v) << 16); }
DEVI bf16_t f2bf(float f) {
    unsigned u = __float_as_uint(f);
    u += 0x7fffu + ((u >> 16) & 1u);
    return (bf16_t)(u >> 16);
}
DEVI unsigned pack2(float a, float b) { return (unsigned)f2bf(a) | ((unsigned)f2bf(b) << 16); }
DEVI float sigmoid_(float x) { return 1.f / (1.f + __expf(-x)); }
DEVI float silu_(float x) { return x / (1.f + __expf(-x)); }
DEVI float gelu_(float x) {
    float u = 0.7978845608028654f * (x + 0.044715f * x * x * x);
    return 0.5f * x * (1.f + tanhf(u));
}
DEVI float softplus_(float x) { return x > 20.f ? x : log1pf(__expf(x)); }
DEVI float wave_sum(float v) {
#pragma unroll
    for (int m = 32; m >= 1; m >>= 1) v += __shfl_xor(v, m);
    return v;
}
DEVI float wave_max(float v) {
#pragma unroll
    for (int m = 32; m >= 1; m >>= 1) v = fmaxf(v, __shfl_xor(v, m));
    return v;
}
DEVI float readlane_f(float v, int l) { return __int_as_float(__builtin_amdgcn_readlane(__float_as_int(v), l)); }

template <class Epi>
DEVI void gemm_tile(const bf16_t* A, int lda, const bf16_t* Bt, int ldb, int K, int m0, int n0,
                    unsigned char* lds, Epi epi) {
    constexpr int ST = 144;
    unsigned char* As = lds;
    unsigned char* Bs = lds + 128 * ST;
    const int tid = threadIdx.x, lane = tid & 63, w = tid >> 6, wm = w >> 2, wn = w & 3;
    f32x4 acc[4][2];
#pragma unroll
    for (int mi = 0; mi < 4; ++mi)
#pragma unroll
        for (int ni = 0; ni < 2; ++ni) acc[mi][ni] = (f32x4){0.f, 0.f, 0.f, 0.f};
    uint4 ra0, ra1, rb0, rb1;
    const int nk = K >> 6;
    const int lrow0 = tid >> 3, lkc = (tid & 7) * 8;
    const bf16_t* Ap = A + (size_t)(m0 + lrow0) * lda + lkc;
    const bf16_t* Bp = Bt + (size_t)(n0 + lrow0) * ldb + lkc;
    const size_t a64 = (size_t)64 * lda, b64 = (size_t)64 * ldb;
    ra0 = *(const uint4*)(Ap); ra1 = *(const uint4*)(Ap + a64);
    rb0 = *(const uint4*)(Bp); rb1 = *(const uint4*)(Bp + b64);
    for (int kt = 0; kt < nk; ++kt) {
        __syncthreads();
        *(uint4*)(As + lrow0 * ST + lkc * 2) = ra0;
        *(uint4*)(As + (lrow0 + 64) * ST + lkc * 2) = ra1;
        *(uint4*)(Bs + lrow0 * ST + lkc * 2) = rb0;
        *(uint4*)(Bs + (lrow0 + 64) * ST + lkc * 2) = rb1;
        __syncthreads();
        if (kt + 1 < nk) {
            const int ko = (kt + 1) * 64;
            ra0 = *(const uint4*)(Ap + ko); ra1 = *(const uint4*)(Ap + a64 + ko);
            rb0 = *(const uint4*)(Bp + ko); rb1 = *(const uint4*)(Bp + b64 + ko);
        }
#pragma unroll
        for (int ks = 0; ks < 2; ++ks) {
            bf16x8 af[4], bfr[2];
            const int kb = (ks * 32 + 8 * (lane >> 4)) * 2;
#pragma unroll
            for (int mi = 0; mi < 4; ++mi) af[mi] = *(const bf16x8*)(As + (wm * 64 + mi * 16 + (lane & 15)) * ST + kb);
#pragma unroll
            for (int ni = 0; ni < 2; ++ni) bfr[ni] = *(const bf16x8*)(Bs + (wn * 32 + ni * 16 + (lane & 15)) * ST + kb);
#pragma unroll
            for (int mi = 0; mi < 4; ++mi)
#pragma unroll
                for (int ni = 0; ni < 2; ++ni)
                    acc[mi][ni] = __builtin_amdgcn_mfma_f32_16x16x32_bf16(af[mi], bfr[ni], acc[mi][ni], 0, 0, 0);
        }
    }
#pragma unroll
    for (int mi = 0; mi < 4; ++mi)
#pragma unroll
        for (int ni = 0; ni < 2; ++ni)
#pragma unroll
            for (int r = 0; r < 4; ++r) {
                const int row = m0 + wm * 64 + mi * 16 + (lane >> 4) * 4 + r;
                const int col = n0 + wn * 32 + ni * 16 + (lane & 15);
                epi(row, col, acc[mi][ni][r]);
            }
    __syncthreads();
}

DEVI void phase_adaln(const Params& p, float* MOD, unsigned char* lds) {
    float* sc = (float*)lds;
    float* red = sc + 17 * 1024;
    const int tid = threadIdx.x;
    const float* c = p.in[1];
    const float* cctx = p.in[3];
    const float* w_mod = p.in[4];
    const float* b_mod = p.in[5];
    if ((int)blockIdx.x >= 192) return;
    for (int i = tid; i < 17 * 1024; i += NTHREADS) {
        int r = i >> 10, d = i & 1023;
        float v = r < 16 ? c[r * 1024 + d] : cctx[d];
        sc[i] = silu_(v);
    }
    __syncthreads();
    for (int item = blockIdx.x; item < 192; item += gridDim.x) {
        const int cc = tid & 31, kg = tid >> 5;
        const int col = item * 32 + cc;
        float acc[17];
#pragma unroll
        for (int r = 0; r < 17; ++r) acc[r] = 0.f;
        for (int k = kg * 64; k < kg * 64 + 64; ++k) {
            const float wv = w_mod[(size_t)k * 6144 + col];
#pragma unroll
            for (int r = 0; r < 17; ++r) acc[r] += sc[r * 1024 + k] * wv;
        }
#pragma unroll
        for (int r = 0; r < 17; ++r) red[(kg * 17 + r) * 32 + cc] = acc[r];
        __syncthreads();
        for (int o = tid; o < 17 * 32; o += NTHREADS) {
            const int r = o >> 5, c2 = o & 31;
            float s = b_mod[item * 32 + c2];
            for (int g = 0; g < 16; ++g) s += red[(g * 17 + r) * 32 + c2];
            MOD[r * 6144 + item * 32 + c2] = s;
        }
        __syncthreads();
    }
}

DEVI void conv_seg(const float* src, int K, int ldsrc, int col0, int ncols, bf16_t* dst, int drow0, unsigned char* lds, int vb, int nvb) {
    float* tile = (float*)lds;
    const int tid = threadIdx.x;
    const int ntn = (ncols + 63) >> 6, ntk = K >> 6;
    for (int t = vb; t < ntn * ntk; t += nvb) {
        const int tn = t / ntk, tk = t % ntk;
        const int n0 = tn * 64, k0 = tk * 64;
        __syncthreads();
#pragma unroll
        for (int i = 0; i < 2; ++i) {
            const int r = (tid >> 4) + 32 * i, c4 = (tid & 15) * 4;
            float4 v = make_float4(0.f, 0.f, 0.f, 0.f);
            if (n0 + c4 < ncols) v = *(const float4*)(src + (size_t)(k0 + r) * ldsrc + col0 + n0 + c4);
            tile[r * 65 + c4 + 0] = v.x; tile[r * 65 + c4 + 1] = v.y; tile[r * 65 + c4 + 2] = v.z; tile[r * 65 + c4 + 3] = v.w;
        }
        __syncthreads();
        {
            const int n = tid >> 3, kq = (tid & 7) * 8;
            if (n0 + n < ncols) {
                uint4 o;
                o.x = pack2(tile[(kq + 0) * 65 + n], tile[(kq + 1) * 65 + n]);
                o.y = pack2(tile[(kq + 2) * 65 + n], tile[(kq + 3) * 65 + n]);
                o.z = pack2(tile[(kq + 4) * 65 + n], tile[(kq + 5) * 65 + n]);
                o.w = pack2(tile[(kq + 6) * 65 + n], tile[(kq + 7) * 65 + n]);
                *(uint4*)(dst + (size_t)(drow0 + n0 + n) * K + k0 + kq) = o;
            }
        }
    }
    __syncthreads();
}

DEVI void phase_weights(const Params& p, unsigned char* lds) {
    unsigned char* ws = p.ws;
    bf16_t* WIN1 = (bf16_t*)(ws + OFF_WIN1);
    bf16_t* WIN2 = (bf16_t*)(ws + OFF_WIN2);
    const int nvb = gridDim.x;
    const int vb = ((int)blockIdx.x + nvb - 192 % nvb) % nvb;
    const float* w_in = p.in[10];
    conv_seg(w_in, 1024, 6688, 0, 2560, WIN1, 0, lds, vb, nvb);
    conv_seg(w_in, 1024, 6688, 2592, 1024, WIN1, 2560, lds, vb, nvb);
    conv_seg(w_in, 1024, 6688, 2560, 32, WIN1, 3584, lds, vb, nvb);
    conv_seg(w_in, 1024, 6688, 3616, 3072, WIN2, 0, lds, vb, nvb);
    conv_seg(p.in[19], 512, 512, 0, 512, (bf16_t*)(ws + OFF_GLU), 0, lds, vb, nvb);
    conv_seg(p.in[25], 512, 1024, 0, 1024, (bf16_t*)(ws + OFF_WB5), 0, lds, vb, nvb);
    conv_seg(p.in[26], 1024, 1024, 0, 1024, (bf16_t*)(ws + OFF_WBDN), 0, lds, vb, nvb);
    conv_seg(p.in[27], 1024, 1024, 0, 1024, (bf16_t*)(ws + OFF_WOUT), 0, lds, vb, nvb);
    conv_seg(p.in[28], 1024, 2048, 0, 2048, (bf16_t*)(ws + OFF_WQ), 0, lds, vb, nvb);
    {
        uint4* z = (uint4*)(WIN1 + (size_t)3616 * 1024);
        const int n16 = 96 * 1024 * 2 / 16;
        for (int i = blockIdx.x * NTHREADS + threadIdx.x; i < n16; i += gridDim.x * NTHREADS) z[i] = make_uint4(0, 0, 0, 0);
    }
}

DEVI void modulate_rows(const float* X, int nrows, int rows_per_batch, const float* gain, const float* shift0, const float* scale0,
                        int bstride, bf16_t* OUT) {
    const int lane = threadIdx.x & 63, w = threadIdx.x >> 6;
    for (int row = blockIdx.x * 8 + w; row < nrows; row += gridDim.x * 8) {
        const float* xr = X + (size_t)row * 1024;
        float4 v[4];
        float ss = 0.f;
#pragma unroll
        for (int i = 0; i < 4; ++i) {
            v[i] = *(const float4*)(xr + lane * 4 + 256 * i);
            ss += v[i].x * v[i].x + v[i].y * v[i].y + v[i].z * v[i].z + v[i].w * v[i].w;
        }
        ss = wave_sum(ss);
        const float r = rsqrtf(ss * (1.f / 1024.f) + 1e-6f);
        const int b = row / rows_per_batch;
        const float* sh = shift0 + (size_t)b * bstride;
        const float* scl = scale0 + (size_t)b * bstride;
#pragma unroll
        for (int i = 0; i < 4; ++i) {
            const int d = lane * 4 + 256 * i;
            const float4 g = *(const float4*)(gain + d);
            const float4 s = *(const float4*)(scl + d);
            const float4 h = *(const float4*)(sh + d);
            uint2 o;
            o.x = pack2(v[i].x * r * g.x * (1.f + s.x) + h.x, v[i].y * r * g.y * (1.f + s.y) + h.y);
            o.y = pack2(v[i].z * r * g.z * (1.f + s.z) + h.z, v[i].w * r * g.w * (1.f + s.w) + h.w);
            *(uint2*)(OUT + (size_t)row * 1024 + d) = o;
        }
    }
}

DEVI void conv_tile(const bf16_t* src, int lds_src, int tok0, bool lo_ok, bool hi_ok, int scol,
                    bf16_t* dst, int ld_dst, int dcol, const float* cw, int wch, bool do_norm, float oscale, unsigned char* lds) {
    float* tile = (float*)lds;
    const int tid = threadIdx.x;
    __syncthreads();
    for (int c = tid; c < 68 * 16; c += NTHREADS) {
        const int r = c >> 4, ch = (c & 15) * 8;
        const int trow = r - 2;
        const bool ok = (trow >= 0 && trow < 64) || (trow < 0 && lo_ok) || (trow >= 64 && hi_ok);
        uint4 v = make_uint4(0, 0, 0, 0);
        if (ok) v = *(const uint4*)(src + (size_t)(tok0 + trow) * lds_src + scol + ch);
        float* t = tile + r * 128 + ch;
        t[0] = __uint_as_float(v.x << 16); t[1] = __uint_as_float(v.x & 0xffff0000u);
        t[2] = __uint_as_float(v.y << 16); t[3] = __uint_as_float(v.y & 0xffff0000u);
        t[4] = __uint_as_float(v.z << 16); t[5] = __uint_as_float(v.z & 0xffff0000u);
        t[6] = __uint_as_float(v.w << 16); t[7] = __uint_as_float(v.w & 0xffff0000u);
    }
    __syncthreads();
    const int cg8 = (tid & 15) * 8, tq = tid >> 4;
    float wv[5][8];
#pragma unroll
    for (int j = 0; j < 5; ++j)
#pragma unroll
        for (int c = 0; c < 8; ++c) wv[j][c] = cw[j * 3072 + wch + cg8 + c];
#pragma unroll
    for (int h = 0; h < 2; ++h) {
        const int t = tq + 32 * h;
        float o[8];
        float ss = 0.f;
#pragma unroll
        for (int c = 0; c < 8; ++c) {
            float a = 0.f;
#pragma unroll
            for (int j = 0; j < 5; ++j) a += wv[j][c] * tile[(t + j) * 128 + cg8 + c];
            a = silu_(a);
            o[c] = a;
            ss += a * a;
        }
        float sc = oscale;
        if (do_norm) {
            ss += __shfl_xor(ss, 1); ss += __shfl_xor(ss, 2); ss += __shfl_xor(ss, 4); ss += __shfl_xor(ss, 8);
            sc = rsqrtf(ss + 1e-6f) * oscale;
        }
        uint4 ov;
        ov.x = pack2(o[0] * sc, o[1] * sc); ov.y = pack2(o[2] * sc, o[3] * sc);
        ov.z = pack2(o[4] * sc, o[5] * sc); ov.w = pack2(o[6] * sc, o[7] * sc);
        *(uint4*)(dst + (size_t)(tok0 + t) * ld_dst + dcol + cg8) = ov;
    }
    __syncthreads();
}

DEVI void s5_seq(const Params& p, const bf16_t* U, int ldu, int tokbase, int Tlen, int b, int g, int dir,
                 const float* h0, float* hout, bf16_t* Y, float* ldsY  ) {
    const int lane = threadIdx.x & 63;
    const int dg = dir * 32 + g;
    const float step = expf(p.in[13][dg]);
    const float lr = p.in[11][dg * 64 + lane], li = p.in[12][dg * 64 + lane];
    const float mag = expf(lr * step);
    const float ar = mag * cosf(li * step), ai = mag * sinf(li * step);
    const float den = lr * lr + li * li;
    const float fr = ((ar - 1.f) * lr + ai * li) / den;
    const float fi = (ai * lr - (ar - 1.f) * li) / den;
    float Bre[16], Bim[16], Cre[16], Cim[16];
#pragma unroll
    for (int h = 0; h < 16; ++h) {
        const float br = p.in[14][(dg * 64 + lane) * 16 + h], bi = p.in[15][(dg * 64 + lane) * 16 + h];
        Bre[h] = fr * br - fi * bi;
        Bim[h] = fr * bi + fi * br;
        Cre[h] = p.in[16][(dg * 16 + h) * 64 + lane];
        Cim[h] = p.in[17][(dg * 16 + h) * 64 + lane];
    }
    float hr = 0.f, hi = 0.f;
    if (h0) { hr = h0[lane]; hi = h0[64 + lane]; }
    const int nch = Tlen >> 6;
    const bool b0 = lane & 1, b1 = lane & 2, b2 = lane & 4, b3 = lane & 8;
    const int hmap = ((lane & 1) << 3) | ((lane & 2) << 1) | ((lane & 4) >> 1) | ((lane & 8) >> 3);
    for (int ci = 0; ci < nch; ++ci) {
        const int ch = dir ? (nch - 1 - ci) : ci;
        const int tok = tokbase + ch * 64 + lane;
        float uf[16];
        {
            const uint4 v0 = *(const uint4*)(U + (size_t)tok * ldu + g * 16);
            const uint4 v1 = *(const uint4*)(U + (size_t)tok * ldu + g * 16 + 8);
            uf[0] = __uint_as_float(v0.x << 16); uf[1] = __uint_as_float(v0.x & 0xffff0000u);
            uf[2] = __uint_as_float(v0.y << 16); uf[3] = __uint_as_float(v0.y & 0xffff0000u);
            uf[4] = __uint_as_float(v0.z << 16); uf[5] = __uint_as_float(v0.z & 0xffff0000u);
            uf[6] = __uint_as_float(v0.w << 16); uf[7] = __uint_as_float(v0.w & 0xffff0000u);
            uf[8] = __uint_as_float(v1.x << 16); uf[9] = __uint_as_float(v1.x & 0xffff0000u);
            uf[10] = __uint_as_float(v1.y << 16); uf[11] = __uint_as_float(v1.y & 0xffff0000u);
            uf[12] = __uint_as_float(v1.z << 16); uf[13] = __uint_as_float(v1.z & 0xffff0000u);
            uf[14] = __uint_as_float(v1.w << 16); uf[15] = __uint_as_float(v1.w & 0xffff0000u);
        }
        for (int s = 0; s < 64; ++s) {
            const int t = dir ? (63 - s) : s;
            float xr = 0.f, xi = 0.f;
#pragma unroll
            for (int h = 0; h < 16; ++h) {
                const float uu = readlane_f(uf[h], t);
                xr += Bre[h] * uu;
                xi += Bim[h] * uu;
            }
            const float nhr = ar * hr - ai * hi + xr;
            const float nhi = ar * hi + ai * hr + xi;
            hr = nhr; hi = nhi;
            if (Y) {
                float v[16];
#pragma unroll
                for (int h = 0; h < 16; ++h) v[h] = Cre[h] * hr - Cim[h] * hi;
                float w8[8], w4[4], w2[2];
#pragma unroll
                for (int i = 0; i < 8; ++i) { const float snd = b0 ? v[i] : v[i + 8]; const float kp = b0 ? v[i + 8] : v[i]; w8[i] = kp + __shfl_xor(snd, 1); }
#pragma unroll
                for (int i = 0; i < 4; ++i) { const float snd = b1 ? w8[i] : w8[i + 4]; const float kp = b1 ? w8[i + 4] : w8[i]; w4[i] = kp + __shfl_xor(snd, 2); }
#pragma unroll
                for (int i = 0; i < 2; ++i) { const float snd = b2 ? w4[i] : w4[i + 2]; const float kp = b2 ? w4[i + 2] : w4[i]; w2[i] = kp + __shfl_xor(snd, 4); }
                float w1;
                { const float snd = b3 ? w2[0] : w2[1]; const float kp = b3 ? w2[1] : w2[0]; w1 = kp + __shfl_xor(snd, 8); }
                w1 += __shfl_xor(w1, 16);
                w1 += __shfl_xor(w1, 32);
                if (lane < 16) ldsY[t * 17 + hmap] = w1;
            }
        }
        if (Y) {
            uint4 o0, o1;
            float y[16];
#pragma unroll
            for (int h = 0; h < 16; ++h) {
                y[h] = ldsY[lane * 17 + h];
                if (dir == 0) y[h] += p.in[18][g * 16 + h] * uf[h];
            }
            o0.x = pack2(y[0], y[1]); o0.y = pack2(y[2], y[3]); o0.z = pack2(y[4], y[5]); o0.w = pack2(y[6], y[7]);
            o1.x = pack2(y[8], y[9]); o1.y = pack2(y[10], y[11]); o1.z = pack2(y[12], y[13]); o1.w = pack2(y[14], y[15]);
            *(uint4*)(Y + (size_t)tok * 512 + g * 16) = o0;
            *(uint4*)(Y + (size_t)tok * 512 + g * 16 + 8) = o1;
        }
    }
    if (hout) { hout[lane] = hr; hout[64 + lane] = hi; }
}

template <bool READOUT>
DEVI void s5_mfma(const Params& p, const bf16_t* U, int ldu, int Tlen, int bp, int g, int dir,
                  const float* S5in, float* S5out, bf16_t* Y, unsigned char* wl  ) {
    constexpr int HST = 272;
    unsigned char* Himg = wl;
    unsigned char* Uimg = wl + 32 * HST;
    const int lane = threadIdx.x & 63;
    const int p0 = lane & 31, hf = lane >> 5;
    const int dg = dir * 32 + g;
    const float step = expf(p.in[13][dg]);
    float ar[2], ai[2], hr[2], hi[2];
    bf16x8 Bf[4];
#pragma unroll
    for (int pt = 0; pt < 2; ++pt) {
        const int pp = dg * 64 + pt * 32 + p0;
        const float lr = p.in[11][pp], li = p.in[12][pp];
        const float mag = expf(lr * step);
        ar[pt] = mag * cosf(li * step); ai[pt] = mag * sinf(li * step);
        const float den = lr * lr + li * li;
        const float fr = ((ar[pt] - 1.f) * lr + ai[pt] * li) / den;
        const float fi = (ai[pt] * lr - (ar[pt] - 1.f) * li) / den;
        bf16x8 bre, bim;
#pragma unroll
        for (int j = 0; j < 8; ++j) {
            const float br = p.in[14][pp * 16 + 8 * hf + j], bi = p.in[15][pp * 16 + 8 * hf + j];
            bre[j] = (short)f2bf(fr * br - fi * bi);
            bim[j] = (short)f2bf(fr * bi + fi * br);
        }
        Bf[pt] = bre; Bf[2 + pt] = bim;
        hr[pt] = 0.f; hi[pt] = 0.f;
    }
    const int myb = 2 * bp + hf;
    if (S5in) {
        const float* h0 = S5in + (size_t)((myb * 32 + g) * 2 + dir) * 128;
#pragma unroll
        for (int pt = 0; pt < 2; ++pt) { hr[pt] = h0[pt * 32 + p0]; hi[pt] = h0[64 + pt * 32 + p0]; }
    }
    bf16x8 Cf[4], Df;
    if (READOUT) {
        const int h = lane & 15, kq = lane >> 4;
#pragma unroll
        for (int ks = 0; ks < 4; ++ks) {
            bf16x8 c;
#pragma unroll
            for (int j = 0; j < 8; ++j) {
                const int pl = ks * 8 + 2 * kq + (j >> 2), tile = j & 3;
                const int pidx = (dg * 16 + h) * 64 + (tile & 1) * 32 + pl;
                const float v = (tile < 2) ? p.in[16][pidx] : -p.in[17][pidx];
                c[j] = (short)f2bf(v);
            }
            Cf[ks] = c;
        }
#pragma unroll
        for (int j = 0; j < 8; ++j) {
            const int k = 8 * kq + j;
            Df[j] = (short)((k == h) ? f2bf(p.in[18][g * 16 + h]) : (bf16_t)0);
        }
    }
    const int m = lane & 31, kh = lane >> 5;
    const int ahf = (m >> 2) & 1, ai_tok = (m & 3) + 4 * (m >> 3);
    const int ab = 2 * bp + ahf;
    const int nblk = Tlen >> 4;
    const bf16_t* Ubase = U + (size_t)ab * Tlen * ldu + g * 16 + 8 * kh;
    auto tok_of = [&](int blk, int i) -> int {
        const int t0 = dir ? (Tlen - 16 * (blk + 1)) : 16 * blk;
        return dir ? (t0 + 15 - i) : (t0 + i);
    };
    uint4 anext = *(const uint4*)(Ubase + (size_t)tok_of(0, ai_tok) * ldu);
    for (int blk = 0; blk < nblk; ++blk) {
        const uint4 acur = anext;
        if (blk + 1 < nblk) anext = *(const uint4*)(Ubase + (size_t)tok_of(blk + 1, ai_tok) * ldu);
        const bf16x8 af = __builtin_bit_cast(bf16x8, acur);
        f32x16 X[4];
#pragma unroll
        for (int t = 0; t < 4; ++t) {
            f32x16 z;
#pragma unroll
            for (int r = 0; r < 16; ++r) z[r] = 0.f;
            X[t] = __builtin_amdgcn_mfma_f32_32x32x16_bf16(af, Bf[t], z, 0, 0, 0);
        }
        if (READOUT && dir == 0) *(uint4*)(Uimg + (ahf * 16 + ai_tok) * 32 + kh * 16) = acur;
#pragma unroll
        for (int r = 0; r < 16; ++r) {
#pragma unroll
            for (int pt = 0; pt < 2; ++pt) {
                const float nr = ar[pt] * hr[pt] - ai[pt] * hi[pt] + X[pt][r];
                const float ni = ar[pt] * hi[pt] + ai[pt] * hr[pt] + X[2 + pt][r];
                hr[pt] = nr; hi[pt] = ni;
                X[pt][r] = nr; X[2 + pt][r] = ni;
            }
            if (READOUT) {
                uint2 o;
                o.x = pack2(X[0][r], X[1][r]);
                o.y = pack2(X[2][r], X[3][r]);
                *(uint2*)(Himg + (hf * 16 + r) * HST + p0 * 8) = o;
            }
        }
        if (READOUT) {
            const int h = lane & 15, kq = lane >> 4;
#pragma unroll
            for (int hb = 0; hb < 2; ++hb) {
                f32x4 yacc = (f32x4){0.f, 0.f, 0.f, 0.f};
#pragma unroll
                for (int ks = 0; ks < 4; ++ks) {
                    const bf16x8 hfrag = *(const bf16x8*)(Himg + (hb * 16 + (lane & 15)) * HST + (ks * 32 + 8 * kq) * 2);
                    yacc = __builtin_amdgcn_mfma_f32_16x16x32_bf16(hfrag, Cf[ks], yacc, 0, 0, 0);
                }
                if (dir == 0) {
                    uint4 uu = make_uint4(0, 0, 0, 0);
                    if (kq < 2) uu = *(const uint4*)(Uimg + (hb * 16 + (lane & 15)) * 32 + kq * 16);
                    yacc = __builtin_amdgcn_mfma_f32_16x16x32_bf16(__builtin_bit_cast(bf16x8, uu), Df, yacc, 0, 0, 0);
                }
                const int ob = 2 * bp + hb;
#pragma unroll
                for (int r = 0; r < 4; ++r) {
                    const int tok = tok_of(blk, 4 * kq + r);
                    Y[((size_t)ob * Tlen + tok) * 512 + g * 16 + h] = f2bf(yacc[r]);
                }
            }
        }
    }
    if (S5out) {
        float* ho = S5out + (size_t)((myb * 32 + g) * 2 + dir) * 128;
#pragma unroll
        for (int pt = 0; pt < 2; ++pt) { ho[pt * 32 + p0] = hr[pt]; ho[64 + pt * 32 + p0] = hi[pt]; }
    }
}

template <int CTRL>
DEVI float dpp_add(float v) {
    const int iv = __float_as_int(v);
    const int r = __builtin_amdgcn_update_dpp(0, iv, CTRL, 0xf, 0xf, true);
    return v + __int_as_float(r);
}
DEVI float red8(float v) {
    v = dpp_add<0xB1>(v);
    v = dpp_add<0x4E>(v);
    v = dpp_add<0x141>(v);
    return v;
}
template <bool HAS_Q>
DEVI void dn_seq(const Params& p, const bf16_t* Kp, const bf16_t* Vp, const bf16_t* Qp, int ld, const float* AB, int tokbase, int Tlen,
                 int head, int dir, const float* S0, float* Sout, bf16_t* O, unsigned char* lds) {
    constexpr int TB = 32;
    float* kb = (float*)lds;
    float* qb = kb + 2 * TB * 128;
    float* vb = qb + 2 * TB * 128;
    float* sc = vb + 2 * TB * 128;
    float* ob = sc + 2 * TB * 4;
    const int tid = threadIdx.x, lane = tid & 63, w = tid >> 6;
    const int rc = lane & 7, cp = lane >> 3;
    const int col = 16 * w + 2 * cp;
    float S[16][2];
    if (S0) {
#pragma unroll
        for (int ii = 0; ii < 16; ++ii) { S[ii][0] = S0[(size_t)(rc * 16 + ii) * 128 + col]; S[ii][1] = S0[(size_t)(rc * 16 + ii) * 128 + col + 1]; }
    } else {
#pragma unroll
        for (int ii = 0; ii < 16; ++ii) { S[ii][0] = 0.f; S[ii][1] = 0.f; }
    }
    const float aexp = expf(p.in[22][dir * 8 + head]);
    const float dtb = p.in[23][dir * 8 + head];
    const int nbat = Tlen / TB;
    const int st_tok = tid >> 4, st_c8 = (tid & 15) * 8;
    uint4 rk, rv, rq; float rg = 0.f, rb = 0.f;
    rq = make_uint4(0, 0, 0, 0);
    auto gload = [&](int bat) {
        const int s = bat * TB + st_tok;
        const size_t tok = (size_t)(tokbase + (dir ? (Tlen - 1 - s) : s));
        rk = *(const uint4*)(Kp + tok * ld + st_c8);
        rv = *(const uint4*)(Vp + tok * ld + st_c8);
        if (HAS_Q) rq = *(const uint4*)(Qp + tok * ld + st_c8);
        if ((tid & 15) == 0) { rg = AB[tok * 32 + (2 * dir) * 8 + head]; rb = AB[tok * 32 + (2 * dir + 1) * 8 + head]; }
    };
    auto lstore = [&](int buf) {
        float* kd = kb + (buf * TB + st_tok) * 128 + st_c8;
        float* vd = vb + (buf * TB + st_tok) * 128 + st_c8;
        float* qd = qb + (buf * TB + st_tok) * 128 + st_c8;
        *(float4*)(kd) = make_float4(__uint_as_float(rk.x << 16), __uint_as_float(rk.x & 0xffff0000u), __uint_as_float(rk.y << 16), __uint_as_float(rk.y & 0xffff0000u));
        *(float4*)(kd + 4) = make_float4(__uint_as_float(rk.z << 16), __uint_as_float(rk.z & 0xffff0000u), __uint_as_float(rk.w << 16), __uint_as_float(rk.w & 0xffff0000u));
        *(float4*)(vd) = make_float4(__uint_as_float(rv.x << 16), __uint_as_float(rv.x & 0xffff0000u), __uint_as_float(rv.y << 16), __uint_as_float(rv.y & 0xffff0000u));
        *(float4*)(vd + 4) = make_float4(__uint_as_float(rv.z << 16), __uint_as_float(rv.z & 0xffff0000u), __uint_as_float(rv.w << 16), __uint_as_float(rv.w & 0xffff0000u));
        if (HAS_Q) {
            *(float4*)(qd) = make_float4(__uint_as_float(rq.x << 16), __uint_as_float(rq.x & 0xffff0000u), __uint_as_float(rq.y << 16), __uint_as_float(rq.y & 0xffff0000u));
            *(float4*)(qd + 4) = make_float4(__uint_as_float(rq.z << 16), __uint_as_float(rq.z & 0xffff0000u), __uint_as_float(rq.w << 16), __uint_as_float(rq.w & 0xffff0000u));
        }
        if ((tid & 15) == 0) {
            sc[(buf * TB + st_tok) * 4 + 0] = __expf(-aexp * softplus_(rg + dtb));
            sc[(buf * TB + st_tok) * 4 + 1] = sigmoid_(rb);
        }
    };
    auto kqdot = [&](int buf) {
        if (HAS_Q) {
            const float* kd = kb + (buf * TB + st_tok) * 128 + st_c8;
            const float* qd = qb + (buf * TB + st_tok) * 128 + st_c8;
            float s = 0.f;
#pragma unroll
            for (int c = 0; c < 8; ++c) s += kd[c] * qd[c];
            s += __shfl_xor(s, 1); s += __shfl_xor(s, 2); s += __shfl_xor(s, 4); s += __shfl_xor(s, 8);
            if ((tid & 15) == 0) sc[(buf * TB + st_tok) * 4 + 2] = s;
        }
    };
    __syncthreads();
    gload(0);
    lstore(0);
    __syncthreads();
    kqdot(0);
    __syncthreads();
    for (int bat = 0; bat < nbat; ++bat) {
        const int buf = bat & 1;
        if (bat + 1 < nbat) gload(bat + 1);
        const float* kbase = kb + buf * TB * 128 + rc * 16;
        const float* qbase = qb + buf * TB * 128 + rc * 16;
        const float* vbase = vb + buf * TB * 128 + col;
        const float* sbase = sc + buf * TB * 4;
#pragma unroll 2
        for (int t = 0; t < TB; ++t) {
            float kk[16];
#pragma unroll
            for (int i4 = 0; i4 < 4; ++i4) {
                const float4 x = *(const float4*)(kbase + t * 128 + i4 * 4);
                kk[4 * i4] = x.x; kk[4 * i4 + 1] = x.y; kk[4 * i4 + 2] = x.z; kk[4 * i4 + 3] = x.w;
            }
            float ks0 = 0.f, ks1 = 0.f, qs0 = 0.f, qs1 = 0.f;
#pragma unroll
            for (int ii = 0; ii < 16; ++ii) { ks0 += kk[ii] * S[ii][0]; ks1 += kk[ii] * S[ii][1]; }
            if (HAS_Q) {
#pragma unroll
                for (int i4 = 0; i4 < 4; ++i4) {
                    const float4 x = *(const float4*)(qbase + t * 128 + i4 * 4);
                    qs0 += x.x * S[4 * i4][0] + x.y * S[4 * i4 + 1][0] + x.z * S[4 * i4 + 2][0] + x.w * S[4 * i4 + 3][0];
                    qs1 += x.x * S[4 * i4][1] + x.y * S[4 * i4 + 1][1] + x.z * S[4 * i4 + 2][1] + x.w * S[4 * i4 + 3][1];
                }
            }
            ks0 = red8(ks0); ks1 = red8(ks1);
            if (HAS_Q) { qs0 = red8(qs0); qs1 = red8(qs1); }
            const float4 scv = *(const float4*)(sbase + t * 4);
            const float a = scv.x, beta = scv.y, kq = scv.z;
            const float2 vv = *(const float2*)(vbase + t * 128);
            const float vn0 = beta * (vv.x - a * ks0), vn1 = beta * (vv.y - a * ks1);
            if (HAS_Q) {
                if (rc == 0) *(float2*)(ob + t * 128 + col) = make_float2(a * qs0 + kq * vn0, a * qs1 + kq * vn1);
            }
#pragma unroll
            for (int ii = 0; ii < 16; ++ii) {
                S[ii][0] = a * S[ii][0] + kk[ii] * vn0;
                S[ii][1] = a * S[ii][1] + kk[ii] * vn1;
            }
        }
        __syncthreads();
        if (HAS_Q) {
            const int s = bat * TB + st_tok;
            const size_t tok = (size_t)(tokbase + (dir ? (Tlen - 1 - s) : s));
            const float* od = ob + st_tok * 128 + st_c8;
            uint4 o;
            o.x = pack2(od[0], od[1]); o.y = pack2(od[2], od[3]); o.z = pack2(od[4], od[5]); o.w = pack2(od[6], od[7]);
            *(uint4*)(O + tok * 1024 + head * 128 + st_c8) = o;
        }
        if (bat + 1 < nbat) {
            lstore(buf ^ 1);
            __syncthreads();
            kqdot(buf ^ 1);
        }
        __syncthreads();
    }
    if (Sout) {
#pragma unroll
        for (int ii = 0; ii < 16; ++ii) { Sout[(size_t)(rc * 16 + ii) * 128 + col] = S[ii][0]; Sout[(size_t)(rc * 16 + ii) * 128 + col + 1] = S[ii][1]; }
    }
}

DEVI void cswap_desc(float& a, float& b) { const float hi = fmaxf(a, b), lo = fminf(a, b); a = hi; b = lo; }
DEVI void sort16_desc(float (&v)[16]) {
#pragma unroll
    for (int k = 2; k <= 16; k <<= 1)
#pragma unroll
        for (int j = k >> 1; j > 0; j >>= 1)
#pragma unroll
            for (int i = 0; i < 16; ++i) {
                const int l = i ^ j;
                if (l > i) {
                    if ((i & k) == 0) cswap_desc(v[i], v[l]); else cswap_desc(v[l], v[i]);
                }
            }
}
DEVI void merge16_desc(float (&a)[16], const float (&b)[16]) {
#pragma unroll
    for (int i = 0; i < 16; ++i) a[i] = fmaxf(a[i], b[15 - i]);
#pragma unroll
    for (int j = 8; j > 0; j >>= 1)
#pragma unroll
        for (int i = 0; i < 16; ++i) {
            const int l = i ^ j;
            if (l > i) cswap_desc(a[i], a[l]);
        }
}

DEVI void phase_topk(const Params& p, const bf16_t* QP, int* IDX, float* GV, unsigned char* lds) {
    constexpr int KST = 272;
    const int tid = threadIdx.x, lane = tid & 63, w = tid >> 6;
    const int nb = gridDim.x;
    const int head = blockIdx.x & 7;
    const int bsub = blockIdx.x >> 3, nsub = (nb + 7 - head) / 8;
    const float* sk = p.in[29] + (size_t)head * 2 * 128 * 128;
    __syncthreads();
    for (int i = tid; i < 256 * 32; i += NTHREADS) {
        const int row = i >> 5, d4 = (i & 31) * 4;
        const float4 v = *(const float4*)(sk + row * 128 + d4);
        uint2 o; o.x = pack2(v.x, v.y); o.y = pack2(v.z, v.w);
        *(uint2*)(lds + row * KST + d4 * 2) = o;
    }
    __syncthreads();
    const int hf = lane >> 5, tl = lane & 31;
    for (int tile = bsub * 8 + w; tile < NT / 32; tile += nsub * 8) {
        const int tok = tile * 32 + tl;
        float L[2][16];
#pragma unroll
        for (int jj = 0; jj < 2; ++jj) {
            const bf16_t* qrow = QP + (size_t)tok * 2048 + head * 256 + jj * 128 + 8 * hf;
            uint4 bq[8];
#pragma unroll
            for (int ks = 0; ks < 8; ++ks) bq[ks] = *(const uint4*)(qrow + ks * 16);
            f32x16 acc[4];
#pragma unroll
            for (int kt = 0; kt < 4; ++kt)
#pragma unroll
                for (int r = 0; r < 16; ++r) acc[kt][r] = 0.f;
#pragma unroll
            for (int ks = 0; ks < 8; ++ks) {
#pragma unroll
                for (int kt = 0; kt < 4; ++kt) {
                    const bf16x8 af = *(const bf16x8*)(lds + (jj * 128 + kt * 32 + tl) * KST + (ks * 16 + 8 * hf) * 2);
                    acc[kt] = __builtin_amdgcn_mfma_f32_32x32x16_bf16(af, __builtin_bit_cast(bf16x8, bq[ks]), acc[kt], 0, 0, 0);
                }
                __builtin_amdgcn_sched_barrier(0);
            }
            float g[4][16];
#pragma unroll
            for (int kt = 0; kt < 4; ++kt) {
#pragma unroll
                for (int r = 0; r < 16; ++r) {
                    const unsigned key = (unsigned)(32 * kt + (r & 3) + 8 * (r >> 2)) + 4u * (unsigned)hf;
                    g[kt][r] = __uint_as_float((__float_as_uint(acc[kt][r]) & 0xffffff80u) | key);
                }
                sort16_desc(g[kt]);
            }
            merge16_desc(g[0], g[1]);
            merge16_desc(g[2], g[3]);
            merge16_desc(g[0], g[2]);
            float o[16];
#pragma unroll
            for (int i = 0; i < 16; ++i) o[i] = __shfl_xor(g[0][i], 32);
            merge16_desc(g[0], o);
#pragma unroll
            for (int i = 0; i < 16; ++i) L[jj][i] = g[0][i];
        }
        float R0[16], G1[16], G2[16], G3[16];
#pragma unroll
        for (int i = 0; i < 16; ++i) { R0[i] = L[0][0] + L[1][i]; G3[i] = -INFINITY; }
        {
            int n = 0;
#pragma unroll
            for (int a2 = 1; a2 < 16; ++a2) {
#pragma unroll
                for (int b2 = 0; b2 < 16 / (a2 + 1); ++b2) {
                    const float c = L[0][a2] + L[1][b2];
                    if (n < 16) G1[n] = c; else if (n < 32) G2[n - 16] = c; else G3[n - 32] = c;
                    ++n;
                }
            }
        }
        sort16_desc(G1);
        sort16_desc(G2);
        cswap_desc(G3[0], G3[1]);
        merge16_desc(R0, G1);
        merge16_desc(R0, G2);
        merge16_desc(R0, G3);
        const float tau = R0[15];
        unsigned* dst = (hf ? (unsigned*)GV : (unsigned*)IDX) + (size_t)tok * 128 + head * 16;
        int pos = 0;
#pragma unroll
        for (int a2 = 0; a2 < 16; ++a2) {
            const unsigned i0 = (__float_as_uint(L[0][a2]) & 127u) << 7;
#pragma unroll
            for (int b2 = 0; b2 < 16 / (a2 + 1); ++b2) {
                const float c = L[0][a2] + L[1][b2];
                if (c >= tau && pos < 16) {
                    const unsigned code = i0 | (__float_as_uint(L[1][b2]) & 127u);
                    dst[pos] = hf ? __float_as_uint(c) : code;
                    ++pos;
                }
            }
        }
    }
}

DEVI float dot2bf(unsigned a, unsigned b, float c) {
    return __builtin_amdgcn_fdot2_f32_bf16(__builtin_bit_cast(bf16x2_t, a), __builtin_bit_cast(bf16x2_t, b), c, false);
}
DEVI float dot8bf(const uint4& a, const uint4& b, float c) {
    c = dot2bf(a.x, b.x, c); c = dot2bf(a.y, b.y, c); c = dot2bf(a.z, b.z, c); c = dot2bf(a.w, b.w, c);
    return c;
}
DEVI void axpy8(float* acc, const uint4& v, float w) {
    acc[0] += w * __uint_as_float(v.x << 16); acc[1] += w * __uint_as_float(v.x & 0xffff0000u);
    acc[2] += w * __uint_as_float(v.y << 16); acc[3] += w * __uint_as_float(v.y & 0xffff0000u);
    acc[4] += w * __uint_as_float(v.z << 16); acc[5] += w * __uint_as_float(v.z & 0xffff0000u);
    acc[6] += w * __uint_as_float(v.w << 16); acc[7] += w * __uint_as_float(v.w & 0xffff0000u);
}
DEVI void convert_table(const float* src, bf16_t* dst, size_t n) {
    const size_t n8 = n >> 3;
    for (size_t i = (size_t)blockIdx.x * NTHREADS + threadIdx.x; i < n8; i += (size_t)gridDim.x * NTHREADS) {
        const float4 a = *(const float4*)(src + i * 8);
        const float4 b = *(const float4*)(src + i * 8 + 4);
        uint4 o;
        o.x = pack2(a.x, a.y); o.y = pack2(a.z, a.w); o.z = pack2(b.x, b.y); o.w = pack2(b.z, b.w);
        *(uint4*)(dst + i * 8) = o;
    }
}

#define PEER_LOAD(U0, U1, V0, V1, idx) do { \
    const bf16_t* up_ = UT + (size_t)(idx) * 1024 + lane * 8; \
    const bf16_t* vp_ = VT + (size_t)(idx) * 1024 + lane * 8; \
    U0 = *(const uint4*)up_; U1 = *(const uint4*)(up_ + 512); \
    V0 = *(const uint4*)vp_; V1 = *(const uint4*)(vp_ + 512); } while (0)
#define PEER_USE(U0, U1, V0, V1, gg) do { \
    float d_ = dot8bf(U0, h0, 0.f); d_ = dot8bf(U1, h1, d_); \
    d_ = wave_sum(d_); \
    const float w_ = gelu_(d_) * (gg); \
    axpy8(acc, V0, w_); axpy8(acc + 8, V1, w_); } while (0)

DEVI void phase_peer(const Params& p, const bf16_t* HX2, const int* IDX, const float* GATE, const float* X1, const float* MOD, float* OUT,
                     const bf16_t* UT, const bf16_t* VT) {
    const int lane = threadIdx.x & 63, w = threadIdx.x >> 6;
    for (int tok = blockIdx.x * 8 + w; tok < NT; tok += gridDim.x * 8) {
        float acc[16];
#pragma unroll
        for (int i = 0; i < 16; ++i) acc[i] = 0.f;
        const uint4 h0 = *(const uint4*)(HX2 + (size_t)tok * 1024 + lane * 8);
        const uint4 h1 = *(const uint4*)(HX2 + (size_t)tok * 1024 + 512 + lane * 8);
        const int id0 = IDX[(size_t)tok * 128 + lane], id1 = IDX[(size_t)tok * 128 + 64 + lane];
        float g0 = GATE[(size_t)tok * 128 + lane], g1 = GATE[(size_t)tok * 128 + 64 + lane];
        {
            float m0 = g0, m1 = g1;
#pragma unroll
            for (int m = 1; m <= 8; m <<= 1) { m0 = fmaxf(m0, __shfl_xor(m0, m)); m1 = fmaxf(m1, __shfl_xor(m1, m)); }
            g0 = __expf(g0 - m0); g1 = __expf(g1 - m1);
            float s0 = g0, s1 = g1;
#pragma unroll
            for (int m = 1; m <= 8; m <<= 1) { s0 += __shfl_xor(s0, m); s1 += __shfl_xor(s1, m); }
            g0 = g0 / s0; g1 = g1 / s1;
        }
        uint4 a0u0, a0u1, a0v0, a0v1, a1u0, a1u1, a1v0, a1v1;
        uint4 b0u0, b0u1, b0v0, b0v1, b1u0, b1u1, b1v0, b1v1;
        PEER_LOAD(a0u0, a0u1, a0v0, a0v1, __builtin_amdgcn_readlane(id0, 0));
        PEER_LOAD(a1u0, a1u1, a1v0, a1v1, __builtin_amdgcn_readlane(id0, 1));
#pragma unroll 1
        for (int hh = 0; hh < 2; ++hh) {
            const int idh = hh ? id1 : id0;
            const float gh = hh ? g1 : g0;
#pragma unroll 1
            for (int e = 0; e < 64; e += 4) {
                PEER_LOAD(b0u0, b0u1, b0v0, b0v1, __builtin_amdgcn_readlane(idh, e + 2));
                PEER_LOAD(b1u0, b1u1, b1v0, b1v1, __builtin_amdgcn_readlane(idh, e + 3));
                PEER_USE(a0u0, a0u1, a0v0, a0v1, readlane_f(gh, e));
                PEER_USE(a1u0, a1u1, a1v0, a1v1, readlane_f(gh, e + 1));
                if (e + 4 < 64) {
                    PEER_LOAD(a0u0, a0u1, a0v0, a0v1, __builtin_amdgcn_readlane(idh, e + 4));
                    PEER_LOAD(a1u0, a1u1, a1v0, a1v1, __builtin_amdgcn_readlane(idh, e + 5));
                } else if (hh == 0) {
                    PEER_LOAD(a0u0, a0u1, a0v0, a0v1, __builtin_amdgcn_readlane(id1, 0));
                    PEER_LOAD(a1u0, a1u1, a1v0, a1v1, __builtin_amdgcn_readlane(id1, 1));
                }
                PEER_USE(b0u0, b0u1, b0v0, b0v1, readlane_f(gh, e + 2));
                PEER_USE(b1u0, b1u1, b1v0, b1v1, readlane_f(gh, e + 3));
            }
        }
        float ss = 0.f;
#pragma unroll
        for (int i = 0; i < 16; ++i) ss += acc[i] * acc[i];
        ss = wave_sum(ss);
        const float r = rsqrtf(ss * (1.f / 1024.f) + 1e-6f);
        const int b = tok / TL;
        const float* gate2 = MOD + (size_t)b * 6144 + 5 * 1024;
        const float* nw = p.in[9];
#pragma unroll
        for (int i = 0; i < 4; ++i) {
            const int d = (i >> 1) * 512 + lane * 8 + (i & 1) * 4;
            const float4 x1 = *(const float4*)(X1 + (size_t)tok * 1024 + d);
            const float4 g = *(const float4*)(gate2 + d);
            const float4 nwv = *(const float4*)(nw + d);
            float4 o;
            o.x = x1.x + g.x * acc[4 * i + 0] * r * nwv.x;
            o.y = x1.y + g.y * acc[4 * i + 1] * r * nwv.y;
            o.z = x1.z + g.z * acc[4 * i + 2] * r * nwv.z;
            o.w = x1.w + g.w * acc[4 * i + 3] * r * nwv.w;
            *(float4*)(OUT + (size_t)tok * 1024 + d) = o;
        }
    }
}

__global__ void __launch_bounds__(NTHREADS) mega(Params p) {
    extern __shared__ __attribute__((aligned(16))) unsigned char lds[];
    cg::grid_group grid = cg::this_grid();
    unsigned char* ws = p.ws;
    const int tid = threadIdx.x, lane = tid & 63, w = tid >> 6;
    const int nb = gridDim.x, bid = blockIdx.x;
    float* MOD = (float*)(ws + OFF_MOD);
    bf16_t* HX = (bf16_t*)((unsigned char*)p.out + DO_HX);
    bf16_t* HC = (bf16_t*)((unsigned char*)p.out + DO_HC);
    bf16_t* PROJ1 = (bf16_t*)(ws + OFF_PROJ1);
    bf16_t* PROJC = (bf16_t*)(ws + OFF_PROJC);
    bf16_t* CKV = (bf16_t*)(ws + OFF_CKV);
    float* AB = (float*)(ws + OFF_AB);
    float* ABC = (float*)(ws + OFF_ABC);
    float* S5ST = (float*)(ws + OFF_S5ST);
    float* DNST = (float*)(ws + OFF_DNST);
    bf16_t* YF = (bf16_t*)(ws + OFF_YF);
    bf16_t* YB = (bf16_t*)(ws + OFF_YB);
    bf16_t* OF = (bf16_t*)(ws + OFF_OF);
    bf16_t* OB = (bf16_t*)(ws + OFF_OB);
    const bf16_t* WIN1 = (const bf16_t*)(ws + OFF_WIN1);
    const bf16_t* WIN2 = (const bf16_t*)(ws + OFF_WIN2);

#ifndef PROBE_PHASE
#define PROBE_PHASE -1
#endif
#define NREP(k) ((k) == PROBE_PHASE ? 2 : 1)
#define IN(k) (p.ph_lo <= (k) && (k) < p.ph_hi)
#define SEAM(k) do { if (rep_ + 1 == NREP(k) && (k) + 1 < p.ph_hi) grid.sync(); } while (0)

    if (IN(0)) for (int rep_ = 0; rep_ < NREP(0); ++rep_) {
        phase_adaln(p, MOD, lds);
        __syncthreads();
        phase_weights(p, lds);
        SEAM(0);
    }
    if (IN(1)) for (int rep_ = 0; rep_ < NREP(1); ++rep_) {
        modulate_rows(p.in[0], NT, TL, p.in[6], MOD, MOD + 1024, 6144, HX);
        modulate_rows(p.in[2], NC, TCX, p.in[6], MOD + 16 * 6144, MOD + 16 * 6144 + 1024, 0, HC);
        SEAM(1);
    }
    if (IN(2)) for (int rep_ = 0; rep_ < NREP(2); ++rep_) {
        const int ntl = 256 * 29, ntc = 32 * 21;
        for (int t = bid; t < ntl + ntc; t += nb) {
            if (t < ntl) {
                const int m = t / 29, n = t % 29;
                gemm_tile(HX, 1024, WIN1, 1024, 1024, m * 128, n * 128, lds, [=](int row, int col, float v) {
                    if (col < LD1) PROJ1[(size_t)row * LD1 + col] = f2bf(v);
                    else if (col < LD1 + 32) AB[(size_t)row * 32 + (col - LD1)] = v;
                });
            } else {
                const int tt = t - ntl;
                const int m = tt / 21, n = tt % 21;
                const int nrow = n < 20 ? n * 128 : 3584;
                gemm_tile(HC, 1024, WIN1, 1024, 1024, m * 128, nrow, lds, [=](int row, int col, float v) {
                    if (col < LDC) PROJC[(size_t)row * LDC + col] = f2bf(v);
                    else if (col >= 3584 && col < 3584 + 32) ABC[(size_t)row * 32 + (col - 3584)] = v;
                });
            }
        }
        SEAM(2);
    }
    if (IN(3)) for (int rep_ = 0; rep_ < NREP(3); ++rep_) {
        const float* cw = p.in[21];
        const int nlat = NB * 32 * 3 * 8, nctx = NB * 4 * 2 * 8;
        for (int it = bid; it < nlat + nctx; it += nb) {
            if (it < nlat) {
                const int head = it & 7, type = (it >> 3) % 3, br = it / 24;
                const int scol = (type == 0 ? 512 : (type == 1 ? 1536 : 2560)) + head * 128;
                conv_tile(PROJ1, LD1, br * 64, false, false, scol, PROJ1, LD1, scol, cw, type * 1024 + head * 128,
                          type != 1, type == 2 ? 0.08838834764831845f : 1.f, lds);
            } else {
                const int i2 = it - nlat;
                const int head = i2 & 7, type = (i2 >> 3) & 1, bt = i2 >> 4;
                const int tt = bt & 3;
                const int scol = (type == 0 ? 512 : 1536) + head * 128;
                conv_tile(PROJC, LDC, bt * 64, tt > 0, tt < 3, scol, CKV, 2048, type * 1024 + head * 128, cw, type * 1024 + head * 128,
                          type == 0, 1.f, lds);
            }
        }
        SEAM(3);
    }
    if (IN(4)) for (int rep_ = 0; rep_ < NREP(4); ++rep_) {
        for (int u = bid; u < 256; u += nb) {
            const int dir = u & 1, head = (u >> 1) & 7, b = u >> 4;
            dn_seq<false>(p, CKV + head * 128, CKV + 1024 + head * 128, nullptr, 2048, ABC, b * TCX, TCX, head, dir, nullptr,
                   DNST + (size_t)u * 128 * 128, nullptr, lds);
        }
        for (int u = w * nb + bid; u < 512; u += nb * 8) {
            const int dir = u & 1, g = (u >> 1) & 31, bp = u >> 6;
            s5_mfma<false>(p, PROJC, LDC, TCX, bp, g, dir, nullptr, S5ST, nullptr, lds + w * 9728);
        }
        SEAM(4);
    }
    if (IN(5)) for (int rep_ = 0; rep_ < NREP(5); ++rep_) {
        for (int u = bid; u < 256; u += nb) {
            const int dir = u & 1, head = (u >> 1) & 7, b = u >> 4;
            dn_seq<true>(p, PROJ1 + 512 + head * 128, PROJ1 + 1536 + head * 128, PROJ1 + 2560 + head * 128, LD1, AB, b * TL, TL, head, dir,
                   DNST + (size_t)u * 128 * 128, nullptr, dir ? OB : OF, lds);
        }
        __syncthreads();
        for (int u = w * nb + bid; u < 512; u += nb * 8) {
            const int dir = u & 1, g = (u >> 1) & 31, bp = u >> 6;
            s5_mfma<true>(p, PROJ1, LD1, TL, bp, g, dir, S5ST, nullptr, dir ? YB : YF, lds + w * 9728);
        }
        SEAM(5);
    }
    bf16_t* PROJ2 = (bf16_t*)(ws + OFF_PROJ2);
    bf16_t* Y5 = (bf16_t*)(ws + OFF_Y5);
    if (IN(6)) for (int rep_ = 0; rep_ < NREP(6); ++rep_) {
        for (int t = bid; t < 256 * 24; t += nb) {
            const int m = t / 24, n = t % 24;
            gemm_tile(HX, 1024, WIN2, 1024, 1024, m * 128, n * 128, lds, [=](int row, int col, float v) {
                PROJ2[(size_t)row * LD2 + col] = f2bf(v);
            });
        }
        for (size_t i = (size_t)bid * NTHREADS + tid; i < (size_t)NT * 512 / 2; i += (size_t)nb * NTHREADS) {
            const unsigned a = ((const unsigned*)YF)[i], b2 = ((const unsigned*)YB)[i];
            const float y0 = __uint_as_float(a << 16) + __uint_as_float(b2 << 16);
            const float y1 = __uint_as_float(a & 0xffff0000u) + __uint_as_float(b2 & 0xffff0000u);
            ((unsigned*)Y5)[i] = pack2(gelu_(y0), gelu_(y1));
        }
        convert_table(p.in[30], (bf16_t*)(ws + OFF_UT), (size_t)16384 * 1024);
        convert_table(p.in[31], (bf16_t*)(ws + OFF_VT), (size_t)16384 * 1024);
        SEAM(6);
    }
    bf16_t* Y5G = (bf16_t*)(ws + OFF_Y5G);
    bf16_t* YDN = (bf16_t*)(ws + OFF_YDN);
    if (IN(7)) for (int rep_ = 0; rep_ < NREP(7); ++rep_) {
        const bf16_t* GLUW = (const bf16_t*)(ws + OFF_GLU);
        const float* glub = p.in[20];
        for (int t = bid; t < 256 * 4; t += nb) {
            const int m = t / 4, n = t % 4;
            gemm_tile(Y5, 512, GLUW, 512, 512, m * 128, n * 128, lds, [=](int row, int col, float v) {
                const float y = bf2f(Y5[(size_t)row * 512 + col]);
                Y5G[(size_t)row * 512 + col] = f2bf(y * sigmoid_(v + glub[col]));
            });
        }
        const float* dnw = p.in[24];
        for (int tok = bid * 8 + w; tok < NT; tok += nb * 8) {
#pragma unroll
            for (int i = 0; i < 2; ++i) {
                const int col = i * 512 + lane * 8;
                const uint4 a = *(const uint4*)(OF + (size_t)tok * 1024 + col);
                const uint4 b2 = *(const uint4*)(OB + (size_t)tok * 1024 + col);
                const uint4 zz = *(const uint4*)(PROJ2 + (size_t)tok * LD2 + col);
                float o[8], z[8];
                o[0] = __uint_as_float(a.x << 16) + __uint_as_float(b2.x << 16); o[1] = __uint_as_float(a.x & 0xffff0000u) + __uint_as_float(b2.x & 0xffff0000u);
                o[2] = __uint_as_float(a.y << 16) + __uint_as_float(b2.y << 16); o[3] = __uint_as_float(a.y & 0xffff0000u) + __uint_as_float(b2.y & 0xffff0000u);
                o[4] = __uint_as_float(a.z << 16) + __uint_as_float(b2.z << 16); o[5] = __uint_as_float(a.z & 0xffff0000u) + __uint_as_float(b2.z & 0xffff0000u);
                o[6] = __uint_as_float(a.w << 16) + __uint_as_float(b2.w << 16); o[7] = __uint_as_float(a.w & 0xffff0000u) + __uint_as_float(b2.w & 0xffff0000u);
                z[0] = __uint_as_float(zz.x << 16); z[1] = __uint_as_float(zz.x & 0xffff0000u);
                z[2] = __uint_as_float(zz.y << 16); z[3] = __uint_as_float(zz.y & 0xffff0000u);
                z[4] = __uint_as_float(zz.z << 16); z[5] = __uint_as_float(zz.z & 0xffff0000u);
                z[6] = __uint_as_float(zz.w << 16); z[7] = __uint_as_float(zz.w & 0xffff0000u);
                float ss = 0.f;
#pragma unroll
                for (int c = 0; c < 8; ++c) ss += o[c] * o[c];
                ss += __shfl_xor(ss, 1); ss += __shfl_xor(ss, 2); ss += __shfl_xor(ss, 4); ss += __shfl_xor(ss, 8);
                const float r = rsqrtf(ss * (1.f / 128.f) + 1e-6f);
                float y[8];
#pragma unroll
                for (int c = 0; c < 8; ++c) y[c] = o[c] * r * dnw[(lane & 15) * 8 + c] * silu_(z[c]);
                uint4 ov;
                ov.x = pack2(y[0], y[1]); ov.y = pack2(y[2], y[3]); ov.z = pack2(y[4], y[5]); ov.w = pack2(y[6], y[7]);
                *(uint4*)(YDN + (size_t)tok * 1024 + col) = ov;
            }
        }
        SEAM(7);
    }
    bf16_t* MERGED = (bf16_t*)(ws + OFF_MERGED);
    if (IN(8)) for (int rep_ = 0; rep_ < NREP(8); ++rep_) {
        const bf16_t* WB5 = (const bf16_t*)(ws + OFF_WB5);
        const bf16_t* WBDN = (const bf16_t*)(ws + OFF_WBDN);
        for (int t = bid; t < 256 * 8; t += nb) {
            const int m = t / 8, n = t % 8;
            gemm_tile(Y5G, 512, WB5, 512, 512, m * 128, n * 128, lds, [=](int row, int col, float v) {
                const float g5 = bf2f(PROJ2[(size_t)row * LD2 + 1024 + col]);
                MERGED[(size_t)row * 1024 + col] = f2bf(sigmoid_(g5) * v);
            });
            gemm_tile(YDN, 1024, WBDN, 1024, 1024, m * 128, n * 128, lds, [=](int row, int col, float v) {
                const float gd = bf2f(PROJ2[(size_t)row * LD2 + 2048 + col]);
                const float prev = bf2f(MERGED[(size_t)row * 1024 + col]);
                MERGED[(size_t)row * 1024 + col] = f2bf(prev + sigmoid_(gd) * v);
            });
        }
        SEAM(8);
    }
    float* XMIX = p.out;
    if (IN(9)) for (int rep_ = 0; rep_ < NREP(9); ++rep_) {
        const bf16_t* WOUT = (const bf16_t*)(ws + OFF_WOUT);
        for (int t = bid; t < 256 * 8; t += nb) {
            const int m = t / 8, n = t % 8;
            gemm_tile(MERGED, 1024, WOUT, 1024, 1024, m * 128, n * 128, lds, [=](int row, int col, float v) {
                XMIX[(size_t)row * 1024 + col] = v;
            });
        }
        SEAM(9);
    }
    float* X1 = (float*)(ws + OFF_X1);
    bf16_t* HX2 = (bf16_t*)(ws + OFF_HX2);
    if (IN(10)) for (int rep_ = 0; rep_ < NREP(10); ++rep_) {
        const float* x = p.in[0];
        const float* npm = p.in[7];
        const float* npf = p.in[8];
        for (int row = bid * 8 + w; row < NT; row += nb * 8) {
            const int b = row / TL;
            const float* mb = MOD + (size_t)b * 6144;
            float4 xm[4];
            float ss = 0.f;
#pragma unroll
            for (int i = 0; i < 4; ++i) {
                xm[i] = *(const float4*)(XMIX + (size_t)row * 1024 + lane * 4 + 256 * i);
                ss += xm[i].x * xm[i].x + xm[i].y * xm[i].y + xm[i].z * xm[i].z + xm[i].w * xm[i].w;
            }
            ss = wave_sum(ss);
            const float r = rsqrtf(ss * (1.f / 1024.f) + 1e-6f);
            float4 x1[4];
            float s2 = 0.f;
#pragma unroll
            for (int i = 0; i < 4; ++i) {
                const int d = lane * 4 + 256 * i;
                const float4 xv = *(const float4*)(x + (size_t)row * 1024 + d);
                const float4 g = *(const float4*)(mb + 2 * 1024 + d);
                const float4 nw = *(const float4*)(npm + d);
                x1[i].x = xv.x + g.x * xm[i].x * r * nw.x;
                x1[i].y = xv.y + g.y * xm[i].y * r * nw.y;
                x1[i].z = xv.z + g.z * xm[i].z * r * nw.z;
                x1[i].w = xv.w + g.w * xm[i].w * r * nw.w;
                s2 += x1[i].x * x1[i].x + x1[i].y * x1[i].y + x1[i].z * x1[i].z + x1[i].w * x1[i].w;
                *(float4*)(X1 + (size_t)row * 1024 + d) = x1[i];
            }
            s2 = wave_sum(s2);
            const float r2 = rsqrtf(s2 * (1.f / 1024.f) + 1e-6f);
#pragma unroll
            for (int i = 0; i < 4; ++i) {
                const int d = lane * 4 + 256 * i;
                const float4 gn = *(const float4*)(npf + d);
                const float4 sh = *(const float4*)(mb + 3 * 1024 + d);
                const float4 scl = *(const float4*)(mb + 4 * 1024 + d);
                uint2 o;
                o.x = pack2(x1[i].x * r2 * gn.x * (1.f + scl.x) + sh.x, x1[i].y * r2 * gn.y * (1.f + scl.y) + sh.y);
                o.y = pack2(x1[i].z * r2 * gn.z * (1.f + scl.z) + sh.z, x1[i].w * r2 * gn.w * (1.f + scl.w) + sh.w);
                *(uint2*)(HX2 + (size_t)row * 1024 + d) = o;
            }
        }
        SEAM(10);
    }
    bf16_t* QP = (bf16_t*)(ws + OFF_QP);
    if (IN(11)) for (int rep_ = 0; rep_ < NREP(11); ++rep_) {
        const bf16_t* WQ = (const bf16_t*)(ws + OFF_WQ);
        for (int t = bid; t < 256 * 16; t += nb) {
            const int m = t / 16, n = t % 16;
            gemm_tile(HX2, 1024, WQ, 1024, 1024, m * 128, n * 128, lds, [=](int row, int col, float v) {
                QP[(size_t)row * 2048 + col] = f2bf(v);
            });
        }
        SEAM(11);
    }
    int* IDX = (int*)(ws + OFF_IDX);
    float* GATE = (float*)(ws + OFF_GATE);
    if (IN(12)) for (int rep_ = 0; rep_ < NREP(12); ++rep_) {
        phase_topk(p, QP, IDX, GATE, lds);
        SEAM(12);
    }
    if (IN(13)) for (int rep_ = 0; rep_ < NREP(13); ++rep_) {
        phase_peer(p, HX2, IDX, GATE, X1, MOD, p.out, (const bf16_t*)(ws + OFF_UT), (const bf16_t*)(ws + OFF_VT));
    }
}

constexpr int NPHASES = 14;

extern "C" void kernel_launch(void* const* d_in, const int* in_sizes, int n_in, void* d_out, int out_size, void* d_ws, size_t ws_size,
                              hipStream_t stream) {
    static int grid_blocks = 0;
    if (grid_blocks == 0) {
        if (n_in != 32 || ws_size < WS_END || out_size != NT * DM) {
            fprintf(stderr, "kernel_launch: unexpected sizes n_in=%d ws=%zu (need %zu) out=%d\n", n_in, ws_size, (size_t)WS_END, out_size);
            grid_blocks = -1;
            return;
        }
        int dev = 0, cus = 0, per_cu = 0;
        hipGetDevice(&dev);
        hipDeviceGetAttribute(&cus, hipDeviceAttributeMultiprocessorCount, dev);
        hipFuncSetAttribute((const void*)mega, hipFuncAttributeMaxDynamicSharedMemorySize, LDS_BYTES);
        hipOccupancyMaxActiveBlocksPerMultiprocessor(&per_cu, (const void*)mega, NTHREADS, LDS_BYTES);
        if (per_cu < 1) { fprintf(stderr, "kernel_launch: occupancy query says %d blocks/CU\n", per_cu); per_cu = 1; }
        grid_blocks = cus;
        fprintf(stderr, "kernel_launch: cus=%d per_cu=%d grid=%d ws=%zu need=%zu\n", cus, per_cu, grid_blocks, ws_size, (size_t)WS_END);
    }
    if (grid_blocks < 0) return;
    Params p{};
    for (int i = 0; i < 32; ++i) p.in[i] = (const float*)d_in[i];
    p.out = (float*)d_out;
    p.ws = (unsigned char*)d_ws;
    p.ph_lo = 0; p.ph_hi = NPHASES;
    void* args[] = {&p};
    hipError_t e = hipLaunchCooperativeKernel((const void*)mega, dim3(grid_blocks), dim3(NTHREADS), args, LDS_BYTES, stream);
    if (e != hipSuccess) fprintf(stderr, "cooperative launch failed: %s (grid %d)\n", hipGetErrorString(e), grid_blocks);
}
```

```cpp
#include <hip/hip_runtime.h>
#include <hip/hip_bf16.h>
#include <hip/hip_cooperative_groups.h>
#include <cstdio>
namespace cg = cooperative_groups;

typedef unsigned short bf16_t;
using bf16x8 = __attribute__((ext_vector_type(8))) short;
using f32x4 = __attribute__((ext_vector_type(4))) float;
typedef __bf16 bf16x2_t __attribute__((ext_vector_type(2)));
using f32x16 = __attribute__((ext_vector_type(16))) float;

#define DEVI __device__ __forceinline__

constexpr int NB = 16, TL = 2048, DM = 1024, NT = NB * TL, TCX = 256, NC = NB * TCX;
constexpr int LD1 = 3584;
constexpr int LDC = 2560;
constexpr int LD2 = 3072;
constexpr int W1ROWS = 3712;
constexpr int NTHREADS = 512;
constexpr int LDS_BYTES = 139264;

constexpr size_t al256(size_t x) { return (x + 255) & ~(size_t)255; }
constexpr size_t OFF_WIN1 = 0;
constexpr size_t OFF_WIN2 = OFF_WIN1 + al256((size_t)W1ROWS * 1024 * 2);
constexpr size_t OFF_GLU  = OFF_WIN2 + al256((size_t)3072 * 1024 * 2);
constexpr size_t OFF_WB5  = OFF_GLU + al256((size_t)512 * 512 * 2);
constexpr size_t OFF_WBDN = OFF_WB5 + al256((size_t)1024 * 512 * 2);
constexpr size_t OFF_WOUT = OFF_WBDN + al256((size_t)1024 * 1024 * 2);
constexpr size_t OFF_WQ   = OFF_WOUT + al256((size_t)1024 * 1024 * 2);
constexpr size_t OFF_MOD  = OFF_WQ + al256((size_t)2048 * 1024 * 2);
constexpr size_t OFF_AB   = OFF_MOD + al256((size_t)17 * 6144 * 4);
constexpr size_t OFF_ABC  = OFF_AB + al256((size_t)NT * 32 * 4);
constexpr size_t OFF_S5ST = OFF_ABC + al256((size_t)NC * 32 * 4);
constexpr size_t OFF_DNST = OFF_S5ST + al256((size_t)NB * 32 * 2 * 64 * 2 * 4);
constexpr size_t OFF_PROJC = OFF_DNST + al256((size_t)NB * 8 * 2 * 128 * 128 * 4);
constexpr size_t OFF_CKV  = OFF_PROJC + al256((size_t)NC * LDC * 2);
constexpr size_t OFF_YF   = OFF_CKV + al256((size_t)NC * 2048 * 2);
constexpr size_t OFF_YB   = OFF_YF + al256((size_t)NT * 512 * 2);
constexpr size_t OFF_OF   = OFF_YB + al256((size_t)NT * 512 * 2);
constexpr size_t OFF_OB   = OFF_OF + al256((size_t)NT * 1024 * 2);
constexpr size_t OFF_PROJ1 = OFF_OB + al256((size_t)NT * 1024 * 2);
constexpr size_t OFF_BAR  = OFF_PROJ1 + al256((size_t)NT * LD1 * 2);
constexpr size_t WS_END   = OFF_BAR + al256((size_t)3456 * 4);
constexpr size_t OFF_PROJ2 = OFF_PROJ1;
constexpr size_t OFF_X1   = OFF_PROJ1;
constexpr size_t OFF_HX2  = OFF_PROJ1 + al256((size_t)NT * 1024 * 4);
constexpr size_t OFF_Y5   = OFF_YF;
constexpr size_t OFF_Y5G  = OFF_YB;
constexpr size_t OFF_YDN  = OFF_OF;
constexpr size_t OFF_MERGED = OFF_OB;
constexpr size_t OFF_QP   = OFF_OF;
constexpr size_t OFF_IDX  = OFF_YF;
constexpr size_t OFF_GATE = OFF_YB;
constexpr size_t OFF_UT   = OFF_PROJC;
constexpr size_t OFF_VT   = OFF_PROJC;
static_assert(OFF_HX2 + (size_t)NT * 1024 * 2 <= OFF_BAR, "alias overflow");
static_assert(OFF_UT + (size_t)16384 * 1024 * 2 <= OFF_YF, "UT overflow");
static_assert(OFF_VT + (size_t)16384 * 1024 * 2 <= OFF_YF, "VT overflow");
static_assert((size_t)NT * 128 * 4 <= (size_t)NT * 512 * 2, "idx alias");
constexpr size_t DO_HX = 0;
constexpr size_t DO_HC = (size_t)NT * 1024 * 2;

struct Params {
    const float* in[32];
    float* out;
    unsigned char* ws;
    int ph_lo, ph_hi;
};

DEVI float bf2f(bf16_t v) { return __uint_as_float(((unsigned)v) << 16); }
typedef float f32x2_t __attribute__((ext_vector_type(2)));
DEVI unsigned pack2(float a, float b) {
    const f32x2_t v = {a, b};
    return __builtin_bit_cast(unsigned, __builtin_convertvector(v, bf16x2_t));
}
DEVI bf16_t f2bf(float f) { return (bf16_t)(pack2(f, 0.f) & 0xffffu); }
DEVI float sigmoid_(float x) { return 1.f / (1.f + __expf(-x)); }
DEVI float silu_(float x) { return x / (1.f + __expf(-x)); }
DEVI float gelu_(float x) {
    float u = 0.7978845608028654f * (x + 0.044715f * x * x * x);
    return 0.5f * x * (1.f + tanhf(u));
}
DEVI float softplus_(float x) { return x > 20.f ? x : log1pf(__expf(x)); }
DEVI float wave_sum(float v) {
#pragma unroll
    for (int m = 32; m >= 1; m >>= 1) v += __shfl_xor(v, m);
    return v;
}
DEVI float wave_max(float v) {
#pragma unroll
    for (int m = 32; m >= 1; m >>= 1) v = fmaxf(v, __shfl_xor(v, m));
    return v;
}
DEVI float readlane_f(float v, int l) { return __int_as_float(__builtin_amdgcn_readlane(__float_as_int(v), l)); }

template <class Epi>
DEVI void gemm_tile(const bf16_t* A, int lda, const bf16_t* Bt, int ldb, int K, int m0, int n0,
                    unsigned char* lds, Epi epi) {
    constexpr int ST = 144;
    unsigned char* As = lds;
    unsigned char* Bs = lds + 128 * ST;
    const int tid = threadIdx.x, lane = tid & 63, w = tid >> 6, wm = w >> 2, wn = w & 3;
    f32x4 acc[4][2];
#pragma unroll
    for (int mi = 0; mi < 4; ++mi)
#pragma unroll
        for (int ni = 0; ni < 2; ++ni) acc[mi][ni] = (f32x4){0.f, 0.f, 0.f, 0.f};
    uint4 ra0, ra1, rb0, rb1;
    const int nk = K >> 6;
    const int lrow0 = tid >> 3, lkc = (tid & 7) * 8;
    const bf16_t* Ap = A + (size_t)(m0 + lrow0) * lda + lkc;
    const bf16_t* Bp = Bt + (size_t)(n0 + lrow0) * ldb + lkc;
    const size_t a64 = (size_t)64 * lda, b64 = (size_t)64 * ldb;
    ra0 = *(const uint4*)(Ap); ra1 = *(const uint4*)(Ap + a64);
    rb0 = *(const uint4*)(Bp); rb1 = *(const uint4*)(Bp + b64);
    for (int kt = 0; kt < nk; ++kt) {
        __syncthreads();
        *(uint4*)(As + lrow0 * ST + lkc * 2) = ra0;
        *(uint4*)(As + (lrow0 + 64) * ST + lkc * 2) = ra1;
        *(uint4*)(Bs + lrow0 * ST + lkc * 2) = rb0;
        *(uint4*)(Bs + (lrow0 + 64) * ST + lkc * 2) = rb1;
        __syncthreads();
        if (kt + 1 < nk) {
            const int ko = (kt + 1) * 64;
            ra0 = *(const uint4*)(Ap + ko); ra1 = *(const uint4*)(Ap + a64 + ko);
            rb0 = *(const uint4*)(Bp + ko); rb1 = *(const uint4*)(Bp + b64 + ko);
        }
#pragma unroll
        for (int ks = 0; ks < 2; ++ks) {
            bf16x8 af[4], bfr[2];
            const int kb = (ks * 32 + 8 * (lane >> 4)) * 2;
#pragma unroll
            for (int mi = 0; mi < 4; ++mi) af[mi] = *(const bf16x8*)(As + (wm * 64 + mi * 16 + (lane & 15)) * ST + kb);
#pragma unroll
            for (int ni = 0; ni < 2; ++ni) bfr[ni] = *(const bf16x8*)(Bs + (wn * 32 + ni * 16 + (lane & 15)) * ST + kb);
#pragma unroll
            for (int mi = 0; mi < 4; ++mi)
#pragma unroll
                for (int ni = 0; ni < 2; ++ni)
                    acc[mi][ni] = __builtin_amdgcn_mfma_f32_16x16x32_bf16(af[mi], bfr[ni], acc[mi][ni], 0, 0, 0);
        }
    }
#pragma unroll
    for (int mi = 0; mi < 4; ++mi)
#pragma unroll
        for (int ni = 0; ni < 2; ++ni)
#pragma unroll
            for (int r = 0; r < 4; ++r) {
                const int row = m0 + wm * 64 + mi * 16 + (lane >> 4) * 4 + r;
                const int col = n0 + wn * 32 + ni * 16 + (lane & 15);
                epi(row, col, acc[mi][ni][r]);
                if (r == 3) __builtin_amdgcn_sched_barrier(0);
            }
    __syncthreads();
}

DEVI void phase_adaln(const Params& p, float* MOD, unsigned char* lds) {
    float* sc = (float*)lds;
    float* red = sc + 17 * 1024;
    const int tid = threadIdx.x;
    const float* c = p.in[1];
    const float* cctx = p.in[3];
    const float* w_mod = p.in[4];
    const float* b_mod = p.in[5];
    const int nab = (int)gridDim.x < 192 ? (int)gridDim.x : 192;
    if ((int)blockIdx.x >= nab) return;
    for (int i = tid; i < 17 * 1024; i += NTHREADS) {
        int r = i >> 10, d = i & 1023;
        float v = r < 16 ? c[r * 1024 + d] : cctx[d];
        sc[i] = silu_(v);
    }
    __syncthreads();
    for (int item = blockIdx.x; item < 192; item += nab) {
        const int cc = tid & 31, kg = tid >> 5;
        const int col = item * 32 + cc;
        float acc[17];
#pragma unroll
        for (int r = 0; r < 17; ++r) acc[r] = 0.f;
        for (int k8 = kg * 64; k8 < kg * 64 + 64; k8 += 8) {
            float wv[8];
#pragma unroll
            for (int u = 0; u < 8; ++u) wv[u] = w_mod[(size_t)(k8 + u) * 6144 + col];
#pragma unroll
            for (int u = 0; u < 8; ++u)
#pragma unroll
                for (int r = 0; r < 17; ++r) acc[r] += sc[r * 1024 + k8 + u] * wv[u];
        }
#pragma unroll
        for (int r = 0; r < 17; ++r) red[(kg * 17 + r) * 32 + cc] = acc[r];
        __syncthreads();
        for (int o = tid; o < 17 * 32; o += NTHREADS) {
            const int r = o >> 5, c2 = o & 31;
            float s = b_mod[item * 32 + c2];
            for (int g = 0; g < 16; ++g) s += red[(g * 17 + r) * 32 + c2];
            MOD[r * 6144 + item * 32 + c2] = s;
        }
        __syncthreads();
    }
}

DEVI void conv_seg(const float* src, int K, int ldsrc, int col0, int ncols, bf16_t* dst, int drow0, unsigned char* lds, int vb, int nvb) {
    float* tile = (float*)lds;
    const int tid = threadIdx.x;
    const int ntn = (ncols + 63) >> 6, ntk = K >> 6;
    const int r0 = tid >> 4, c4 = (tid & 15) * 4;
    float4 v0, v1;
    auto tload = [&](int t) {
        const int tn = t / ntk, tk = t % ntk;
        const int n0 = tn * 64, k0 = tk * 64;
        v0 = make_float4(0.f, 0.f, 0.f, 0.f); v1 = v0;
        if (n0 + c4 < ncols) {
            v0 = *(const float4*)(src + (size_t)(k0 + r0) * ldsrc + col0 + n0 + c4);
            v1 = *(const float4*)(src + (size_t)(k0 + r0 + 32) * ldsrc + col0 + n0 + c4);
        }
    };
    if (vb < ntn * ntk) tload(vb);
    for (int t = vb; t < ntn * ntk; t += nvb) {
        const int tn = t / ntk, tk = t % ntk;
        const int n0 = tn * 64, k0 = tk * 64;
        __syncthreads();
        tile[r0 * 65 + c4 + 0] = v0.x; tile[r0 * 65 + c4 + 1] = v0.y; tile[r0 * 65 + c4 + 2] = v0.z; tile[r0 * 65 + c4 + 3] = v0.w;
        tile[(r0 + 32) * 65 + c4 + 0] = v1.x; tile[(r0 + 32) * 65 + c4 + 1] = v1.y; tile[(r0 + 32) * 65 + c4 + 2] = v1.z; tile[(r0 + 32) * 65 + c4 + 3] = v1.w;
        __syncthreads();
        if (t + nvb < ntn * ntk) tload(t + nvb);
        {
            const int n = tid >> 3, kq = (tid & 7) * 8;
            if (n0 + n < ncols) {
                uint4 o;
                o.x = pack2(tile[(kq + 0) * 65 + n], tile[(kq + 1) * 65 + n]);
                o.y = pack2(tile[(kq + 2) * 65 + n], tile[(kq + 3) * 65 + n]);
                o.z = pack2(tile[(kq + 4) * 65 + n], tile[(kq + 5) * 65 + n]);
                o.w = pack2(tile[(kq + 6) * 65 + n], tile[(kq + 7) * 65 + n]);
                *(uint4*)(dst + (size_t)(drow0 + n0 + n) * K + k0 + kq) = o;
            }
        }
    }
    __syncthreads();
}

DEVI void phase_weights(const Params& p, unsigned char* lds) {
    unsigned char* ws = p.ws;
    bf16_t* WIN1 = (bf16_t*)(ws + OFF_WIN1);
    bf16_t* WIN2 = (bf16_t*)(ws + OFF_WIN2);
    const int nvb = gridDim.x;
    const int vb = ((int)blockIdx.x + nvb - 192 % nvb) % nvb;
    const float* w_in = p.in[10];
    conv_seg(w_in, 1024, 6688, 0, 2560, WIN1, 0, lds, vb, nvb);
    conv_seg(w_in, 1024, 6688, 2592, 1024, WIN1, 2560, lds, vb, nvb);
    conv_seg(w_in, 1024, 6688, 2560, 32, WIN1, 3584, lds, vb, nvb);
    conv_seg(w_in, 1024, 6688, 3616, 3072, WIN2, 0, lds, vb, nvb);
    conv_seg(p.in[19], 512, 512, 0, 512, (bf16_t*)(ws + OFF_GLU), 0, lds, vb, nvb);
    conv_seg(p.in[25], 512, 1024, 0, 1024, (bf16_t*)(ws + OFF_WB5), 0, lds, vb, nvb);
    conv_seg(p.in[26], 1024, 1024, 0, 1024, (bf16_t*)(ws + OFF_WBDN), 0, lds, vb, nvb);
    conv_seg(p.in[27], 1024, 1024, 0, 1024, (bf16_t*)(ws + OFF_WOUT), 0, lds, vb, nvb);
    conv_seg(p.in[28], 1024, 2048, 0, 2048, (bf16_t*)(ws + OFF_WQ), 0, lds, vb, nvb);
    {
        uint4* z = (uint4*)(WIN1 + (size_t)3616 * 1024);
        const int n16 = 96 * 1024 * 2 / 16;
        for (int i = vb * NTHREADS + threadIdx.x; i < n16; i += nvb * NTHREADS) z[i] = make_uint4(0, 0, 0, 0);
    }
}

template <int RUN>
DEVI void modulate_rows(const float* X, int nrows, int rows_per_batch, const float* gain, const float* shift0, const float* scale0,
                        int bstride, bf16_t* OUT) {
    const int lane = threadIdx.x & 63, w = threadIdx.x >> 6;
    for (int run = blockIdx.x * 8 + w; run < nrows / RUN; run += gridDim.x * 8) {
        const int row0 = run * RUN;
        const int b = row0 / rows_per_batch;
        const float* sh = shift0 + (size_t)b * bstride;
        const float* scl = scale0 + (size_t)b * bstride;
        float4 c1[4], c2[4];
#pragma unroll
        for (int i = 0; i < 4; ++i) {
            const int d = lane * 4 + 256 * i;
            const float4 g = *(const float4*)(gain + d), s = *(const float4*)(scl + d);
            c1[i] = make_float4(g.x * (1.f + s.x), g.y * (1.f + s.y), g.z * (1.f + s.z), g.w * (1.f + s.w));
            c2[i] = *(const float4*)(sh + d);
        }
        float4 nv[4];
#pragma unroll
        for (int i = 0; i < 4; ++i) nv[i] = *(const float4*)(X + (size_t)row0 * 1024 + lane * 4 + 256 * i);
#pragma unroll 1
        for (int rr = 0; rr < RUN; ++rr) {
            const int row = row0 + rr;
            float4 v[4];
            float ss = 0.f;
#pragma unroll
            for (int i = 0; i < 4; ++i) {
                v[i] = nv[i];
                ss += v[i].x * v[i].x + v[i].y * v[i].y + v[i].z * v[i].z + v[i].w * v[i].w;
            }
            if (rr + 1 < RUN) {
#pragma unroll
                for (int i = 0; i < 4; ++i) nv[i] = *(const float4*)(X + (size_t)(row + 1) * 1024 + lane * 4 + 256 * i);
            }
            ss = wave_sum(ss);
            const float r = rsqrtf(ss * (1.f / 1024.f) + 1e-6f);
#pragma unroll
            for (int i = 0; i < 4; ++i) {
                const int d = lane * 4 + 256 * i;
                uint2 o;
                o.x = pack2(v[i].x * r * c1[i].x + c2[i].x, v[i].y * r * c1[i].y + c2[i].y);
                o.y = pack2(v[i].z * r * c1[i].z + c2[i].z, v[i].w * r * c1[i].w + c2[i].w);
                *(uint2*)(OUT + (size_t)row * 1024 + d) = o;
            }
        }
    }
}


template <bool READOUT>
DEVI void s5_mfma(const Params& p, const bf16_t* U, int ldu, int Tlen, int bp, int g, int dir,
                  const float* S5in, float* S5out, bf16_t* Y, unsigned char* wl  ) {
    constexpr int HST = 272;
    unsigned char* Himg = wl;
    const int lane = threadIdx.x & 63;
    const int p0 = lane & 31, hf = lane >> 5;
    const int dg = dir * 32 + g;
    const float step = expf(p.in[13][dg]);
    float ar[2], ai[2], hr[2], hi[2];
    bf16x8 Bf[4];
#pragma unroll
    for (int pt = 0; pt < 2; ++pt) {
        const int pp = dg * 64 + pt * 32 + p0;
        const float lr = p.in[11][pp], li = p.in[12][pp];
        const float mag = expf(lr * step);
        ar[pt] = mag * cosf(li * step); ai[pt] = mag * sinf(li * step);
        const float den = lr * lr + li * li;
        const float fr = ((ar[pt] - 1.f) * lr + ai[pt] * li) / den;
        const float fi = (ai[pt] * lr - (ar[pt] - 1.f) * li) / den;
        bf16x8 bre, bim;
#pragma unroll
        for (int j = 0; j < 8; ++j) {
            const float br = p.in[14][pp * 16 + 8 * hf + j], bi = p.in[15][pp * 16 + 8 * hf + j];
            bre[j] = (short)f2bf(fr * br - fi * bi);
            bim[j] = (short)f2bf(fr * bi + fi * br);
        }
        Bf[pt] = bre; Bf[2 + pt] = bim;
        hr[pt] = 0.f; hi[pt] = 0.f;
    }
    const int myb = 2 * bp + hf;
    if (S5in) {
        const float* h0 = S5in + (size_t)((myb * 32 + g) * 2 + dir) * 128;
#pragma unroll
        for (int pt = 0; pt < 2; ++pt) { hr[pt] = h0[pt * 32 + p0]; hi[pt] = h0[64 + pt * 32 + p0]; }
    }
    bf16x8 Cf[4], Df;
    if (READOUT) {
        const int h = lane & 15, kq = lane >> 4;
#pragma unroll
        for (int ks = 0; ks < 4; ++ks) {
            bf16x8 c;
#pragma unroll
            for (int j = 0; j < 8; ++j) {
                const int pl = ks * 8 + 2 * kq + (j >> 2), tile = j & 3;
                const int pidx = (dg * 16 + h) * 64 + (tile & 1) * 32 + pl;
                const float v = (tile < 2) ? p.in[16][pidx] : -p.in[17][pidx];
                c[j] = (short)f2bf(v);
            }
            Cf[ks] = c;
        }
#pragma unroll
        for (int j = 0; j < 8; ++j) {
            const int k = 8 * kq + j;
            Df[j] = (short)((k == h) ? f2bf(p.in[18][g * 16 + h]) : (bf16_t)0);
        }
    }
    const int m = lane & 31, kh = lane >> 5;
    const int ahf = (m >> 2) & 1, ai_tok = (m & 3) + 4 * (m >> 3);
    const int ab = 2 * bp + ahf;
    const int nblk = Tlen >> 4;
    const bf16_t* Ubase = U + (size_t)ab * Tlen * ldu + g * 16 + 8 * kh;
    auto tok_of = [&](int blk, int i) -> int {
        const int t0 = dir ? (Tlen - 16 * (blk + 1)) : 16 * blk;
        return dir ? (t0 + 15 - i) : (t0 + i);
    };
    constexpr int BUFB = 32 * HST + 1024;
    unsigned char* Yimg = Himg + 2 * BUFB;
    f32x16 X[4];
    auto issue_x = [&](const uint4& acur, int buf) {
        const bf16x8 af = __builtin_bit_cast(bf16x8, acur);
#pragma unroll
        for (int t = 0; t < 4; ++t) {
            f32x16 z;
#pragma unroll
            for (int r = 0; r < 16; ++r) z[r] = 0.f;
            X[t] = __builtin_amdgcn_mfma_f32_32x32x16_bf16(af, Bf[t], z, 0, 0, 0);
        }
        if (READOUT && dir == 0) *(uint4*)(Himg + buf * BUFB + 32 * HST + (ahf * 16 + ai_tok) * 32 + kh * 16) = acur;
    };
    auto scan_x = [&](int buf) {
        unsigned char* Hb = Himg + buf * BUFB;
#pragma unroll
        for (int r = 0; r < 16; ++r) {
            float v4[4];
#pragma unroll
            for (int pt = 0; pt < 2; ++pt) {
                float nr = fmaf(ar[pt], hr[pt], fmaf(-ai[pt], hi[pt], X[pt][r]));
                asm volatile("" : "+v"(nr));
                float ni = fmaf(ar[pt], hi[pt], fmaf(ai[pt], hr[pt], X[2 + pt][r]));
                asm volatile("" : "+v"(ni));
                hr[pt] = nr; hi[pt] = ni;
                v4[pt] = nr; v4[2 + pt] = ni;
            }
            if (READOUT) {
                uint2 o;
                o.x = pack2(v4[0], v4[1]);
                o.y = pack2(v4[2], v4[3]);
                *(uint2*)(Hb + (hf * 16 + r) * HST + p0 * 8) = o;
            }
        }
    };
    uint4 anext = *(const uint4*)(Ubase + (size_t)tok_of(0, ai_tok) * ldu);
    {
        const uint4 a0 = anext;
        if (nblk > 1) anext = *(const uint4*)(Ubase + (size_t)tok_of(1, ai_tok) * ldu);
        issue_x(a0, 0);
        scan_x(0);
    }
    for (int blk = 0; blk < nblk; ++blk) {
        const int buf = blk & 1;
        if (blk + 1 < nblk) {
            const uint4 acur = anext;
            if (blk + 2 < nblk) anext = *(const uint4*)(Ubase + (size_t)tok_of(blk + 2, ai_tok) * ldu);
            issue_x(acur, buf ^ 1);
        }
        f32x4 yacc[2];
        if (READOUT) {
            const int kq = lane >> 4;
            const unsigned char* Hb = Himg + buf * BUFB;
#pragma unroll
            for (int hb = 0; hb < 2; ++hb) {
                yacc[hb] = (f32x4){0.f, 0.f, 0.f, 0.f};
#pragma unroll
                for (int ks = 0; ks < 4; ++ks) {
                    const bf16x8 hfrag = *(const bf16x8*)(Hb + (hb * 16 + (lane & 15)) * HST + (ks * 32 + 8 * kq) * 2);
                    yacc[hb] = __builtin_amdgcn_mfma_f32_16x16x32_bf16(hfrag, Cf[ks], yacc[hb], 0, 0, 0);
                }
                if (dir == 0) {
                    uint4 uu = make_uint4(0, 0, 0, 0);
                    if (kq < 2) uu = *(const uint4*)(Hb + 32 * HST + (hb * 16 + (lane & 15)) * 32 + kq * 16);
                    yacc[hb] = __builtin_amdgcn_mfma_f32_16x16x32_bf16(__builtin_bit_cast(bf16x8, uu), Df, yacc[hb], 0, 0, 0);
                }
            }
        }
        if (blk + 1 < nblk) scan_x(buf ^ 1);
        if (READOUT) {
            const int h = lane & 15, kq = lane >> 4;
#pragma unroll
            for (int hb = 0; hb < 2; ++hb)
#pragma unroll
                for (int r = 0; r < 4; ++r) *(unsigned short*)(Yimg + (hb * 16 + 4 * kq + r) * 32 + 2 * h) = f2bf(yacc[hb][r]);
            const int row = lane >> 1, half = lane & 1;
            const uint4 ov = *(const uint4*)(Yimg + row * 32 + half * 16);
            const int ob = 2 * bp + (row >> 4);
            const int tok = tok_of(blk, row & 15);
            *(uint4*)(Y + ((size_t)ob * Tlen + tok) * 512 + g * 16 + 8 * half) = ov;
        }
    }
    if (S5out) {
        float* ho = S5out + (size_t)((myb * 32 + g) * 2 + dir) * 128;
#pragma unroll
        for (int pt = 0; pt < 2; ++pt) { ho[pt * 32 + p0] = hr[pt]; ho[64 + pt * 32 + p0] = hi[pt]; }
    }
}

template <int CTRL>
DEVI float dpp_add(float v) {
    const int iv = __float_as_int(v);
    const int r = __builtin_amdgcn_update_dpp(0, iv, CTRL, 0xf, 0xf, true);
    return v + __int_as_float(r);
}
DEVI float red8(float v) {
    v = dpp_add<0xB1>(v);
    v = dpp_add<0x4E>(v);
    v = dpp_add<0x141>(v);
    return v;
}

#ifndef DN_DUP
#define DN_DUP -1
#endif
typedef short s16x4 __attribute__((ext_vector_type(4)));
DEVI int pos32(int x) { return ((x >> 2) & 3) * 8 + (x >> 4) * 4 + (x & 3); }
DEVI unsigned cvtpk(float lo, float hi) { return pack2(lo, hi); }
DEVI s16x4 cvt4(const f32x4& v) { uint2 t; t.x = cvtpk(v[0], v[1]); t.y = cvtpk(v[2], v[3]); return __builtin_bit_cast(s16x4, t); }
DEVI bf16x8 cvt8(const f32x4& a, const f32x4& b) { uint4 t; t.x = cvtpk(a[0], a[1]); t.y = cvtpk(a[2], a[3]); t.z = cvtpk(b[0], b[1]); t.w = cvtpk(b[2], b[3]); return __builtin_bit_cast(bf16x8, t); }
DEVI f32x4 mfma16(const s16x4& a, const s16x4& b, const f32x4& c) { return __builtin_amdgcn_mfma_f32_16x16x16bf16_1k(a, b, c, 0, 0, 0); }
DEVI f32x4 mfma32(const bf16x8& a, const bf16x8& b, const f32x4& c) { return __builtin_amdgcn_mfma_f32_16x16x32_bf16(a, b, c, 0, 0, 0); }

DEVI s16x4 lds_tr_read(const unsigned char* p) { return __builtin_amdgcn_ds_read_tr16_b64_v4i16((__attribute__((address_space(3))) s16x4*)p); }
DEVI void lds_barrier() { asm volatile("s_waitcnt lgkmcnt(0)" ::: "memory"); __builtin_amdgcn_s_barrier(); asm volatile("" ::: "memory"); }
template <bool HAS_Q>
DEVI void dn_chunked(const Params& p, const bf16_t* Kg, const bf16_t* Vg, const bf16_t* Qg, int ld, const float* AB, int tokbase, int Tlen,
                     int head, int dir, const float* S0, float* Sout, bf16_t* O, unsigned char* lds) {
    constexpr int RS = 272, TS = 144, BS = 40;
    constexpr int KP_OFF = 0, QP_OFF = 17408, WP_OFF = 34816, KT_OFF = 52224, VT_OFF = 70656, AT_OFF = 89088, AB_OFF = 98304,
                  AF_OFF = 107520, TN_OFF = 111872, TSW_OFF = 114432, TSU_OFF = 116992, GT_OFF = 119552, OT_OFF = 120848;
    float* gt = (float*)(lds + GT_OFF);
    const int tid = threadIdx.x, lane = tid & 63, w = tid >> 6;
    const int m = lane & 15, q = lane >> 4;
    f32x4 S[8];
#pragma unroll
    for (int mt = 0; mt < 8; ++mt) {
        if (S0) {
#pragma unroll
            for (int r = 0; r < 4; ++r) S[mt][r] = S0[(size_t)(16 * mt + 4 * q + r) * 128 + 16 * w + m];
        } else S[mt] = (f32x4){0.f, 0.f, 0.f, 0.f};
    }
    const float aexp = expf(p.in[22][dir * 8 + head]);
    const float dtb = p.in[23][dir * 8 + head];
    const int nch = Tlen >> 6;
    uint4 rk0, rk1, rq0, rq1, rv0, rv1; float rg = 0.f, rb = 0.f;
    rq0 = make_uint4(0, 0, 0, 0); rq1 = rq0;
    auto gload = [&](int ci) {
        const int cb = dir ? (nch - 1 - ci) : ci;
        const size_t tok = (size_t)(tokbase + cb * 64 + (dir ? (63 - lane) : lane));
        const bf16_t* kp = Kg + tok * ld + 16 * w;
        const bf16_t* vp = Vg + tok * ld + 16 * w;
        rk0 = *(const uint4*)kp; rk1 = *(const uint4*)(kp + 8);
        rv0 = *(const uint4*)vp; rv1 = *(const uint4*)(vp + 8);
        if (HAS_Q) { const bf16_t* qp = Qg + tok * ld + 16 * w; rq0 = *(const uint4*)qp; rq1 = *(const uint4*)(qp + 8); }
        if (w == 0) { rg = AB[tok * 32 + (2 * dir) * 8 + head]; rb = AB[tok * 32 + (2 * dir + 1) * 8 + head]; }
    };
    gload(0);
    for (int ci = 0; ci < nch; ++ci) {
        for (int dup0_ = 0; dup0_ < (DN_DUP == 0 ? 2 : 1); ++dup0_)
        {
            const int Bk = w >> 1, tk = w & 1;
            unsigned char* kr = lds + KP_OFF + lane * RS + 2 * (32 * Bk + 4 * tk);
            *(uint2*)(kr + 0)  = make_uint2(rk0.x, rk0.y);
            *(uint2*)(kr + 16) = make_uint2(rk0.z, rk0.w);
            *(uint2*)(kr + 32) = make_uint2(rk1.x, rk1.y);
            *(uint2*)(kr + 48) = make_uint2(rk1.z, rk1.w);
            if (HAS_Q) {
                unsigned char* qr = lds + QP_OFF + lane * RS + 2 * (32 * Bk + 4 * tk);
                *(uint2*)(qr + 0)  = make_uint2(rq0.x, rq0.y);
                *(uint2*)(qr + 16) = make_uint2(rq0.z, rq0.w);
                *(uint2*)(qr + 32) = make_uint2(rq1.x, rq1.y);
                *(uint2*)(qr + 48) = make_uint2(rq1.z, rq1.w);
            }
            {
                unsigned char* vr = lds + VT_OFF + lane * RS + 32 * w;
                *(uint4*)(vr) = rv0; *(uint4*)(vr + 16) = rv1;
            }
            if (w == 0) {
                float g = -aexp * softplus_(rg + dtb);
#pragma unroll
                for (int d = 1; d < 64; d <<= 1) { const float t = __shfl_up(g, d); if (lane >= d) g += t; }
                const float glast = __shfl(g, 63);
                const float beta = sigmoid_(rb), eg = __expf(g);
                gt[lane] = g; gt[64 + lane] = eg; gt[128 + lane] = beta; gt[192 + lane] = __expf(glast - g); gt[256 + lane] = beta * eg;
                if (lane == 0) gt[320] = __expf(glast);
            }
        }
        if (ci + 1 < nch) gload(ci + 1);
        lds_barrier();
        auto gram_job = [&](int type, int t10) {
            const int ct = (t10 >= 6) ? 3 : (t10 >= 3) ? 2 : (t10 >= 1) ? 1 : 0;
            const int st = t10 - ct * (ct + 1) / 2;
            const unsigned char* xa = lds + (type ? QP_OFF : KP_OFF) + (16 * ct + m) * RS + 16 * q;
            const unsigned char* xb = lds + KP_OFF + (16 * st + m) * RS + 16 * q;
            bf16x8 fa[4], fb[4];
#pragma unroll
            for (int B = 0; B < 4; ++B) { fa[B] = *(const bf16x8*)(xa + 64 * B); fb[B] = *(const bf16x8*)(xb + 64 * B); }
            f32x4 acc = (f32x4){0.f, 0.f, 0.f, 0.f};
#pragma unroll
            for (int B = 0; B < 4; ++B) acc = mfma32(fa[B], fb[B], acc);
            const int sidx = 16 * st + m;
            const float gs = gt[sidx];
#pragma unroll
            for (int r = 0; r < 4; ++r) {
                const int c = 16 * ct + 4 * q + r;
                const float dec = __expf(fminf(gt[c] - gs, 0.f));
                if (type == 0) {
                    const float a = (sidx < c) ? gt[128 + c] * acc[r] * dec : 0.f;
                    *(unsigned short*)(lds + AB_OFF + c * TS + 2 * sidx) = f2bf(a);
                    if (ct == st) *(float*)(lds + AF_OFF + ((ct * 16 + (c & 15)) * 17 + m) * 4) = a;
                } else {
                    const float a = (sidx <= c) ? acc[r] * dec : 0.f;
                    *(unsigned short*)(lds + AT_OFF + c * TS + 2 * (32 * (sidx >> 5) + pos32(sidx & 31))) = f2bf(a);
                }
            }
        };
        for (int dup1_ = 0; dup1_ < (DN_DUP == 1 ? 2 : 1); ++dup1_) for (int j = w; j < 10; j += 8) gram_job(0, j);
        lds_barrier();
        if (w == 0) for (int dup2_ = 0; dup2_ < (DN_DUP == 2 ? 2 : 1); ++dup2_) {
            const int r = q, col = m;
            const float* af = (const float*)(lds + AF_OFF) + r * 16 * 17;
            float t[16];
#pragma unroll
            for (int i = 0; i < 16; ++i) t[i] = (i == col) ? 1.f : 0.f;
#pragma unroll
            for (int jj = 0; jj < 15; ++jj) {
#pragma unroll
                for (int i = jj + 1; i < 16; ++i) t[i] -= af[i * 17 + jj] * t[jj];
                if ((jj & 1) == 1) __builtin_amdgcn_sched_barrier(0);
            }
            const float sw = gt[256 + 16 * r + col], su = gt[128 + 16 * r + col];
#pragma unroll
            for (int i = 0; i < 16; ++i) {
                *(unsigned short*)(lds + TN_OFF + (r * 16 + i) * BS + 2 * col) = f2bf(-t[i]);
                *(unsigned short*)(lds + TSW_OFF + (r * 16 + i) * BS + 2 * col) = f2bf(t[i] * sw);
                *(unsigned short*)(lds + TSU_OFF + (r * 16 + i) * BS + 2 * col) = f2bf(t[i] * su);
            }
        } else if (HAS_Q) {
            for (int j = w - 1; j < 10; j += 7) gram_job(1, j);
            for (int idx = tid - 64; idx < 6 * 256; idx += NTHREADS - 64) {
                const int tile = idx >> 8, e = idx & 255;
                const int ct = (tile < 3) ? 0 : (tile < 5) ? 1 : 2;
                const int st = (tile < 3) ? tile + 1 : (tile < 5) ? tile - 1 : 3;
                const int c = 16 * ct + (e >> 4), sidx = 16 * st + (e & 15);
                *(unsigned short*)(lds + AT_OFF + c * TS + 2 * (32 * (sidx >> 5) + pos32(sidx & 31))) = 0;
            }
        }
        lds_barrier();
        f32x4 vn[4];
        for (int dup3_ = 0; dup3_ < (DN_DUP == 3 ? 2 : 1); ++dup3_) {
            const int tq = (lane & 15) >> 2, tp = lane & 3;
            const unsigned char* xtk = lds + KP_OFF + (4 * q + tq) * RS + 2 * (32 * (w >> 1) + 8 * tp + 4 * (w & 1));
            const unsigned char* xtv = lds + VT_OFF + (4 * q + tq) * RS + 2 * (16 * w + 4 * tp);
            s16x4 XbW[4], XbU[4];
            f32x4 XW[4];
#pragma unroll
            for (int r = 0; r < 4; ++r) {
                const s16x4 a_tw = *(const s16x4*)(lds + TSW_OFF + (r * 16 + m) * BS + 8 * q);
                const s16x4 a_tu = *(const s16x4*)(lds + TSU_OFF + (r * 16 + m) * BS + 8 * q);
                const s16x4 b_k = lds_tr_read(xtk + 16 * r * RS);
                const s16x4 b_v = lds_tr_read(xtv + 16 * r * RS);
                XW[r] = mfma16(a_tw, b_k, (f32x4){0.f, 0.f, 0.f, 0.f});
                vn[r] = mfma16(a_tu, b_v, (f32x4){0.f, 0.f, 0.f, 0.f});
                if (r > 0) {
                    f32x4 accW = (f32x4){0.f, 0.f, 0.f, 0.f}, accU = (f32x4){0.f, 0.f, 0.f, 0.f};
#pragma unroll
                    for (int c = 0; c < r; ++c) {
                        const s16x4 a_ab = *(const s16x4*)(lds + AB_OFF + (16 * r + m) * TS + 2 * (16 * c + 4 * q));
                        accW = mfma16(a_ab, XbW[c], accW);
                        accU = mfma16(a_ab, XbU[c], accU);
                    }
                    const s16x4 a_tn = *(const s16x4*)(lds + TN_OFF + (r * 16 + m) * BS + 8 * q);
                    XW[r] = mfma16(a_tn, cvt4(accW), XW[r]);
                    vn[r] = mfma16(a_tn, cvt4(accU), vn[r]);
                }
                XbW[r] = cvt4(XW[r]);
                XbU[r] = cvt4(vn[r]);
            }
            const int colpos = 32 * (w >> 1) + pos32(16 * (w & 1) + m);
#pragma unroll
            for (int r = 0; r < 4; ++r)
#pragma unroll
                for (int rr = 0; rr < 4; ++rr)
                    *(unsigned short*)(lds + WP_OFF + (16 * r + 4 * q + rr) * RS + 2 * colpos) = f2bf(-XW[r][rr]);
        }
        lds_barrier();
        bf16x8 Sf[4];
#pragma unroll
        for (int B = 0; B < 4; ++B) Sf[B] = cvt8(S[2 * B], S[2 * B + 1]);
#pragma unroll
        for (int r = 0; r < 4; ++r) {
            bf16x8 wf[4];
#pragma unroll
            for (int B = 0; B < 4; ++B) wf[B] = *(const bf16x8*)(lds + WP_OFF + (16 * r + m) * RS + 64 * B + 16 * q);
#pragma unroll
            for (int B = 0; B < 4; ++B) vn[r] = mfma32(wf[B], Sf[B], vn[r]);
        }
        if (HAS_Q) {
            const int cb = dir ? (nch - 1 - ci) : ci;
            f32x4 o[4];
#pragma unroll
            for (int r = 0; r < 4; ++r) o[r] = (f32x4){0.f, 0.f, 0.f, 0.f};
#pragma unroll
            for (int r = 0; r < 4; ++r) {
                bf16x8 qf[4];
#pragma unroll
                for (int B = 0; B < 4; ++B) qf[B] = *(const bf16x8*)(lds + QP_OFF + (16 * r + m) * RS + 64 * B + 16 * q);
#pragma unroll
                for (int B = 0; B < 4; ++B) o[r] = mfma32(qf[B], Sf[B], o[r]);
            }
            const bf16x8 Vn0 = cvt8(vn[0], vn[1]), Vn1 = cvt8(vn[2], vn[3]);
            bf16x8 af0[4], af1[2];
#pragma unroll
            for (int r = 0; r < 4; ++r) af0[r] = *(const bf16x8*)(lds + AT_OFF + (16 * r + m) * TS + 16 * q);
#pragma unroll
            for (int r = 2; r < 4; ++r) af1[r - 2] = *(const bf16x8*)(lds + AT_OFF + (16 * r + m) * TS + 64 + 16 * q);
#pragma unroll
            for (int r = 0; r < 4; ++r) {
                const f32x4 egv = *(const f32x4*)(gt + 64 + 16 * r + 4 * q);
                o[r] = o[r] * egv;
            }
#pragma unroll
            for (int r = 0; r < 4; ++r) o[r] = mfma32(af0[r], Vn0, o[r]);
#pragma unroll
            for (int r = 2; r < 4; ++r) o[r] = mfma32(af1[r - 2], Vn1, o[r]);
            unsigned char* ot = lds + OT_OFF + w * 2048;
#pragma unroll
            for (int r = 0; r < 4; ++r)
#pragma unroll
                for (int rr = 0; rr < 4; ++rr) *(unsigned short*)(ot + (16 * r + 4 * q + rr) * 32 + 2 * m) = f2bf(o[r][rr]);
            {
                const uint4 o0 = *(const uint4*)(ot + lane * 32), o1 = *(const uint4*)(ot + lane * 32 + 16);
                const size_t tok = (size_t)(tokbase + cb * 64 + (dir ? (63 - lane) : lane));
                bf16_t* op = O + tok * 1024 + head * 128 + 16 * w;
                *(uint4*)op = o0; *(uint4*)(op + 8) = o1;
            }
        }
        {
            f32x4 vk[4];
#pragma unroll
            for (int r = 0; r < 4; ++r) {
                const f32x4 kdv = *(const f32x4*)(gt + 192 + 16 * r + 4 * q);
                vk[r] = vn[r] * kdv;
            }
            const bf16x8 Vk0 = cvt8(vk[0], vk[1]), Vk1 = cvt8(vk[2], vk[3]);
            const float eS = gt[320];
#pragma unroll
            for (int mt = 0; mt < 8; ++mt) S[mt] = S[mt] * eS;
            const int tq = (lane & 15) >> 2, tp = lane & 3;
#pragma unroll
            for (int hh = 0; hh < 2; ++hh) {
                s16x4 kf[4][4];
#pragma unroll
                for (int mi = 0; mi < 4; ++mi) {
                    const int mt = 4 * hh + mi;
                    const unsigned char* kr = lds + KP_OFF + (4 * q + tq) * RS + 2 * (32 * (mt >> 1) + 8 * tp + 4 * (mt & 1));
                    kf[mi][0] = lds_tr_read(kr); kf[mi][1] = lds_tr_read(kr + 16 * RS); kf[mi][2] = lds_tr_read(kr + 32 * RS); kf[mi][3] = lds_tr_read(kr + 48 * RS);
                }
#pragma unroll
                for (int mi = 0; mi < 4; ++mi) {
                    const uint2 a0 = __builtin_bit_cast(uint2, kf[mi][0]), a1 = __builtin_bit_cast(uint2, kf[mi][1]);
                    S[4 * hh + mi] = mfma32(__builtin_bit_cast(bf16x8, make_uint4(a0.x, a0.y, a1.x, a1.y)), Vk0, S[4 * hh + mi]);
                }
#pragma unroll
                for (int mi = 0; mi < 4; ++mi) {
                    const uint2 a2 = __builtin_bit_cast(uint2, kf[mi][2]), a3 = __builtin_bit_cast(uint2, kf[mi][3]);
                    S[4 * hh + mi] = mfma32(__builtin_bit_cast(bf16x8, make_uint4(a2.x, a2.y, a3.x, a3.y)), Vk1, S[4 * hh + mi]);
                }
            }
        }
        lds_barrier();
    }
    if (Sout) {
#pragma unroll
        for (int mt = 0; mt < 8; ++mt)
#pragma unroll
            for (int r = 0; r < 4; ++r) Sout[(size_t)(16 * mt + 4 * q + r) * 128 + 16 * w + m] = S[mt][r];
    }
}

DEVI void cswap_desc(float& a, float& b) { const float hi = fmaxf(a, b), lo = fminf(a, b); a = hi; b = lo; }
DEVI void sort16_desc(float (&v)[16]) {
#pragma unroll
    for (int k = 2; k <= 16; k <<= 1)
#pragma unroll
        for (int j = k >> 1; j > 0; j >>= 1)
#pragma unroll
            for (int i = 0; i < 16; ++i) {
                const int l = i ^ j;
                if (l > i) {
                    if ((i & k) == 0) cswap_desc(v[i], v[l]); else cswap_desc(v[l], v[i]);
                }
            }
}
DEVI void merge16_desc(float (&a)[16], const float (&b)[16]) {
#pragma unroll
    for (int i = 0; i < 16; ++i) a[i] = fmaxf(a[i], b[15 - i]);
#pragma unroll
    for (int j = 8; j > 0; j >>= 1)
#pragma unroll
        for (int i = 0; i < 16; ++i) {
            const int l = i ^ j;
            if (l > i) cswap_desc(a[i], a[l]);
        }
}

DEVI void phase_topk(const Params& p, const bf16_t* QP, int* IDX, float* GV, unsigned char* lds) {
    constexpr int KST = 272;
    const int tid = threadIdx.x, lane = tid & 63, w = tid >> 6;
    const int nb = gridDim.x;
    const int head = blockIdx.x & 7;
    const int bsub = blockIdx.x >> 3, nsub = (nb + 7 - head) / 8;
    const float* sk = p.in[29] + (size_t)head * 2 * 128 * 128;
    __syncthreads();
    for (int i = tid; i < 256 * 32; i += NTHREADS) {
        const int row = i >> 5, d4 = (i & 31) * 4;
        const float4 v = *(const float4*)(sk + row * 128 + d4);
        uint2 o; o.x = pack2(v.x, v.y); o.y = pack2(v.z, v.w);
        *(uint2*)(lds + row * KST + d4 * 2) = o;
    }
    __syncthreads();
    const int hf = lane >> 5, tl = lane & 31;
    for (int tile = bsub * 8 + w; tile < NT / 32; tile += nsub * 8) {
        const int tok = tile * 32 + tl;
        float L[2][16];
#pragma unroll
        for (int jj = 0; jj < 2; ++jj) {
            const bf16_t* qrow = QP + (size_t)tok * 2048 + head * 256 + jj * 128 + 8 * hf;
            uint4 bq[8];
#pragma unroll
            for (int ks = 0; ks < 8; ++ks) bq[ks] = *(const uint4*)(qrow + ks * 16);
            f32x16 acc[4];
#pragma unroll
            for (int kt = 0; kt < 4; ++kt)
#pragma unroll
                for (int r = 0; r < 16; ++r) acc[kt][r] = 0.f;
#pragma unroll
            for (int ks = 0; ks < 8; ++ks) {
#pragma unroll
                for (int kt = 0; kt < 4; ++kt) {
                    const bf16x8 af = *(const bf16x8*)(lds + (jj * 128 + kt * 32 + tl) * KST + (ks * 16 + 8 * hf) * 2);
                    acc[kt] = __builtin_amdgcn_mfma_f32_32x32x16_bf16(af, __builtin_bit_cast(bf16x8, bq[ks]), acc[kt], 0, 0, 0);
                }
                __builtin_amdgcn_sched_barrier(0);
            }
            float g[4][16];
#pragma unroll
            for (int kt = 0; kt < 4; ++kt) {
#pragma unroll
                for (int r = 0; r < 16; ++r) {
                    const unsigned key = (unsigned)(32 * kt + (r & 3) + 8 * (r >> 2)) + 4u * (unsigned)hf;
                    g[kt][r] = __uint_as_float((__float_as_uint(acc[kt][r]) & 0xffffff80u) | key);
                }
                sort16_desc(g[kt]);
            }
            merge16_desc(g[0], g[1]);
            merge16_desc(g[2], g[3]);
            merge16_desc(g[0], g[2]);
            float o[16];
#pragma unroll
            for (int i = 0; i < 16; ++i) o[i] = __shfl_xor(g[0][i], 32);
            merge16_desc(g[0], o);
#pragma unroll
            for (int i = 0; i < 16; ++i) L[jj][i] = g[0][i];
        }
        float R0[16], G1[16], G2[16], G3a = 0.f, G3b = 0.f;
#pragma unroll
        for (int i = 0; i < 16; ++i) R0[i] = L[0][0] + L[1][i];
        {
            int n = 0;
#pragma unroll
            for (int a2 = 1; a2 < 16; ++a2) {
#pragma unroll
                for (int b2 = 0; b2 < 16 / (a2 + 1); ++b2) {
                    const float c = L[0][a2] + L[1][b2];
                    if (n < 16) G1[n] = c; else if (n < 32) G2[n - 16] = c; else if (n == 32) G3a = c; else G3b = c;
                    ++n;
                }
            }
        }
        sort16_desc(G1);
        sort16_desc(G2);
        merge16_desc(R0, G1);
        merge16_desc(R0, G2);
#pragma unroll
        for (int i = 0; i < 16; ++i) { cswap_desc(R0[i], G3a); }
#pragma unroll
        for (int i = 0; i < 16; ++i) { cswap_desc(R0[i], G3b); }
        const float tau = R0[15];
#pragma unroll
        for (int i = 0; i < 16; ++i) { asm volatile("" : "+v"(L[0][i])); asm volatile("" : "+v"(L[1][i])); }
        unsigned* dst = (hf ? (unsigned*)GV : (unsigned*)IDX) + (size_t)tok * 128 + head * 16;
        int pos = 0;
#pragma unroll
        for (int a2 = 0; a2 < 16; ++a2) {
            const unsigned i0 = (__float_as_uint(L[0][a2]) & 127u) << 7;
#pragma unroll
            for (int b2 = 0; b2 < 16 / (a2 + 1); ++b2) {
                const float c = L[0][a2] + L[1][b2];
                if (c >= tau && pos < 16) {
                    const unsigned code = i0 | (__float_as_uint(L[1][b2]) & 127u);
                    dst[pos] = hf ? __float_as_uint(c) : code;
                    ++pos;
                }
            }
        }
    }
}

typedef float float2_ __attribute__((ext_vector_type(2)));
DEVI float wave_sum_u(float v) {
    v = dpp_add<0xB1>(v); v = dpp_add<0x4E>(v); v = dpp_add<0x141>(v); v = dpp_add<0x140>(v);
    int t = __builtin_amdgcn_update_dpp(0, __float_as_int(v), 0x142, 0xA, 0xF, false); v += __int_as_float(t);
    t = __builtin_amdgcn_update_dpp(0, __float_as_int(v), 0x143, 0xC, 0xF, false); v += __int_as_float(t);
    return readlane_f(v, 63);
}

constexpr float PEER_USCALE = 256.f, PEER_VSCALE = 64.f;


DEVI void convert_table_fp8_sliced(const float* src, unsigned char* dst, float scale, int wid, int nwork) {
    const size_t n16 = (size_t)16384 * 1024 / 16;
    for (size_t i = (size_t)wid; i < n16; i += (size_t)nwork) {
        const size_t e = i >> 6; const int d0 = (int)(i & 63) * 16;
        float4 v[4];
#pragma unroll
        for (int j = 0; j < 4; ++j) v[j] = *(const float4*)(src + e * 1024 + d0 + j * 4);
        unsigned o[4];
#pragma unroll
        for (int j = 0; j < 4; ++j) {
            const float x0 = fminf(fmaxf(v[j].x * scale, -448.f), 448.f), x1 = fminf(fmaxf(v[j].y * scale, -448.f), 448.f);
            const float x2 = fminf(fmaxf(v[j].z * scale, -448.f), 448.f), x3 = fminf(fmaxf(v[j].w * scale, -448.f), 448.f);
            int pk = __builtin_amdgcn_cvt_pk_fp8_f32(x0, x1, 0, false);
            pk = __builtin_amdgcn_cvt_pk_fp8_f32(x2, x3, pk, true);
            o[j] = (unsigned)pk;
        }
        *(uint4*)(dst + ((size_t)(d0 >> 7) * 16384 + e) * 128 + (d0 & 127)) = make_uint4(o[0], o[1], o[2], o[3]);
    }
}
DEVI unsigned peer_xcc_id() { return (unsigned)__builtin_amdgcn_s_getreg((3 << 11) | 20) & 0xFu; }
constexpr int PEER_CHUNK_TOK = 512;
template <class F>
DEVI void peer_claim_loop(unsigned* ctr, unsigned char* lds, F body) {
    const unsigned xcc = peer_xcc_id() & 7u;
    volatile unsigned* bc = (volatile unsigned*)(lds + LDS_BYTES - 64);
    for (unsigned s = 0; s < 8; ++s) {
        const unsigned slice = (xcc + s) & 7u;
        for (;;) {
            __syncthreads();
            if (threadIdx.x == 0) bc[0] = __hip_atomic_fetch_add(&ctr[16 * slice], 1u, __ATOMIC_RELAXED, __HIP_MEMORY_SCOPE_AGENT);
            __syncthreads();
            const unsigned c = bc[0];
            if (c >= (unsigned)(NT / PEER_CHUNK_TOK)) break;
            body((int)slice, (int)c);
        }
    }
}
#define PEER_ISSUE(BUF, IDL, IDH, base) do { _Pragma("unroll") for (int r_ = 0; r_ < 16; ++r_) { \
    const int id_ = __shfl(r_ < 8 ? (IDL) : (IDH), (8 * r_ + es) & 63); \
    BUF[r_] = *(const uint4*)((base) + (size_t)id_ * 128); } } while (0)
typedef _Float16 f16x2_t __attribute__((ext_vector_type(2)));
DEVI float dot16_fp8_f16(const uint4& u, const f16x2_t* h) {
    float d = 0.f;
    const float sc = 1.f / PEER_USCALE;
    d = __builtin_amdgcn_fdot2(__builtin_amdgcn_cvt_scalef32_pk_f16_fp8((int)u.x, sc, false), h[0], d, false);
    d = __builtin_amdgcn_fdot2(__builtin_amdgcn_cvt_scalef32_pk_f16_fp8((int)u.x, sc, true), h[1], d, false);
    d = __builtin_amdgcn_fdot2(__builtin_amdgcn_cvt_scalef32_pk_f16_fp8((int)u.y, sc, false), h[2], d, false);
    d = __builtin_amdgcn_fdot2(__builtin_amdgcn_cvt_scalef32_pk_f16_fp8((int)u.y, sc, true), h[3], d, false);
    d = __builtin_amdgcn_fdot2(__builtin_amdgcn_cvt_scalef32_pk_f16_fp8((int)u.z, sc, false), h[4], d, false);
    d = __builtin_amdgcn_fdot2(__builtin_amdgcn_cvt_scalef32_pk_f16_fp8((int)u.z, sc, true), h[5], d, false);
    d = __builtin_amdgcn_fdot2(__builtin_amdgcn_cvt_scalef32_pk_f16_fp8((int)u.w, sc, false), h[6], d, false);
    d = __builtin_amdgcn_fdot2(__builtin_amdgcn_cvt_scalef32_pk_f16_fp8((int)u.w, sc, true), h[7], d, false);
    return d;
}
DEVI f16x2_t bfpair_to_f16(unsigned w) { return __builtin_bit_cast(f16x2_t, __builtin_amdgcn_cvt_pkrtz(__uint_as_float(w << 16), __uint_as_float(w & 0xffff0000u))); }
template <int CTRL>
DEVI float dpp_get(float v) { return __int_as_float(__builtin_amdgcn_update_dpp(0, __float_as_int(v), CTRL, 0xf, 0xf, true)); }
DEVI void phase_peer_u(const bf16_t* HX2, const int* IDX, float* PART, const unsigned char* U8, unsigned* ctr, unsigned char* lds) {
    const int lane = threadIdx.x & 63, w = threadIdx.x >> 6;
    const int es = lane >> 3, part = lane & 7;
    const bool p0 = lane & 1, p1 = lane & 2, p2 = lane & 4;
    const int rbase = (p0 ? 8 : 0) + (p1 ? 4 : 0) + (p2 ? 2 : 0);
    peer_claim_loop(ctr, lds, [=](int x, int chunk) {
        constexpr int NTW = PEER_CHUNK_TOK / 8;
        const unsigned char* ub = U8 + (size_t)x * 16384 * 128;
        const unsigned loff = 16u * (unsigned)part;
        const int t0 = chunk * PEER_CHUNK_TOK + w * NTW;
        const bf16_t* hb = HX2 + 128 * x + 16 * part;
        uint4 u[16];
        int ilA, ihA, ilB, ihB; uint4 hA0, hA1, hB0, hB1;
#define PU_META(T, IL, IH, H0, H1) do { const int tk_ = t0 + ((T) < NTW ? (T) : NTW - 1); \
        IL = IDX[(size_t)tk_ * 128 + lane] & 16383; IH = IDX[(size_t)tk_ * 128 + 64 + lane] & 16383; \
        H0 = *(const uint4*)(hb + (size_t)tk_ * 1024); H1 = *(const uint4*)(hb + (size_t)tk_ * 1024 + 8); } while (0)
        PU_META(0, ilA, ihA, hA0, hA1);
#pragma unroll
        for (int r = 0; r < 16; ++r) u[r] = *(const uint4*)(ub + ((unsigned)__shfl(r < 8 ? ilA : ihA, (8 * r + es) & 63) * 128u + loff));
        PU_META(1, ilB, ihB, hB0, hB1);
#pragma unroll 1
        for (int i = 0; i < NTW; ++i) {
            f16x2_t h[8];
            h[0] = bfpair_to_f16(hA0.x); h[1] = bfpair_to_f16(hA0.y); h[2] = bfpair_to_f16(hA0.z); h[3] = bfpair_to_f16(hA0.w);
            h[4] = bfpair_to_f16(hA1.x); h[5] = bfpair_to_f16(hA1.y); h[6] = bfpair_to_f16(hA1.z); h[7] = bfpair_to_f16(hA1.w);
            float d[16];
#pragma unroll
            for (int r = 0; r < 16; ++r) {
                d[r] = dot16_fp8_f16(u[r], h);
                const unsigned id = (unsigned)__shfl(r < 8 ? ilB : ihB, (8 * r + es) & 63);
                u[r] = *(const uint4*)(ub + (id * 128u + loff));
                if ((r & 1) == 1) __builtin_amdgcn_sched_barrier(0);
            }
            float k8[8], k4[4], k2[2];
#pragma unroll
            for (int j = 0; j < 8; ++j) { const float snd = p0 ? d[j] : d[j + 8]; const float kp = p0 ? d[j + 8] : d[j]; k8[j] = kp + dpp_get<0xB1>(snd); }
#pragma unroll
            for (int j = 0; j < 4; ++j) { const float snd = p1 ? k8[j] : k8[j + 4]; const float kp = p1 ? k8[j + 4] : k8[j]; k4[j] = kp + dpp_get<0x4E>(snd); }
#pragma unroll
            for (int j = 0; j < 2; ++j) { const float snd = p2 ? k4[j] : k4[j + 2]; const float kp = p2 ? k4[j + 2] : k4[j]; k2[j] = kp + __shfl_xor(snd, 4); }
            float* pp = PART + ((size_t)(t0 + i) * 8 + x) * 128 + 8 * rbase + es;
            pp[0] = k2[0]; pp[8] = k2[1];
            ilA = ilB; ihA = ihB; hA0 = hB0; hA1 = hB1;
            PU_META(i + 2, ilB, ihB, hB0, hB1);
        }
#undef PU_META
    });
}
DEVI void phase_peer_w(const float* PART, float* GW) {
    const int lane = threadIdx.x & 63, w = threadIdx.x >> 6;
    for (int tok = blockIdx.x * 8 + w; tok < NT; tok += gridDim.x * 8) {
        float d0 = 0.f, d1 = 0.f;
#pragma unroll
        for (int x = 0; x < 8; ++x) { d0 += PART[((size_t)tok * 8 + x) * 128 + lane]; d1 += PART[((size_t)tok * 8 + x) * 128 + 64 + lane]; }
        float g0 = GW[(size_t)tok * 128 + lane], g1 = GW[(size_t)tok * 128 + 64 + lane];
        float m0 = g0, m1 = g1;
#pragma unroll
        for (int m = 1; m <= 8; m <<= 1) { m0 = fmaxf(m0, __shfl_xor(m0, m)); m1 = fmaxf(m1, __shfl_xor(m1, m)); }
        g0 = __expf(g0 - m0); g1 = __expf(g1 - m1);
        float s0 = g0, s1 = g1;
#pragma unroll
        for (int m = 1; m <= 8; m <<= 1) { s0 += __shfl_xor(s0, m); s1 += __shfl_xor(s1, m); }
        GW[(size_t)tok * 128 + lane] = gelu_(d0) * g0 / s0;
        GW[(size_t)tok * 128 + 64 + lane] = gelu_(d1) * g1 / s1;
    }
}
DEVI void axpy16_fp8_f16(f16x2_t* acc, const uint4& v, f16x2_t w2) {
    const float sc = 1.f / PEER_VSCALE;
    acc[0] = __builtin_amdgcn_cvt_scalef32_pk_f16_fp8((int)v.x, sc, false) * w2 + acc[0];
    acc[1] = __builtin_amdgcn_cvt_scalef32_pk_f16_fp8((int)v.x, sc, true) * w2 + acc[1];
    acc[2] = __builtin_amdgcn_cvt_scalef32_pk_f16_fp8((int)v.y, sc, false) * w2 + acc[2];
    acc[3] = __builtin_amdgcn_cvt_scalef32_pk_f16_fp8((int)v.y, sc, true) * w2 + acc[3];
    acc[4] = __builtin_amdgcn_cvt_scalef32_pk_f16_fp8((int)v.z, sc, false) * w2 + acc[4];
    acc[5] = __builtin_amdgcn_cvt_scalef32_pk_f16_fp8((int)v.z, sc, true) * w2 + acc[5];
    acc[6] = __builtin_amdgcn_cvt_scalef32_pk_f16_fp8((int)v.w, sc, false) * w2 + acc[6];
    acc[7] = __builtin_amdgcn_cvt_scalef32_pk_f16_fp8((int)v.w, sc, true) * w2 + acc[7];
}
DEVI f16x2_t shfl_xor_h2(f16x2_t v, int m) { return __builtin_bit_cast(f16x2_t, __shfl_xor(__builtin_bit_cast(int, v), m)); }
DEVI void phase_peer_v(const int* IDX, const float* GW, bf16_t* PE, const unsigned char* V8, unsigned* ctr, unsigned char* lds) {
    const int lane = threadIdx.x & 63, w = threadIdx.x >> 6;
    const int es = lane >> 3, part = lane & 7;
    const bool b3 = lane & 8, b4 = lane & 16, b5 = lane & 32;
    const int o = (b3 ? 8 : 0) + (b4 ? 4 : 0) + (b5 ? 2 : 0);
    peer_claim_loop(ctr, lds, [=](int x, int chunk) {
        constexpr int NTW = PEER_CHUNK_TOK / 8;
        const unsigned char* vb = V8 + (size_t)x * 16384 * 128;
        const unsigned loff = 16u * (unsigned)part;
        const int t0 = chunk * PEER_CHUNK_TOK + w * NTW;
        uint4 v[8];
        int il, ih, iln; float wl, wh;
        il = IDX[(size_t)t0 * 128 + lane] & 16383; ih = IDX[(size_t)t0 * 128 + 64 + lane] & 16383;
        wl = GW[(size_t)t0 * 128 + lane]; wh = GW[(size_t)t0 * 128 + 64 + lane];
#pragma unroll
        for (int r = 0; r < 8; ++r) v[r] = *(const uint4*)(vb + ((unsigned)__shfl(il, 8 * r + es) * 128u + loff));
#pragma unroll 1
        for (int i = 0; i < NTW; ++i) {
            const int tn = t0 + (i + 1 < NTW ? i + 1 : i);
            iln = IDX[(size_t)tn * 128 + lane] & 16383;
            f16x2_t acc[8];
#pragma unroll
            for (int j = 0; j < 8; ++j) acc[j] = (f16x2_t){(_Float16)0.f, (_Float16)0.f};
#pragma unroll
            for (int r = 0; r < 8; ++r) {
                const float wr = __shfl(wl, 8 * r + es);
                axpy16_fp8_f16(acc, v[r], __builtin_bit_cast(f16x2_t, __builtin_amdgcn_cvt_pkrtz(wr, wr)));
                v[r] = *(const uint4*)(vb + ((unsigned)__shfl(ih, 8 * r + es) * 128u + loff));
            }
            const float wh_c = wh;
            const int ihn = IDX[(size_t)tn * 128 + 64 + lane] & 16383;
            wl = GW[(size_t)tn * 128 + lane]; wh = GW[(size_t)tn * 128 + 64 + lane];
#pragma unroll
            for (int r = 0; r < 8; ++r) {
                const float wr = __shfl(wh_c, 8 * r + es);
                axpy16_fp8_f16(acc, v[r], __builtin_bit_cast(f16x2_t, __builtin_amdgcn_cvt_pkrtz(wr, wr)));
                v[r] = *(const uint4*)(vb + ((unsigned)__shfl(iln, 8 * r + es) * 128u + loff));
            }
            il = iln; ih = ihn;
            f16x2_t k4[4], k2[2], k1;
#pragma unroll
            for (int j = 0; j < 4; ++j) { const f16x2_t snd = b3 ? acc[j] : acc[j + 4]; const f16x2_t kp = b3 ? acc[j + 4] : acc[j]; k4[j] = kp + shfl_xor_h2(snd, 8); }
#pragma unroll
            for (int j = 0; j < 2; ++j) { const f16x2_t snd = b4 ? k4[j] : k4[j + 2]; const f16x2_t kp = b4 ? k4[j + 2] : k4[j]; k2[j] = kp + shfl_xor_h2(snd, 16); }
            { const f16x2_t snd = b5 ? k2[0] : k2[1]; const f16x2_t kp = b5 ? k2[1] : k2[0]; k1 = kp + shfl_xor_h2(snd, 32); }
            *(unsigned*)(PE + (size_t)(t0 + i) * 1024 + 128 * x + 16 * part + o) = pack2((float)k1.x, (float)k1.y);
        }
    });
}
DEVI float4 bf4_to_f4(const uint2& t) { return make_float4(__uint_as_float(t.x << 16), __uint_as_float(t.x & 0xffff0000u), __uint_as_float(t.y << 16), __uint_as_float(t.y & 0xffff0000u)); }
DEVI void phase_peer_final(const Params& p, const bf16_t* X1b, const bf16_t* PE, const float* MOD, float* OUT) {
    const int lane = threadIdx.x & 63, w = threadIdx.x >> 6;
    const float* nw = p.in[9];
    for (int run = blockIdx.x * 8 + w; run < NT / 16; run += gridDim.x * 8) {
        const int row0 = run * 16;
        const float* gate2 = MOD + (size_t)(row0 / TL) * 6144 + 5 * 1024;
        float4 c[4];
#pragma unroll
        for (int i = 0; i < 4; ++i) {
            const int d = lane * 4 + 256 * i;
            const float4 g = *(const float4*)(gate2 + d), nwv = *(const float4*)(nw + d);
            c[i] = make_float4(g.x * nwv.x, g.y * nwv.y, g.z * nwv.z, g.w * nwv.w);
        }
        uint2 na[4], nx[4];
#pragma unroll
        for (int i = 0; i < 4; ++i) {
            na[i] = *(const uint2*)(PE + (size_t)row0 * 1024 + lane * 4 + 256 * i);
            nx[i] = *(const uint2*)(X1b + (size_t)row0 * 1024 + lane * 4 + 256 * i);
        }
#pragma unroll 1
        for (int rr = 0; rr < 16; ++rr) {
            const int tok = row0 + rr;
            float4 a[4], x1[4]; float ss = 0.f;
#pragma unroll
            for (int i = 0; i < 4; ++i) {
                a[i] = bf4_to_f4(na[i]); x1[i] = bf4_to_f4(nx[i]);
                ss += a[i].x * a[i].x + a[i].y * a[i].y + a[i].z * a[i].z + a[i].w * a[i].w;
            }
            if (rr + 1 < 16) {
#pragma unroll
                for (int i = 0; i < 4; ++i) {
                    na[i] = *(const uint2*)(PE + (size_t)(tok + 1) * 1024 + lane * 4 + 256 * i);
                    nx[i] = *(const uint2*)(X1b + (size_t)(tok + 1) * 1024 + lane * 4 + 256 * i);
                }
            }
            ss = wave_sum_u(ss);
            const float r = rsqrtf(ss * (1.f / 1024.f) + 1e-6f);
#pragma unroll
            for (int i = 0; i < 4; ++i) {
                const int d = lane * 4 + 256 * i;
                float4 o;
                o.x = x1[i].x + c[i].x * a[i].x * r; o.y = x1[i].y + c[i].y * a[i].y * r;
                o.z = x1[i].z + c[i].z * a[i].z * r; o.w = x1[i].w + c[i].w * a[i].w * r;
                *(float4*)(OUT + (size_t)tok * 1024 + d) = o;
            }
        }
    }
}

template <bool NORM>
DEVI void conv_wave(const bf16_t* src, int ld_src, int tok0, bool lo_ok, bool hi_ok, int scol,
                    bf16_t* dst, int ld_dst, int dcol, const float* cw, int wch, float oscale) {
    const int lane = threadIdx.x & 63;
    unsigned x[68];
    const bf16_t* sp = src + (size_t)tok0 * ld_src + scol + 2 * lane;
#pragma unroll
    for (int t = 0; t < 64; ++t) x[t + 2] = *(const unsigned*)(sp + (size_t)t * ld_src);
    x[0] = lo_ok ? *(const unsigned*)(sp - 2 * (size_t)ld_src) : 0u;
    x[1] = lo_ok ? *(const unsigned*)(sp - (size_t)ld_src) : 0u;
    x[66] = hi_ok ? *(const unsigned*)(sp + 64 * (size_t)ld_src) : 0u;
    x[67] = hi_ok ? *(const unsigned*)(sp + 65 * (size_t)ld_src) : 0u;
    float w0[5], w1[5];
#pragma unroll
    for (int j = 0; j < 5; ++j) { w0[j] = cw[j * 3072 + wch + 2 * lane]; w1[j] = cw[j * 3072 + wch + 2 * lane + 1]; }
    bf16_t* dp = dst + (size_t)tok0 * ld_dst + dcol + 2 * lane;
#pragma unroll
    for (int t = 0; t < 64; ++t) {
        float a0 = 0.f, a1 = 0.f;
#pragma unroll
        for (int j = 0; j < 5; ++j) {
            a0 += w0[j] * __uint_as_float(x[t + j] << 16);
            a1 += w1[j] * __uint_as_float(x[t + j] & 0xffff0000u);
        }
        a0 = silu_(a0); a1 = silu_(a1);
        float sc = oscale;
        if (NORM) sc = rsqrtf(wave_sum_u(a0 * a0 + a1 * a1) + 1e-6f) * oscale;
        *(unsigned*)(dp + (size_t)t * ld_dst) = pack2(a0 * sc, a1 * sc);
    }
}

namespace pg8 {
#define PG8_LAS __attribute__((address_space(3)))
typedef unsigned short bf16_t;
typedef short bf16x8 __attribute__((ext_vector_type(8)));
typedef float f32x4 __attribute__((ext_vector_type(4)));
typedef unsigned u32x4 __attribute__((ext_vector_type(4)));
constexpr int BM = 256, BK = 64, HALF = 128, HTB = HALF * BK * 2  , STAGE_BYTES = 8 * HTB, NXCD = 8, WGM = 8;

__host__ __device__ __forceinline__ int lds_byte(int r, int c) { const int st = (r >> 4) * 2 + (c >> 5), rr = r & 15, cc = c & 31, ob = rr * 64 + cc * 2; return st * 1024 + (ob ^ (((ob >> 9) & 1) << 5)); }
__host__ __device__ __forceinline__ void stage_rc(int b, int& R, int& C) { const int st = b / 1024, sb = b % 1024, swz = sb ^ (((sb >> 9) & 1) << 5); R = (st >> 1) * 16 + swz / 64; C = (st & 1) * 32 + (swz % 64) / 2; }
__host__ __device__ __forceinline__ int perm32(int rho) { const int n = rho >> 4, i = rho & 15; return 8 * (i >> 2) + 4 * n + (i & 3); }

struct Unit { int pm, pn; };
struct Gemm { const bf16_t* A; const bf16_t* Bt; int M, N, K; };

struct StaticOrder {
    int nM, nN, nwg, G, c;
    __host__ __device__ void init(int M, int N, int G_, int c_) { nM = M / BM; nN = N / BM; nwg = nM * nN; G = G_; c = c_; }
    __host__ __device__ bool next(int i, Unit& u) const {
        const long L = (long)i * G + c; if (L >= nwg) return false;
        int wgid = (int)L; { const int q = nwg / NXCD, r = nwg % NXCD, xcd = wgid % NXCD, off = wgid / NXCD; wgid = (xcd < r ? xcd * (q + 1) : r * (q + 1) + (xcd - r) * q) + off; }
        const int nig = WGM * nN, gid = wgid / nig, fm = gid * WGM, gsz = (nM - fm) < WGM ? (nM - fm) : WGM;
        u.pm = fm + ((wgid % nig) % gsz); u.pn = (wgid % nig) / gsz; return true;
    }
    __device__ __forceinline__ void a_ready(const Unit&) const {}
    __device__ __forceinline__ void done(const Unit&) const {}
};
__device__ __forceinline__ unsigned cvt_pk_bf16(float lo, float hi) { unsigned r; asm volatile("v_cvt_pk_bf16_f32 %0, %1, %2" : "=v"(r) : "v"(lo), "v"(hi)); return r; }
template <class Epi, class Sched, bool ALIGN_EPI = false, bool SP2 = false>
__device__ __forceinline__ void gemm_phase(PG8_LAS unsigned char* lds, const Gemm g, const Sched& S, const Epi& E) {
    const int tid = threadIdx.x, wid = __builtin_amdgcn_readfirstlane(tid >> 6), lane = tid & 63, wr = wid >> 2, wc = wid & 3, fr = lane & 15, fq = lane >> 4;
    const int K = g.K, nt = K / BK;
    unsigned voffA[2], voffB[2];
#pragma unroll
    for (int i = 0; i < 2; ++i) { int R, C; stage_rc(tid * 16 + i * 8192, R, C); const int Rb = Epi::PERM ? ((R & ~31) + perm32(R & 31)) : R;
        voffA[i] = (unsigned)(R * K + C) * 2u; voffB[i] = (unsigned)(Rb * K + C) * 2u; }
    const size_t kstep = (size_t)(BK * 2);
    const size_t hstep = (size_t)HALF * K * 2;
    const size_t tstep = 2 * hstep;
    const unsigned ldsw = (unsigned)wid * 1024u;
    const int aoff = lds_byte(wr * 64 + fr, fq * 8), boff = lds_byte(wc * 32 + fr, fq * 8);
#define PG8_SA(b, h) (((b) * 2 + (h)) * HTB)
#define PG8_SB(b, h) ((4 + (b) * 2 + (h)) * HTB)
#define PG8_STAGE(bufoff, gbase, voff) do { _Pragma("unroll") for (int _i = 0; _i < 2; ++_i) \
        __builtin_amdgcn_global_load_lds((const unsigned*)((const char*)(gbase) + (voff)[_i]), (PG8_LAS unsigned*)(lds + (bufoff) + ldsw + _i * 8192), 16, 0, 0); } while (0)
#define PG8_LDA(dst, b, h) do { _Pragma("unroll") for (int m = 0; m < 4; ++m) _Pragma("unroll") for (int k = 0; k < 2; ++k) dst[m][k] = *(const PG8_LAS bf16x8*)(lds + PG8_SA(b, h) + aoff + m * 2048 + k * 1024); } while (0)
#define PG8_LDB(dst, b, h) do { _Pragma("unroll") for (int n = 0; n < 2; ++n) _Pragma("unroll") for (int k = 0; k < 2; ++k) dst[n][k] = *(const PG8_LAS bf16x8*)(lds + PG8_SB(b, h) + boff + n * 2048 + k * 1024); } while (0)
#define PG8_MMA(ai, bj, At, Bt) do { __builtin_amdgcn_s_setprio(1); _Pragma("unroll") for (int m = 0; m < 4; ++m) _Pragma("unroll") for (int n = 0; n < 2; ++n) _Pragma("unroll") for (int k = 0; k < 2; ++k) \
        acc[ai][bj][m][n] = __builtin_amdgcn_mfma_f32_16x16x32_bf16(Bt[n][k], At[m][k], acc[ai][bj][m][n], 0, 0, 0); __builtin_amdgcn_s_setprio(0); } while (0)
#define PG8_WAIT_V(n) asm volatile("s_waitcnt vmcnt(" #n ")" ::: "memory")
#define PG8_WAIT_L(n) asm volatile("s_waitcnt lgkmcnt(" #n ")" ::: "memory")
#define PG8_BAR __builtin_amdgcn_s_barrier()
#define PG8_SCHED __builtin_amdgcn_sched_barrier(0)
    Unit cur, nxt; int ui = 0;
    if (!S.next(0, cur)) return;
    f32x4 acc[2][2][4][2];
#pragma unroll
    for (int a = 0; a < 2; ++a)
#pragma unroll
        for (int b = 0; b < 2; ++b)
#pragma unroll
            for (int m = 0; m < 4; ++m)
#pragma unroll
                for (int n = 0; n < 2; ++n) acc[a][b][m][n] = (f32x4){0.f, 0.f, 0.f, 0.f};
    bf16x8 At[4][2], B0[2][2], B1[2][2];
    const char* cA = (const char*)g.A + (size_t)cur.pm * tstep; const char* cB = (const char*)g.Bt + (size_t)cur.pn * tstep;
    S.a_ready(cur);
    if constexpr (SP2) {
        PG8_STAGE(PG8_SB(0, 0), cB, voffB); PG8_STAGE(PG8_SB(0, 1), cB + hstep, voffB); PG8_STAGE(PG8_SA(0, 0), cA, voffA); PG8_STAGE(PG8_SA(0, 1), cA + hstep, voffA);
        if (wr == 1) PG8_BAR;
        PG8_WAIT_V(2); PG8_BAR;
        PG8_STAGE(PG8_SB(1, 0), cB + kstep, voffB); PG8_STAGE(PG8_SA(1, 0), cA + kstep, voffA); PG8_STAGE(PG8_SB(1, 1), cB + hstep + kstep, voffB);
        PG8_WAIT_V(6); PG8_BAR;
    } else {
        PG8_STAGE(PG8_SB(0, 0), cB, voffB); PG8_STAGE(PG8_SA(0, 0), cA, voffA); PG8_STAGE(PG8_SB(0, 1), cB + hstep, voffB); PG8_STAGE(PG8_SA(0, 1), cA + hstep, voffA);
        if (wr == 1) PG8_BAR;
        PG8_WAIT_V(4); PG8_BAR;
        PG8_STAGE(PG8_SB(1, 0), cB + kstep, voffB); PG8_STAGE(PG8_SA(1, 0), cA + kstep, voffA); PG8_STAGE(PG8_SB(1, 1), cB + hstep + kstep, voffB);
        PG8_WAIT_V(6); PG8_BAR;
    }
    for (;;) {
        const bool has_next = S.next(ui + 1, nxt);
        const char* nA = has_next ? (const char*)g.A + (size_t)nxt.pm * tstep : cA; const char* nB = has_next ? (const char*)g.Bt + (size_t)nxt.pn * tstep : cB;
        for (int t = 0; t < nt; t += 2) {
            const bool last = (t == nt - 2);
            const char* a1 = cA + (size_t)(t + 1) * kstep;
            const char* a2 = last ? nA : cA + (size_t)(t + 2) * kstep; const char* b2 = last ? nB : cB + (size_t)(t + 2) * kstep;
            const char* a3 = a2 + kstep; const char* b3 = b2 + kstep;
            if (last && has_next) S.a_ready(nxt);
            if constexpr (SP2) {
            PG8_LDB(B0, 0, 0); PG8_LDB(B1, 0, 1); PG8_SCHED; PG8_LDA(At, 0, 0); PG8_STAGE(PG8_SA(1, 1), a1 + hstep, voffA);
            PG8_WAIT_V(8); PG8_WAIT_L(0); PG8_BAR; PG8_MMA(0, 0, At, B0); PG8_MMA(0, 1, At, B1); PG8_BAR; PG8_SCHED;
            PG8_LDA(At, 0, 1); PG8_STAGE(PG8_SB(0, 0), b2, voffB); PG8_STAGE(PG8_SB(0, 1), b2 + hstep, voffB); PG8_STAGE(PG8_SA(0, 0), a2, voffA);
            PG8_WAIT_V(8); PG8_WAIT_L(0); PG8_BAR; PG8_MMA(1, 0, At, B0); PG8_MMA(1, 1, At, B1); PG8_BAR; PG8_SCHED;
            PG8_LDB(B0, 1, 0); PG8_LDB(B1, 1, 1); PG8_SCHED; PG8_LDA(At, 1, 0); PG8_STAGE(PG8_SA(0, 1), a2 + hstep, voffA);
            PG8_WAIT_V(8); PG8_WAIT_L(0); PG8_BAR; PG8_MMA(0, 0, At, B0); PG8_MMA(0, 1, At, B1); PG8_BAR; PG8_SCHED;
            PG8_LDA(At, 1, 1); PG8_STAGE(PG8_SB(1, 0), b3, voffB); PG8_STAGE(PG8_SB(1, 1), b3 + hstep, voffB); PG8_STAGE(PG8_SA(1, 0), a3, voffA);
            PG8_WAIT_V(8); PG8_WAIT_L(0); PG8_BAR; PG8_MMA(1, 0, At, B0); PG8_MMA(1, 1, At, B1); PG8_BAR; PG8_SCHED;
            } else {
            PG8_LDB(B0, 0, 0); PG8_SCHED; PG8_LDA(At, 0, 0); PG8_STAGE(PG8_SA(1, 1), a1 + hstep, voffA);
            PG8_WAIT_L(8); PG8_BAR; PG8_WAIT_L(0); PG8_MMA(0, 0, At, B0); PG8_BAR; PG8_SCHED;
            PG8_LDB(B1, 0, 1); PG8_STAGE(PG8_SB(0, 0), b2, voffB);
            PG8_BAR; PG8_WAIT_L(0); PG8_MMA(0, 1, At, B1); PG8_BAR;
            PG8_LDA(At, 0, 1); PG8_STAGE(PG8_SA(0, 0), a2, voffA);
            PG8_BAR; PG8_WAIT_L(0); PG8_MMA(1, 0, At, B0); PG8_BAR; PG8_SCHED;
            PG8_STAGE(PG8_SB(0, 1), b2 + hstep, voffB);
            PG8_WAIT_V(6); PG8_BAR; PG8_MMA(1, 1, At, B1); PG8_BAR;
            PG8_LDB(B0, 1, 0); PG8_SCHED; PG8_LDA(At, 1, 0); PG8_STAGE(PG8_SA(0, 1), a2 + hstep, voffA);
            PG8_WAIT_L(8); PG8_BAR; PG8_WAIT_L(0); PG8_MMA(0, 0, At, B0); PG8_BAR; PG8_SCHED;
            PG8_LDB(B1, 1, 1); PG8_STAGE(PG8_SB(1, 0), b3, voffB);
            PG8_BAR; PG8_WAIT_L(0); PG8_MMA(0, 1, At, B1); PG8_BAR;
            PG8_LDA(At, 1, 1); PG8_STAGE(PG8_SA(1, 0), a3, voffA);
            PG8_BAR; PG8_WAIT_L(0); PG8_MMA(1, 0, At, B0); PG8_BAR; PG8_SCHED;
            PG8_STAGE(PG8_SB(1, 1), b3 + hstep, voffB);
            PG8_WAIT_V(6); PG8_BAR; PG8_MMA(1, 1, At, B1); PG8_BAR;
            }
        }
        if constexpr (ALIGN_EPI) { if (wr == 0) PG8_BAR; }
        if constexpr (!Epi::AFTER_DRAIN) { E(acc, cur, wr, wc, fr, fq); S.done(cur); }
        if (!has_next) break;
#pragma unroll
        for (int a = 0; a < 2; ++a)
#pragma unroll
            for (int b = 0; b < 2; ++b)
#pragma unroll
                for (int m = 0; m < 4; ++m)
#pragma unroll
                    for (int n = 0; n < 2; ++n) acc[a][b][m][n] = (f32x4){0.f, 0.f, 0.f, 0.f};
        cur = nxt; cA = nA; cB = nB; ++ui;
        if constexpr (ALIGN_EPI) { if (wr == 1) PG8_BAR; }
    }
    PG8_WAIT_V(0);
    if constexpr (!ALIGN_EPI) { if (wr == 0) PG8_BAR; }
    PG8_BAR;
    if constexpr (Epi::AFTER_DRAIN) { E.fused(acc, cur, wr, wc, fr, fq, lds, wid, lane); S.done(cur); }
#undef PG8_SA
#undef PG8_SB
#undef PG8_STAGE
#undef PG8_LDA
#undef PG8_LDB
#undef PG8_MMA
#undef PG8_WAIT_V
#undef PG8_WAIT_L
#undef PG8_BAR
#undef PG8_SCHED
}
__device__ __forceinline__ void unpack8(const u32x4& w, float* f) {
    f[0] = __uint_as_float(w.x << 16); f[1] = __uint_as_float(w.x & 0xffff0000u); f[2] = __uint_as_float(w.y << 16); f[3] = __uint_as_float(w.y & 0xffff0000u);
    f[4] = __uint_as_float(w.z << 16); f[5] = __uint_as_float(w.z & 0xffff0000u); f[6] = __uint_as_float(w.w << 16); f[7] = __uint_as_float(w.w & 0xffff0000u);
}
__device__ __forceinline__ float sigm(float x) { return 1.f / (1.f + __expf(-x)); }
struct EpiStore16 {
    static constexpr bool PERM = true, AFTER_DRAIN = false;
    bf16_t* O; int ldc;
    __device__ __forceinline__ void operator()(const f32x4 (&acc)[2][2][4][2], const Unit& u, int wr, int wc, int fr, int fq) const {
        const int row0 = u.pm * BM + wr * 64 + fr, col0 = u.pn * BM + wc * 32 + 8 * fq;
#pragma unroll
        for (int ai = 0; ai < 2; ++ai)
#pragma unroll
            for (int m = 0; m < 4; ++m) { bf16_t* rowp = O + (size_t)(row0 + ai * HALF + m * 16) * ldc + col0;
#pragma unroll
                for (int bj = 0; bj < 2; ++bj) { const f32x4 v0 = acc[ai][bj][m][0], v1 = acc[ai][bj][m][1];
                    u32x4 w; w.x = cvt_pk_bf16(v0[0], v0[1]); w.y = cvt_pk_bf16(v0[2], v0[3]); w.z = cvt_pk_bf16(v1[0], v1[1]); w.w = cvt_pk_bf16(v1[2], v1[3]);
                    *(u32x4*)(rowp + bj * HALF) = w; } }
    }
};
template <int MODE> struct EpiGate {
    static constexpr bool PERM = true, AFTER_DRAIN = false;
    bf16_t* O; int ldc; const bf16_t* G; int ldg; int goff; const float* bias;
    __device__ __forceinline__ void operator()(const f32x4 (&acc)[2][2][4][2], const Unit& u, int wr, int wc, int fr, int fq) const {
        const int row0 = u.pm * BM + wr * 64 + fr, col0 = u.pn * BM + wc * 32 + 8 * fq;
#pragma unroll
        for (int ai = 0; ai < 2; ++ai)
#pragma unroll
            for (int m = 0; m < 4; ++m) { const size_t row = (size_t)(row0 + ai * HALF + m * 16);
#pragma unroll
                for (int bj = 0; bj < 2; ++bj) { const int col = col0 + bj * HALF; const f32x4 v0 = acc[ai][bj][m][0], v1 = acc[ai][bj][m][1];
                    float a[8] = {v0[0], v0[1], v0[2], v0[3], v1[0], v1[1], v1[2], v1[3]}; float g[8], o[8];
                    unpack8(*(const u32x4*)(G + row * ldg + goff + col), g);
                    if (MODE == 0) {
                        const f32x4 b0 = *(const f32x4*)(bias + col), b1 = *(const f32x4*)(bias + col + 4);
                        const float bb[8] = {b0[0], b0[1], b0[2], b0[3], b1[0], b1[1], b1[2], b1[3]};
#pragma unroll
                        for (int j = 0; j < 8; ++j) o[j] = g[j] * sigm(a[j] + bb[j]);
                    } else if (MODE == 1) {
#pragma unroll
                        for (int j = 0; j < 8; ++j) o[j] = sigm(g[j]) * a[j];
                    } else {
                        float pv[8]; unpack8(*(const u32x4*)(O + row * ldc + col), pv);
#pragma unroll
                        for (int j = 0; j < 8; ++j) o[j] = pv[j] + sigm(g[j]) * a[j];
                    }
                    u32x4 w; w.x = cvt_pk_bf16(o[0], o[1]); w.y = cvt_pk_bf16(o[2], o[3]); w.z = cvt_pk_bf16(o[4], o[5]); w.w = cvt_pk_bf16(o[6], o[7]);
                    *(u32x4*)(O + row * ldc + col) = w; }
                asm volatile("" ::: "memory"); }
    }
};
struct EpiStoreF32 {
    static constexpr bool PERM = false, AFTER_DRAIN = false;
    float* C; int ldc;
    __device__ __forceinline__ void operator()(const f32x4 (&acc)[2][2][4][2], const Unit& u, int wr, int wc, int fr, int fq) const {
        const int row0 = u.pm * BM + wr * 64 + fr, col0 = u.pn * BM + wc * 32 + 4 * fq;
#pragma unroll
        for (int ai = 0; ai < 2; ++ai)
#pragma unroll
            for (int m = 0; m < 4; ++m) { float* rowp = C + (size_t)(row0 + ai * HALF + m * 16) * ldc + col0;
#pragma unroll
                for (int bj = 0; bj < 2; ++bj)
#pragma unroll
                    for (int n = 0; n < 2; ++n) *(f32x4*)(rowp + bj * HALF + n * 16) = acc[ai][bj][m][n]; }
    }
};
}

#define XB_TMO      128
#define XB_XCNT(j)  (256  + 64 * (j))
#define XB_XSUB(j)  (1280 + 64 * (j))
#define XB_XGEN(j)  (2304 + 64 * (j))
#define XB_TOP      3328
#define XB_TOPGEN   3392
#define XCD_BAR_WORDS 3456
#define XB_SPIN_CAP (1u << 22)
#define LAS __attribute__((address_space(3)))
DEVI unsigned xb_ld(unsigned* p)              { return __hip_atomic_load(p, __ATOMIC_RELAXED, __HIP_MEMORY_SCOPE_AGENT); }
DEVI unsigned xb_add(unsigned* p, unsigned v) { return __hip_atomic_fetch_add(p, v, __ATOMIC_RELAXED, __HIP_MEMORY_SCOPE_AGENT); }
DEVI unsigned xb_xcc_id() { return (unsigned)__builtin_amdgcn_s_getreg((3 << 11) | 20) & 0xFu; }
#define XB_SPIN(cond, bar) do { unsigned _sp = 0; while (cond) { __builtin_amdgcn_s_sleep(1); \
    if ((++_sp & 255u) == 0u) { if (xb_ld(&(bar)[XB_TMO])) break; if (_sp > XB_SPIN_CAP) { atomicAdd(&(bar)[XB_TMO], 1u); break; } } } } while (0)
struct XcdBarrier { unsigned* bar; unsigned x; volatile LAS unsigned* st; };
DEVI XcdBarrier xcd_barrier_post(unsigned* bar, volatile LAS unsigned* st) {
    XcdBarrier b; b.bar = bar; b.x = xb_xcc_id(); b.st = st;
    if (threadIdx.x == 0) (void)xb_add(&bar[XB_XCNT(b.x)], 1u);
    return b;
}
DEVI void xcd_barrier_complete(unsigned* bar, unsigned x, unsigned& nloc, unsigned& nx) {
    const unsigned G = gridDim.x * gridDim.y * gridDim.z;
    unsigned sum, cnt, mine, sp = 0u;
    for (;;) {
        sum = 0u; cnt = 0u; mine = 0u;
#pragma unroll
        for (unsigned j = 0; j < 16; ++j) { const unsigned c = xb_ld(&bar[XB_XCNT(j)]); sum += c; cnt += (c > 0u) ? 1u : 0u; mine = (j == x) ? c : mine; }
        if (sum == G) break;
        __builtin_amdgcn_s_sleep(1);
        if ((++sp & 255u) == 0u) { if (xb_ld(&bar[XB_TMO])) break; if (sp > XB_SPIN_CAP) { atomicAdd(&bar[XB_TMO], 1u); break; } }
    }
    nloc = mine > 0u ? mine : 1u; nx = cnt > 0u ? cnt : 1u;
}
DEVI void xcd_barrier(const XcdBarrier& b) {
    asm volatile("s_waitcnt vmcnt(0)" ::: "memory");
    __syncthreads();
    if (threadIdx.x == 0) {
        unsigned* bar = b.bar;
        __builtin_amdgcn_s_waitcnt(0);
        unsigned nloc = b.st[0], nx = b.st[1];
        if (nloc == 0u) { xcd_barrier_complete(bar, b.x, nloc, nx); b.st[0] = nloc; b.st[1] = nx; }
        const unsigned old = xb_add(&bar[XB_XSUB(b.x)], 1u);
        const unsigned gen = old / nloc;
        if (old + 1u == (gen + 1u) * nloc) {
            __builtin_amdgcn_fence(__ATOMIC_RELEASE, "agent");
            asm volatile("s_waitcnt vmcnt(0)" ::: "memory");
            const unsigned og = xb_add(&bar[XB_TOP], 1u);
            const unsigned tg = og / nx;
            if (og + 1u == (tg + 1u) * nx) xb_add(&bar[XB_TOPGEN], 1u);
            else XB_SPIN(xb_ld(&bar[XB_TOPGEN]) == tg, bar);
            __builtin_amdgcn_fence(__ATOMIC_ACQUIRE, "agent");
            xb_add(&bar[XB_XGEN(b.x)], 1u);
            asm volatile("s_waitcnt vmcnt(0)" ::: "memory");
        } else {
            XB_SPIN(xb_ld(&bar[XB_XGEN(b.x)]) == gen, bar);
            __builtin_amdgcn_fence(__ATOMIC_ACQUIRE, "agent");
            asm volatile("s_waitcnt vmcnt(0)" ::: "memory");
        }
    }
    __syncthreads();
}

__global__ void __launch_bounds__(NTHREADS) mega(Params p) {
    extern __shared__ __attribute__((aligned(16))) unsigned char lds[];
    unsigned char* ws = p.ws;
    {
        volatile LAS unsigned* stw = (volatile LAS unsigned*)(lds + LDS_BYTES - 16);
        if (threadIdx.x < 4) stw[threadIdx.x] = 0u;
    }
    __syncthreads();
    XcdBarrier gbar = xcd_barrier_post((unsigned*)(ws + OFF_BAR), (volatile LAS unsigned*)(lds + LDS_BYTES - 16));
    const int tid = threadIdx.x, lane = tid & 63, w = tid >> 6;
    const int nb = gridDim.x, bid = blockIdx.x;
#define MOD ((float*)(p.ws + OFF_MOD))
#define HX ((bf16_t*)((unsigned char*)p.out + DO_HX))
#define HC ((bf16_t*)((unsigned char*)p.out + DO_HC))
#define PROJ1 ((bf16_t*)(p.ws + OFF_PROJ1))
#define PROJC ((bf16_t*)(p.ws + OFF_PROJC))
#define CKV ((bf16_t*)(p.ws + OFF_CKV))
#define AB ((float*)(p.ws + OFF_AB))
#define ABC ((float*)(p.ws + OFF_ABC))
#define S5ST ((float*)(p.ws + OFF_S5ST))
#define DNST ((float*)(p.ws + OFF_DNST))
#define YF ((bf16_t*)(p.ws + OFF_YF))
#define YB ((bf16_t*)(p.ws + OFF_YB))
#define OF ((bf16_t*)(p.ws + OFF_OF))
#define OB ((bf16_t*)(p.ws + OFF_OB))
#define WIN1 ((const bf16_t*)(p.ws + OFF_WIN1))
#define WIN2 ((const bf16_t*)(p.ws + OFF_WIN2))
#ifndef PROBE_PHASE
#define PROBE_PHASE -1
#endif
#define NREP(k) ((k) == PROBE_PHASE ? 2 : 1)
#define IN(k) (p.ph_lo <= (k) && (k) < p.ph_hi)
#define SEAM(k) do { if (rep_ + 1 == NREP(k) && (k) + 1 < p.ph_hi) xcd_barrier(gbar); } while (0)

    if (IN(0)) for (int rep_ = 0; rep_ < NREP(0); ++rep_) {
        phase_adaln(p, MOD, lds);
        __syncthreads();
        phase_weights(p, lds);
        SEAM(0);
    }
    if (IN(1)) for (int rep_ = 0; rep_ < NREP(1); ++rep_) {
        modulate_rows<16>(p.in[0], NT, TL, p.in[6], MOD, MOD + 1024, 6144, HX);
        modulate_rows<2>(p.in[2], NC, TCX, p.in[6], MOD + 16 * 6144, MOD + 16 * 6144 + 1024, 0, HC);
        SEAM(1);
    }
    if (IN(2)) for (int rep_ = 0; rep_ < NREP(2); ++rep_) {
        {
            pg8::Gemm g{HX, WIN1, NT, 3584, 1024}; pg8::StaticOrder S; S.init(NT, 3584, nb, bid); pg8::EpiStore16 E{PROJ1, LD1};
            pg8::gemm_phase<pg8::EpiStore16, pg8::StaticOrder, true, true>((PG8_LAS unsigned char*)lds, g, S, E);
        }
        const int nctxb = nb >= 256 ? 160 : nb;
        if (bid < nctxb) {
            pg8::Gemm g{HC, WIN1, NC, 2560, 1024}; pg8::StaticOrder S; S.init(NC, 2560, nctxb, bid); pg8::EpiStore16 E{PROJC, LDC};
            pg8::gemm_phase<pg8::EpiStore16, pg8::StaticOrder, true, true>((PG8_LAS unsigned char*)lds, g, S, E);
        }
        __syncthreads();
        {
            const int nab = nb - nctxb;
            const int t0 = nab > 0 ? (bid >= nctxb ? bid - nctxb : 256 + 32) : bid;
            const int stride = nab > 0 ? nab : nb;
            for (int t = t0; t < 256 + 32; t += stride) {
                if (t < 256) gemm_tile(HX, 1024, WIN1, 1024, 1024, t * 128, 3584, lds, [=](int row, int col, float v) { if (col < 3584 + 32) AB[(size_t)row * 32 + (col - 3584)] = v; });
                else gemm_tile(HC, 1024, WIN1, 1024, 1024, (t - 256) * 128, 3584, lds, [=](int row, int col, float v) { if (col < 3584 + 32) ABC[(size_t)row * 32 + (col - 3584)] = v; });
            }
        }
        SEAM(2);
    }
    if (IN(3)) for (int rep_ = 0; rep_ < NREP(3); ++rep_) {
        const float* cw = p.in[21];
        const int nlat = NB * 32 * 3 * 8, nctx = NB * 4 * 2 * 8;
        for (int it = w * nb + bid; it < nlat + nctx; it += nb * 8) {
            if (it < nlat) {
                const int head = it & 7, type = (it >> 3) % 3, br = it / 24;
                const int scol = (type == 0 ? 512 : (type == 1 ? 1536 : 2560)) + head * 128;
                if (type == 1) conv_wave<false>(PROJ1, LD1, br * 64, false, false, scol, PROJ1, LD1, scol, cw, type * 1024 + head * 128, 1.f);
                else conv_wave<true>(PROJ1, LD1, br * 64, false, false, scol, PROJ1, LD1, scol, cw, type * 1024 + head * 128, type == 2 ? 0.08838834764831845f : 1.f);
            } else {
                const int i2 = it - nlat;
                const int head = i2 & 7, type = (i2 >> 3) & 1, bt = i2 >> 4;
                const int tt = bt & 3;
                const int scol = (type == 0 ? 512 : 1536) + head * 128;
                if (type == 1) conv_wave<false>(PROJC, LDC, bt * 64, tt > 0, tt < 3, scol, CKV, 2048, type * 1024 + head * 128, cw, type * 1024 + head * 128, 1.f);
                else conv_wave<true>(PROJC, LDC, bt * 64, tt > 0, tt < 3, scol, CKV, 2048, type * 1024 + head * 128, cw, type * 1024 + head * 128, 1.f);
            }
        }
        SEAM(3);
    }
    if (IN(4)) for (int rep_ = 0; rep_ < NREP(4); ++rep_) {
        for (int u = bid; u < 256; u += nb) {
            const int dir = u & 1, head = (u >> 1) & 7, b = u >> 4;
            dn_chunked<false>(p, CKV + head * 128, CKV + 1024 + head * 128, nullptr, 2048, ABC, b * TCX, TCX, head, dir, nullptr,
                   DNST + (size_t)u * 128 * 128, nullptr, lds);
        }
        for (int u = w * nb + bid; u < 512; u += nb * 8) {
            const int dir = u & 1, g = (u >> 1) & 31, bp = u >> 6;
            s5_mfma<false>(p, PROJC, LDC, TCX, bp, g, dir, nullptr, S5ST, nullptr, lds + w * 20480);
        }
        SEAM(4);
    }
    if (IN(5)) for (int rep_ = 0; rep_ < NREP(5); ++rep_) {
        for (int u = bid; u < 256; u += nb) {
            const int dir = u & 1, head = (u >> 1) & 7, b = u >> 4;
            dn_chunked<true>(p, PROJ1 + 512 + head * 128, PROJ1 + 1536 + head * 128, PROJ1 + 2560 + head * 128, LD1, AB, b * TL, TL, head, dir,
                   DNST + (size_t)u * 128 * 128, nullptr, dir ? OB : OF, lds);
        }
        __syncthreads();
        for (int u = w * nb + bid; u < 512; u += nb * 8) {
            const int dir = u & 1, g = (u >> 1) & 31, bp = u >> 6;
            s5_mfma<true>(p, PROJ1, LD1, TL, bp, g, dir, S5ST, nullptr, dir ? YB : YF, lds + w * 20480);
        }
        if (w >= 2) {
            convert_table_fp8_sliced(p.in[30], ws + OFF_UT, PEER_USCALE, bid * 384 + (tid - 128), nb * 384);
            convert_table_fp8_sliced(p.in[31], ws + OFF_UT + (size_t)16384 * 1024, PEER_VSCALE, bid * 384 + (tid - 128), nb * 384);
        }
        __syncthreads();
        SEAM(5);
    }
#define PROJ2 ((bf16_t*)(p.ws + OFF_PROJ2))
#define Y5 ((bf16_t*)(p.ws + OFF_Y5))
    if (IN(6)) for (int rep_ = 0; rep_ < NREP(6); ++rep_) {
        {
            pg8::Gemm g{HX, WIN2, NT, 3072, 1024}; pg8::StaticOrder S; S.init(NT, 3072, nb, bid); pg8::EpiStore16 E{PROJ2, LD2};
            pg8::gemm_phase<pg8::EpiStore16, pg8::StaticOrder, true, true>((PG8_LAS unsigned char*)lds, g, S, E);
        }
        for (size_t i = (size_t)bid * NTHREADS + tid; i < (size_t)NT * 512 / 2; i += (size_t)nb * NTHREADS) {
            const unsigned a = ((const unsigned*)YF)[i], b2 = ((const unsigned*)YB)[i];
            const float y0 = __uint_as_float(a << 16) + __uint_as_float(b2 << 16);
            const float y1 = __uint_as_float(a & 0xffff0000u) + __uint_as_float(b2 & 0xffff0000u);
            ((unsigned*)Y5)[i] = pack2(gelu_(y0), gelu_(y1));
        }
        SEAM(6);
    }
#define Y5G ((bf16_t*)(p.ws + OFF_Y5G))
#define YDN ((bf16_t*)(p.ws + OFF_YDN))
    if (IN(7)) for (int rep_ = 0; rep_ < NREP(7); ++rep_) {
#define GLUW ((const bf16_t*)(p.ws + OFF_GLU))
        const float* glub = p.in[20];
        {
            pg8::Gemm g{Y5, GLUW, NT, 512, 512}; pg8::StaticOrder S; S.init(NT, 512, nb, bid); pg8::EpiGate<0> E{Y5G, 512, Y5, 512, 0, glub};
            pg8::gemm_phase<pg8::EpiGate<0>, pg8::StaticOrder, true, true>((PG8_LAS unsigned char*)lds, g, S, E);
        }
        const float* dnw = p.in[24];
        for (int tok = bid * 8 + w; tok < NT; tok += nb * 8) {
#pragma unroll
            for (int i = 0; i < 2; ++i) {
                const int col = i * 512 + lane * 8;
                const uint4 a = *(const uint4*)(OF + (size_t)tok * 1024 + col);
                const uint4 b2 = *(const uint4*)(OB + (size_t)tok * 1024 + col);
                const uint4 zz = *(const uint4*)(PROJ2 + (size_t)tok * LD2 + col);
                float o[8], z[8];
                o[0] = __uint_as_float(a.x << 16) + __uint_as_float(b2.x << 16); o[1] = __uint_as_float(a.x & 0xffff0000u) + __uint_as_float(b2.x & 0xffff0000u);
                o[2] = __uint_as_float(a.y << 16) + __uint_as_float(b2.y << 16); o[3] = __uint_as_float(a.y & 0xffff0000u) + __uint_as_float(b2.y & 0xffff0000u);
                o[4] = __uint_as_float(a.z << 16) + __uint_as_float(b2.z << 16); o[5] = __uint_as_float(a.z & 0xffff0000u) + __uint_as_float(b2.z & 0xffff0000u);
                o[6] = __uint_as_float(a.w << 16) + __uint_as_float(b2.w << 16); o[7] = __uint_as_float(a.w & 0xffff0000u) + __uint_as_float(b2.w & 0xffff0000u);
                z[0] = __uint_as_float(zz.x << 16); z[1] = __uint_as_float(zz.x & 0xffff0000u);
                z[2] = __uint_as_float(zz.y << 16); z[3] = __uint_as_float(zz.y & 0xffff0000u);
                z[4] = __uint_as_float(zz.z << 16); z[5] = __uint_as_float(zz.z & 0xffff0000u);
                z[6] = __uint_as_float(zz.w << 16); z[7] = __uint_as_float(zz.w & 0xffff0000u);
                float ss = 0.f;
#pragma unroll
                for (int c = 0; c < 8; ++c) ss += o[c] * o[c];
                ss += __shfl_xor(ss, 1); ss += __shfl_xor(ss, 2); ss += __shfl_xor(ss, 4); ss += __shfl_xor(ss, 8);
                const float r = rsqrtf(ss * (1.f / 128.f) + 1e-6f);
                float y[8];
#pragma unroll
                for (int c = 0; c < 8; ++c) y[c] = o[c] * r * dnw[(lane & 15) * 8 + c] * silu_(z[c]);
                uint4 ov;
                ov.x = pack2(y[0], y[1]); ov.y = pack2(y[2], y[3]); ov.z = pack2(y[4], y[5]); ov.w = pack2(y[6], y[7]);
                *(uint4*)(YDN + (size_t)tok * 1024 + col) = ov;
            }
        }
        SEAM(7);
    }
#define MERGED ((bf16_t*)(p.ws + OFF_MERGED))
    if (IN(8)) for (int rep_ = 0; rep_ < NREP(8); ++rep_) {
#define WB5 ((const bf16_t*)(p.ws + OFF_WB5))
#define WBDN ((const bf16_t*)(p.ws + OFF_WBDN))
        {
            pg8::Gemm g{Y5G, WB5, NT, 1024, 512}; pg8::StaticOrder S; S.init(NT, 1024, nb, bid); pg8::EpiGate<1> E{MERGED, 1024, PROJ2, LD2, 1024, nullptr};
            pg8::gemm_phase<pg8::EpiGate<1>, pg8::StaticOrder, true, true>((PG8_LAS unsigned char*)lds, g, S, E);
        }
        {
            pg8::Gemm g{YDN, WBDN, NT, 1024, 1024}; pg8::StaticOrder S; S.init(NT, 1024, nb, bid); pg8::EpiGate<2> E{MERGED, 1024, PROJ2, LD2, 2048, nullptr};
            pg8::gemm_phase<pg8::EpiGate<2>, pg8::StaticOrder, true, true>((PG8_LAS unsigned char*)lds, g, S, E);
        }
        SEAM(8);
    }
    bf16_t* XMIX = (bf16_t*)p.out;
    if (IN(9)) for (int rep_ = 0; rep_ < NREP(9); ++rep_) {
#define WOUT ((const bf16_t*)(p.ws + OFF_WOUT))
        {
            pg8::Gemm g{MERGED, WOUT, NT, 1024, 1024}; pg8::StaticOrder S; S.init(NT, 1024, nb, bid); pg8::EpiStore16 E{XMIX, 1024};
            pg8::gemm_phase<pg8::EpiStore16, pg8::StaticOrder, true, true>((PG8_LAS unsigned char*)lds, g, S, E);
        }
        SEAM(9);
    }
#define X1 ((bf16_t*)(p.ws + OFF_X1))
#define HX2 ((bf16_t*)(p.ws + OFF_HX2))
    if (IN(10)) for (int rep_ = 0; rep_ < NREP(10); ++rep_) {
        const float* x = p.in[0];
        const float* npm = p.in[7];
        const float* npf = p.in[8];
        for (int run = bid * 8 + w; run < NT / 16; run += nb * 8) {
            const int row0 = run * 16;
            const float* mb = MOD + (size_t)(row0 / TL) * 6144;
            float4 c1[4], c2[4], c3[4];
#pragma unroll
            for (int i = 0; i < 4; ++i) {
                const int d = lane * 4 + 256 * i;
                const float4 g = *(const float4*)(mb + 2 * 1024 + d), nw = *(const float4*)(npm + d);
                const float4 gn = *(const float4*)(npf + d), scl = *(const float4*)(mb + 4 * 1024 + d);
                c1[i] = make_float4(g.x * nw.x, g.y * nw.y, g.z * nw.z, g.w * nw.w);
                c2[i] = make_float4(gn.x * (1.f + scl.x), gn.y * (1.f + scl.y), gn.z * (1.f + scl.z), gn.w * (1.f + scl.w));
                c3[i] = *(const float4*)(mb + 3 * 1024 + d);
            }
            uint2 nm[4]; float4 nx[4];
#pragma unroll
            for (int i = 0; i < 4; ++i) {
                nm[i] = *(const uint2*)(XMIX + (size_t)row0 * 1024 + lane * 4 + 256 * i);
                nx[i] = *(const float4*)(x + (size_t)row0 * 1024 + lane * 4 + 256 * i);
            }
#pragma unroll 1
            for (int rr = 0; rr < 16; ++rr) {
                const int row = row0 + rr;
                float4 xm[4], xv[4];
                float ss = 0.f;
#pragma unroll
                for (int i = 0; i < 4; ++i) {
                    xm[i] = make_float4(__uint_as_float(nm[i].x << 16), __uint_as_float(nm[i].x & 0xffff0000u), __uint_as_float(nm[i].y << 16), __uint_as_float(nm[i].y & 0xffff0000u));
                    xv[i] = nx[i];
                    ss += xm[i].x * xm[i].x + xm[i].y * xm[i].y + xm[i].z * xm[i].z + xm[i].w * xm[i].w;
                }
                if (rr + 1 < 16) {
#pragma unroll
                    for (int i = 0; i < 4; ++i) {
                        nm[i] = *(const uint2*)(XMIX + (size_t)(row + 1) * 1024 + lane * 4 + 256 * i);
                        nx[i] = *(const float4*)(x + (size_t)(row + 1) * 1024 + lane * 4 + 256 * i);
                    }
                }
                ss = wave_sum_u(ss);
                const float r = rsqrtf(ss * (1.f / 1024.f) + 1e-6f);
                float4 x1[4];
                float s2 = 0.f;
#pragma unroll
                for (int i = 0; i < 4; ++i) {
                    const int d = lane * 4 + 256 * i;
                    x1[i].x = xv[i].x + c1[i].x * xm[i].x * r;
                    x1[i].y = xv[i].y + c1[i].y * xm[i].y * r;
                    x1[i].z = xv[i].z + c1[i].z * xm[i].z * r;
                    x1[i].w = xv[i].w + c1[i].w * xm[i].w * r;
                    s2 += x1[i].x * x1[i].x + x1[i].y * x1[i].y + x1[i].z * x1[i].z + x1[i].w * x1[i].w;
                    { uint2 t_; t_.x = pack2(x1[i].x, x1[i].y); t_.y = pack2(x1[i].z, x1[i].w); *(uint2*)(X1 + (size_t)row * 1024 + d) = t_; }
                }
                s2 = wave_sum_u(s2);
                const float r2 = rsqrtf(s2 * (1.f / 1024.f) + 1e-6f);
#pragma unroll
                for (int i = 0; i < 4; ++i) {
                    const int d = lane * 4 + 256 * i;
                    uint2 o;
                    o.x = pack2(x1[i].x * r2 * c2[i].x + c3[i].x, x1[i].y * r2 * c2[i].y + c3[i].y);
                    o.y = pack2(x1[i].z * r2 * c2[i].z + c3[i].z, x1[i].w * r2 * c2[i].w + c3[i].w);
                    *(uint2*)(HX2 + (size_t)row * 1024 + d) = o;
                }
            }
        }
        SEAM(10);
    }
#define QP ((bf16_t*)(p.ws + OFF_QP))
    if (IN(11)) for (int rep_ = 0; rep_ < NREP(11); ++rep_) {
#define WQ ((const bf16_t*)(p.ws + OFF_WQ))
        {
            pg8::Gemm g{HX2, WQ, NT, 2048, 1024}; pg8::StaticOrder S; S.init(NT, 2048, nb, bid); pg8::EpiStore16 E{QP, 2048};
            pg8::gemm_phase<pg8::EpiStore16, pg8::StaticOrder, true, true>((PG8_LAS unsigned char*)lds, g, S, E);
        }
        SEAM(11);
    }
#define IDX ((int*)(p.ws + OFF_IDX))
#define GATE ((float*)(p.ws + OFF_GATE))
    if (IN(12)) for (int rep_ = 0; rep_ < NREP(12); ++rep_) {
        phase_topk(p, QP, IDX, GATE, lds);
        SEAM(12);
    }
#define PART ((float*)(p.ws + OFF_QP))
#define pctr ((unsigned*)(p.ws + OFF_BAR))
    if (IN(13)) for (int rep_ = 0; rep_ < NREP(13); ++rep_) {
        phase_peer_u(HX2, IDX, PART, ws + OFF_UT, pctr, lds);
        SEAM(13);
    }
    if (IN(14)) for (int rep_ = 0; rep_ < NREP(14); ++rep_) {
        phase_peer_w(PART, GATE);
        SEAM(14);
    }
    if (IN(15)) for (int rep_ = 0; rep_ < NREP(15); ++rep_) {
        phase_peer_v(IDX, GATE, (bf16_t*)(ws + OFF_QP), ws + OFF_UT + (size_t)16384 * 1024, pctr + 8, lds);
        SEAM(15);
    }
    if (IN(16)) for (int rep_ = 0; rep_ < NREP(16); ++rep_) {
        phase_peer_final(p, X1, (const bf16_t*)(ws + OFF_QP), MOD, p.out);
    }
}

constexpr int NPHASES = 17;

extern "C" void kernel_launch(void* const* d_in, const int* in_sizes, int n_in, void* d_out, int out_size, void* d_ws, size_t ws_size,
                              hipStream_t stream) {
    static int grid_blocks = 0;
    if (grid_blocks == 0) {
        if (n_in != 32 || ws_size < WS_END || out_size != NT * DM) {
            fprintf(stderr, "kernel_launch: unexpected sizes n_in=%d ws=%zu (need %zu) out=%d\n", n_in, ws_size, (size_t)WS_END, out_size);
            grid_blocks = -1;
            return;
        }
        int dev = 0, cus = 0, per_cu = 0;
        hipGetDevice(&dev);
        hipDeviceGetAttribute(&cus, hipDeviceAttributeMultiprocessorCount, dev);
        hipFuncSetAttribute((const void*)mega, hipFuncAttributeMaxDynamicSharedMemorySize, LDS_BYTES);
        hipOccupancyMaxActiveBlocksPerMultiprocessor(&per_cu, (const void*)mega, NTHREADS, LDS_BYTES);
        if (per_cu < 1) { fprintf(stderr, "kernel_launch: occupancy query says %d blocks/CU\n", per_cu); per_cu = 1; }
        grid_blocks = cus;
        fprintf(stderr, "kernel_launch: cus=%d per_cu=%d grid=%d ws=%zu need=%zu\n", cus, per_cu, grid_blocks, ws_size, (size_t)WS_END);
    }
    if (grid_blocks < 0) return;
    Params p{};
    for (int i = 0; i < 32; ++i) p.in[i] = (const float*)d_in[i];
    p.out = (float*)d_out;
    p.ws = (unsigned char*)d_ws;
    p.ph_lo = 0; p.ph_hi = NPHASES;
    void* args[] = {&p};
    if (hipMemsetAsync((unsigned char*)d_ws + OFF_BAR, 0, (size_t)XCD_BAR_WORDS * 4, stream) != hipSuccess) { fprintf(stderr, "kernel_launch: memset of barrier words failed\n"); return; }
    hipError_t e = hipLaunchCooperativeKernel((const void*)mega, dim3(grid_blocks), dim3(NTHREADS), args, LDS_BYTES, stream);
    if (e != hipSuccess) fprintf(stderr, "cooperative launch failed: %s (grid %d)\n", hipGetErrorString(e), grid_blocks);
#if defined(PROBE_EXTRA_PHASE)
    {
        Params q = p; q.ph_lo = PROBE_EXTRA_PHASE; q.ph_hi = PROBE_EXTRA_PHASE + 1;
        void* args2[] = {&q};
        hipLaunchCooperativeKernel((const void*)mega, dim3(grid_blocks), dim3(NTHREADS), args2, LDS_BYTES, stream);
    }
#endif
}
```

```cpp
#include <hip/hip_runtime.h>
#include <hip/hip_bf16.h>
#include <hip/hip_cooperative_groups.h>
#include <cstdio>
namespace cg = cooperative_groups;

typedef unsigned short bf16_t;
using bf16x8 = __attribute__((ext_vector_type(8))) short;
using f32x4 = __attribute__((ext_vector_type(4))) float;
typedef __bf16 bf16x2_t __attribute__((ext_vector_type(2)));
using f32x16 = __attribute__((ext_vector_type(16))) float;

#define DEVI __device__ __forceinline__

constexpr int NB = 16, TL = 2048, DM = 1024, NT = NB * TL, TCX = 256, NC = NB * TCX;
constexpr int LD1 = 3584;
constexpr int LDC = 2560;
constexpr int LD2 = 3072;
constexpr int W1ROWS = 3712;
constexpr int NTHREADS = 512;
constexpr int LDS_BYTES = 139264;

constexpr size_t al256(size_t x) { return (x + 255) & ~(size_t)255; }
constexpr size_t OFF_WIN1 = 0;
constexpr size_t OFF_WIN2 = OFF_WIN1 + al256((size_t)W1ROWS * 1024 * 2);
constexpr size_t OFF_GLU  = OFF_WIN2 + al256((size_t)3072 * 1024 * 2);
constexpr size_t OFF_WB5  = OFF_GLU + al256((size_t)512 * 512 * 2);
constexpr size_t OFF_WBDN = OFF_WB5 + al256((size_t)1024 * 512 * 2);
constexpr size_t OFF_WOUT = OFF_WBDN + al256((size_t)1024 * 1024 * 2);
constexpr size_t OFF_WQ   = OFF_WOUT + al256((size_t)1024 * 1024 * 2);
constexpr size_t OFF_MOD  = OFF_WQ + al256((size_t)2048 * 1024 * 2);
constexpr size_t OFF_AB   = OFF_MOD + al256((size_t)17 * 6144 * 4);
constexpr size_t OFF_ABC  = OFF_AB + al256((size_t)NT * 32 * 4);
constexpr size_t OFF_S5ST = OFF_ABC + al256((size_t)NC * 32 * 4);
constexpr size_t OFF_DNST = OFF_S5ST + al256((size_t)NB * 32 * 2 * 64 * 2 * 4);
constexpr size_t OFF_PROJC = OFF_DNST + al256((size_t)NB * 8 * 2 * 128 * 128 * 4);
constexpr size_t OFF_CKV  = OFF_PROJC + al256((size_t)NC * LDC * 2);
constexpr size_t OFF_YF   = OFF_CKV + al256((size_t)NC * 2048 * 2);
constexpr size_t OFF_YB   = OFF_YF + al256((size_t)NT * 512 * 2);
constexpr size_t OFF_OF   = OFF_YB + al256((size_t)NT * 512 * 2);
constexpr size_t OFF_OB   = OFF_OF + al256((size_t)NT * 1024 * 2);
constexpr size_t OFF_PROJ1 = OFF_OB + al256((size_t)NT * 1024 * 2);
constexpr size_t OFF_BAR  = OFF_PROJ1 + al256((size_t)NT * LD1 * 2);
constexpr size_t WS_END   = OFF_BAR + al256((size_t)3456 * 4);
constexpr size_t OFF_PROJ2 = OFF_PROJ1;
constexpr size_t OFF_X1   = OFF_PROJ1;
constexpr size_t OFF_HX2  = OFF_PROJ1 + al256((size_t)NT * 1024 * 4);
constexpr size_t OFF_Y5   = OFF_YF;
constexpr size_t OFF_Y5G  = OFF_YB;
constexpr size_t OFF_YDN  = OFF_OF;
constexpr size_t OFF_MERGED = OFF_OB;
constexpr size_t OFF_QP   = OFF_OF;
constexpr size_t OFF_IDX  = OFF_YF;
constexpr size_t OFF_GATE = OFF_YB;
constexpr size_t OFF_UT   = OFF_PROJC;
constexpr size_t OFF_VT   = OFF_PROJC;
static_assert(OFF_HX2 + (size_t)NT * 1024 * 2 <= OFF_BAR, "alias overflow");
static_assert(OFF_UT + (size_t)16384 * 1024 * 2 <= OFF_YF, "UT overflow");
static_assert(OFF_VT + (size_t)16384 * 1024 * 2 <= OFF_YF, "VT overflow");
static_assert((size_t)NT * 128 * 4 <= (size_t)NT * 512 * 2, "idx alias");
constexpr size_t DO_HX = 0;
constexpr size_t DO_HC = (size_t)NT * 1024 * 2;

struct Params {
    const float* in[32];
    float* out;
    unsigned char* ws;
    int ph_lo, ph_hi;
};

DEVI float bf2f(bf16_t v) { return __uint_as_float(((unsigned)v) << 16); }
typedef float f32x2_t __attribute__((ext_vector_type(2)));
DEVI unsigned pack2(float a, float b) {
    const f32x2_t v = {a, b};
    return __builtin_bit_cast(unsigned, __builtin_convertvector(v, bf16x2_t));
}
DEVI bf16_t f2bf(float f) { return (bf16_t)(pack2(f, 0.f) & 0xffffu); }
DEVI float sigmoid_(float x) { return 1.f / (1.f + __expf(-x)); }
DEVI float silu_(float x) { return x / (1.f + __expf(-x)); }
DEVI float gelu_(float x) {
    float u = 0.7978845608028654f * (x + 0.044715f * x * x * x);
    return 0.5f * x * (1.f + tanhf(u));
}
DEVI float softplus_(float x) { return x > 20.f ? x : log1pf(__expf(x)); }
DEVI float wave_sum(float v) {
#pragma unroll
    for (int m = 32; m >= 1; m >>= 1) v += __shfl_xor(v, m);
    return v;
}
DEVI float wave_max(float v) {
#pragma unroll
    for (int m = 32; m >= 1; m >>= 1) v = fmaxf(v, __shfl_xor(v, m));
    return v;
}
DEVI float readlane_f(float v, int l) { return __int_as_float(__builtin_amdgcn_readlane(__float_as_int(v), l)); }

template <class Epi>
DEVI void gemm_tile(const bf16_t* A, int lda, const bf16_t* Bt, int ldb, int K, int m0, int n0,
                    unsigned char* lds, Epi epi) {
    constexpr int ST = 144;
    unsigned char* As = lds;
    unsigned char* Bs = lds + 128 * ST;
    const int tid = threadIdx.x, lane = tid & 63, w = tid >> 6, wm = w >> 2, wn = w & 3;
    f32x4 acc[4][2];
#pragma unroll
    for (int mi = 0; mi < 4; ++mi)
#pragma unroll
        for (int ni = 0; ni < 2; ++ni) acc[mi][ni] = (f32x4){0.f, 0.f, 0.f, 0.f};
    uint4 ra0, ra1, rb0, rb1;
    const int nk = K >> 6;
    const int lrow0 = tid >> 3, lkc = (tid & 7) * 8;
    const bf16_t* Ap = A + (size_t)(m0 + lrow0) * lda + lkc;
    const bf16_t* Bp = Bt + (size_t)(n0 + lrow0) * ldb + lkc;
    const size_t a64 = (size_t)64 * lda, b64 = (size_t)64 * ldb;
    ra0 = *(const uint4*)(Ap); ra1 = *(const uint4*)(Ap + a64);
    rb0 = *(const uint4*)(Bp); rb1 = *(const uint4*)(Bp + b64);
    for (int kt = 0; kt < nk; ++kt) {
        __syncthreads();
        *(uint4*)(As + lrow0 * ST + lkc * 2) = ra0;
        *(uint4*)(As + (lrow0 + 64) * ST + lkc * 2) = ra1;
        *(uint4*)(Bs + lrow0 * ST + lkc * 2) = rb0;
        *(uint4*)(Bs + (lrow0 + 64) * ST + lkc * 2) = rb1;
        __syncthreads();
        if (kt + 1 < nk) {
            const int ko = (kt + 1) * 64;
            ra0 = *(const uint4*)(Ap + ko); ra1 = *(const uint4*)(Ap + a64 + ko);
            rb0 = *(const uint4*)(Bp + ko); rb1 = *(const uint4*)(Bp + b64 + ko);
        }
#pragma unroll
        for (int ks = 0; ks < 2; ++ks) {
            bf16x8 af[4], bfr[2];
            const int kb = (ks * 32 + 8 * (lane >> 4)) * 2;
#pragma unroll
            for (int mi = 0; mi < 4; ++mi) af[mi] = *(const bf16x8*)(As + (wm * 64 + mi * 16 + (lane & 15)) * ST + kb);
#pragma unroll
            for (int ni = 0; ni < 2; ++ni) bfr[ni] = *(const bf16x8*)(Bs + (wn * 32 + ni * 16 + (lane & 15)) * ST + kb);
#pragma unroll
            for (int mi = 0; mi < 4; ++mi)
#pragma unroll
                for (int ni = 0; ni < 2; ++ni)
                    acc[mi][ni] = __builtin_amdgcn_mfma_f32_16x16x32_bf16(af[mi], bfr[ni], acc[mi][ni], 0, 0, 0);
        }
    }
#pragma unroll
    for (int mi = 0; mi < 4; ++mi)
#pragma unroll
        for (int ni = 0; ni < 2; ++ni)
#pragma unroll
            for (int r = 0; r < 4; ++r) {
                const int row = m0 + wm * 64 + mi * 16 + (lane >> 4) * 4 + r;
                const int col = n0 + wn * 32 + ni * 16 + (lane & 15);
                epi(row, col, acc[mi][ni][r]);
                if (r == 3) __builtin_amdgcn_sched_barrier(0);
            }
    __syncthreads();
}

DEVI void phase_adaln(const Params& p, float* MOD, unsigned char* lds) {
    float* sc = (float*)lds;
    float* red = sc + 17 * 1024;
    const int tid = threadIdx.x;
    const float* c = p.in[1];
    const float* cctx = p.in[3];
    const float* w_mod = p.in[4];
    const float* b_mod = p.in[5];
    const int nab = (int)gridDim.x < 192 ? (int)gridDim.x : 192;
    if ((int)blockIdx.x >= nab) return;
    for (int i = tid; i < 17 * 1024; i += NTHREADS) {
        int r = i >> 10, d = i & 1023;
        float v = r < 16 ? c[r * 1024 + d] : cctx[d];
        sc[i] = silu_(v);
    }
    __syncthreads();
    for (int item = blockIdx.x; item < 192; item += nab) {
        const int cc = tid & 31, kg = tid >> 5;
        const int col = item * 32 + cc;
        float acc[17];
#pragma unroll
        for (int r = 0; r < 17; ++r) acc[r] = 0.f;
        for (int k8 = kg * 64; k8 < kg * 64 + 64; k8 += 8) {
            float wv[8];
#pragma unroll
            for (int u = 0; u < 8; ++u) wv[u] = w_mod[(size_t)(k8 + u) * 6144 + col];
#pragma unroll
            for (int u = 0; u < 8; ++u)
#pragma unroll
                for (int r = 0; r < 17; ++r) acc[r] += sc[r * 1024 + k8 + u] * wv[u];
        }
#pragma unroll
        for (int r = 0; r < 17; ++r) red[(kg * 17 + r) * 32 + cc] = acc[r];
        __syncthreads();
        for (int o = tid; o < 17 * 32; o += NTHREADS) {
            const int r = o >> 5, c2 = o & 31;
            float s = b_mod[item * 32 + c2];
            for (int g = 0; g < 16; ++g) s += red[(g * 17 + r) * 32 + c2];
            MOD[r * 6144 + item * 32 + c2] = s;
        }
        __syncthreads();
    }
}

DEVI void conv_seg(const float* src, int K, int ldsrc, int col0, int ncols, bf16_t* dst, int drow0, unsigned char* lds, int vb, int nvb) {
    float* tile = (float*)lds;
    const int tid = threadIdx.x;
    const int ntn = (ncols + 63) >> 6, ntk = K >> 6;
    const int r0 = tid >> 4, c4 = (tid & 15) * 4;
    float4 v0, v1;
    auto tload = [&](int t) {
        const int tn = t / ntk, tk = t % ntk;
        const int n0 = tn * 64, k0 = tk * 64;
        v0 = make_float4(0.f, 0.f, 0.f, 0.f); v1 = v0;
        if (n0 + c4 < ncols) {
            v0 = *(const float4*)(src + (size_t)(k0 + r0) * ldsrc + col0 + n0 + c4);
            v1 = *(const float4*)(src + (size_t)(k0 + r0 + 32) * ldsrc + col0 + n0 + c4);
        }
    };
    if (vb < ntn * ntk) tload(vb);
    for (int t = vb; t < ntn * ntk; t += nvb) {
        const int tn = t / ntk, tk = t % ntk;
        const int n0 = tn * 64, k0 = tk * 64;
        __syncthreads();
        tile[r0 * 65 + c4 + 0] = v0.x; tile[r0 * 65 + c4 + 1] = v0.y; tile[r0 * 65 + c4 + 2] = v0.z; tile[r0 * 65 + c4 + 3] = v0.w;
        tile[(r0 + 32) * 65 + c4 + 0] = v1.x; tile[(r0 + 32) * 65 + c4 + 1] = v1.y; tile[(r0 + 32) * 65 + c4 + 2] = v1.z; tile[(r0 + 32) * 65 + c4 + 3] = v1.w;
        __syncthreads();
        if (t + nvb < ntn * ntk) tload(t + nvb);
        {
            const int n = tid >> 3, kq = (tid & 7) * 8;
            if (n0 + n < ncols) {
                uint4 o;
                o.x = pack2(tile[(kq + 0) * 65 + n], tile[(kq + 1) * 65 + n]);
                o.y = pack2(tile[(kq + 2) * 65 + n], tile[(kq + 3) * 65 + n]);
                o.z = pack2(tile[(kq + 4) * 65 + n], tile[(kq + 5) * 65 + n]);
                o.w = pack2(tile[(kq + 6) * 65 + n], tile[(kq + 7) * 65 + n]);
                *(uint4*)(dst + (size_t)(drow0 + n0 + n) * K + k0 + kq) = o;
            }
        }
    }
    __syncthreads();
}

DEVI void phase_weights(const Params& p, unsigned char* lds) {
    unsigned char* ws = p.ws;
    bf16_t* WIN1 = (bf16_t*)(ws + OFF_WIN1);
    bf16_t* WIN2 = (bf16_t*)(ws + OFF_WIN2);
    const int nvb = gridDim.x;
    const int vb = ((int)blockIdx.x + nvb - 192 % nvb) % nvb;
    const float* w_in = p.in[10];
    conv_seg(w_in, 1024, 6688, 0, 2560, WIN1, 0, lds, vb, nvb);
    conv_seg(w_in, 1024, 6688, 2592, 1024, WIN1, 2560, lds, vb, nvb);
    conv_seg(w_in, 1024, 6688, 2560, 32, WIN1, 3584, lds, vb, nvb);
    conv_seg(w_in, 1024, 6688, 3616, 3072, WIN2, 0, lds, vb, nvb);
    conv_seg(p.in[19], 512, 512, 0, 512, (bf16_t*)(ws + OFF_GLU), 0, lds, vb, nvb);
    conv_seg(p.in[25], 512, 1024, 0, 1024, (bf16_t*)(ws + OFF_WB5), 0, lds, vb, nvb);
    conv_seg(p.in[26], 1024, 1024, 0, 1024, (bf16_t*)(ws + OFF_WBDN), 0, lds, vb, nvb);
    conv_seg(p.in[27], 1024, 1024, 0, 1024, (bf16_t*)(ws + OFF_WOUT), 0, lds, vb, nvb);
    conv_seg(p.in[28], 1024, 2048, 0, 2048, (bf16_t*)(ws + OFF_WQ), 0, lds, vb, nvb);
    {
        uint4* z = (uint4*)(WIN1 + (size_t)3616 * 1024);
        const int n16 = 96 * 1024 * 2 / 16;
        for (int i = vb * NTHREADS + threadIdx.x; i < n16; i += nvb * NTHREADS) z[i] = make_uint4(0, 0, 0, 0);
    }
}

template <int RUN>
DEVI void modulate_rows(const float* X, int nrows, int rows_per_batch, const float* gain, const float* shift0, const float* scale0,
                        int bstride, bf16_t* OUT) {
    const int lane = threadIdx.x & 63, w = threadIdx.x >> 6;
    for (int run = blockIdx.x * 8 + w; run < nrows / RUN; run += gridDim.x * 8) {
        const int row0 = run * RUN;
        const int b = row0 / rows_per_batch;
        const float* sh = shift0 + (size_t)b * bstride;
        const float* scl = scale0 + (size_t)b * bstride;
        float4 c1[4], c2[4];
#pragma unroll
        for (int i = 0; i < 4; ++i) {
            const int d = lane * 4 + 256 * i;
            const float4 g = *(const float4*)(gain + d), s = *(const float4*)(scl + d);
            c1[i] = make_float4(g.x * (1.f + s.x), g.y * (1.f + s.y), g.z * (1.f + s.z), g.w * (1.f + s.w));
            c2[i] = *(const float4*)(sh + d);
        }
        float4 nv[4];
#pragma unroll
        for (int i = 0; i < 4; ++i) nv[i] = *(const float4*)(X + (size_t)row0 * 1024 + lane * 4 + 256 * i);
#pragma unroll 1
        for (int rr = 0; rr < RUN; ++rr) {
            const int row = row0 + rr;
            float4 v[4];
            float ss = 0.f;
#pragma unroll
            for (int i = 0; i < 4; ++i) {
                v[i] = nv[i];
                ss += v[i].x * v[i].x + v[i].y * v[i].y + v[i].z * v[i].z + v[i].w * v[i].w;
            }
            if (rr + 1 < RUN) {
#pragma unroll
                for (int i = 0; i < 4; ++i) nv[i] = *(const float4*)(X + (size_t)(row + 1) * 1024 + lane * 4 + 256 * i);
            }
            ss = wave_sum(ss);
            const float r = rsqrtf(ss * (1.f / 1024.f) + 1e-6f);
#pragma unroll
            for (int i = 0; i < 4; ++i) {
                const int d = lane * 4 + 256 * i;
                uint2 o;
                o.x = pack2(v[i].x * r * c1[i].x + c2[i].x, v[i].y * r * c1[i].y + c2[i].y);
                o.y = pack2(v[i].z * r * c1[i].z + c2[i].z, v[i].w * r * c1[i].w + c2[i].w);
                *(uint2*)(OUT + (size_t)row * 1024 + d) = o;
            }
        }
    }
}


template <bool READOUT>
DEVI void s5_mfma(const Params& p, const bf16_t* U, int ldu, int Tlen, int bp, int g, int dir,
                  const float* S5in, float* S5out, bf16_t* Y, unsigned char* wl  ) {
    constexpr int HST = 272;
    unsigned char* Himg = wl;
    const int lane = threadIdx.x & 63;
    const int p0 = lane & 31, hf = lane >> 5;
    const int dg = dir * 32 + g;
    const float step = expf(p.in[13][dg]);
    float ar[2], ai[2], hr[2], hi[2];
    bf16x8 Bf[4];
#pragma unroll
    for (int pt = 0; pt < 2; ++pt) {
        const int pp = dg * 64 + pt * 32 + p0;
        const float lr = p.in[11][pp], li = p.in[12][pp];
        const float mag = expf(lr * step);
        ar[pt] = mag * cosf(li * step); ai[pt] = mag * sinf(li * step);
        const float den = lr * lr + li * li;
        const float fr = ((ar[pt] - 1.f) * lr + ai[pt] * li) / den;
        const float fi = (ai[pt] * lr - (ar[pt] - 1.f) * li) / den;
        bf16x8 bre, bim;
#pragma unroll
        for (int j = 0; j < 8; ++j) {
            const float br = p.in[14][pp * 16 + 8 * hf + j], bi = p.in[15][pp * 16 + 8 * hf + j];
            bre[j] = (short)f2bf(fr * br - fi * bi);
            bim[j] = (short)f2bf(fr * bi + fi * br);
        }
        Bf[pt] = bre; Bf[2 + pt] = bim;
        hr[pt] = 0.f; hi[pt] = 0.f;
    }
    const int myb = 2 * bp + hf;
    if (S5in) {
        const float* h0 = S5in + (size_t)((myb * 32 + g) * 2 + dir) * 128;
#pragma unroll
        for (int pt = 0; pt < 2; ++pt) { hr[pt] = h0[pt * 32 + p0]; hi[pt] = h0[64 + pt * 32 + p0]; }
    }
    bf16x8 Cf[4], Df;
    if (READOUT) {
        const int h = lane & 15, kq = lane >> 4;
#pragma unroll
        for (int ks = 0; ks < 4; ++ks) {
            bf16x8 c;
#pragma unroll
            for (int j = 0; j < 8; ++j) {
                const int pl = ks * 8 + 2 * kq + (j >> 2), tile = j & 3;
                const int pidx = (dg * 16 + h) * 64 + (tile & 1) * 32 + pl;
                const float v = (tile < 2) ? p.in[16][pidx] : -p.in[17][pidx];
                c[j] = (short)f2bf(v);
            }
            Cf[ks] = c;
        }
#pragma unroll
        for (int j = 0; j < 8; ++j) {
            const int k = 8 * kq + j;
            Df[j] = (short)((k == h) ? f2bf(p.in[18][g * 16 + h]) : (bf16_t)0);
        }
    }
    const int m = lane & 31, kh = lane >> 5;
    const int ahf = (m >> 2) & 1, ai_tok = (m & 3) + 4 * (m >> 3);
    const int ab = 2 * bp + ahf;
    const int nblk = Tlen >> 4;
    const bf16_t* Ubase = U + (size_t)ab * Tlen * ldu + g * 16 + 8 * kh;
    auto tok_of = [&](int blk, int i) -> int {
        const int t0 = dir ? (Tlen - 16 * (blk + 1)) : 16 * blk;
        return dir ? (t0 + 15 - i) : (t0 + i);
    };
    auto scan_block = [&](const uint4& acur, int buf) {
        const bf16x8 af = __builtin_bit_cast(bf16x8, acur);
        f32x16 X[4];
#pragma unroll
        for (int t = 0; t < 4; ++t) {
            f32x16 z;
#pragma unroll
            for (int r = 0; r < 16; ++r) z[r] = 0.f;
            X[t] = __builtin_amdgcn_mfma_f32_32x32x16_bf16(af, Bf[t], z, 0, 0, 0);
        }
        unsigned char* Hb = Himg + buf * (32 * HST + 1024);
        if (READOUT && dir == 0) *(uint4*)(Hb + 32 * HST + (ahf * 16 + ai_tok) * 32 + kh * 16) = acur;
#pragma unroll
        for (int r = 0; r < 16; ++r) {
#pragma unroll
            for (int pt = 0; pt < 2; ++pt) {
                const float nr = ar[pt] * hr[pt] - ai[pt] * hi[pt] + X[pt][r];
                const float ni = ar[pt] * hi[pt] + ai[pt] * hr[pt] + X[2 + pt][r];
                hr[pt] = nr; hi[pt] = ni;
                X[pt][r] = nr; X[2 + pt][r] = ni;
            }
            if (READOUT) {
                uint2 o;
                o.x = pack2(X[0][r], X[1][r]);
                o.y = pack2(X[2][r], X[3][r]);
                *(uint2*)(Hb + (hf * 16 + r) * HST + p0 * 8) = o;
            }
        }
    };
    uint4 anext = *(const uint4*)(Ubase + (size_t)tok_of(0, ai_tok) * ldu);
    {
        const uint4 a0 = anext;
        if (nblk > 1) anext = *(const uint4*)(Ubase + (size_t)tok_of(1, ai_tok) * ldu);
        scan_block(a0, 0);
    }
    for (int blk = 0; blk < nblk; ++blk) {
        const int buf = blk & 1;
        f32x4 yacc[2];
        if (READOUT) {
            const int kq = lane >> 4;
            const unsigned char* Hb = Himg + buf * (32 * HST + 1024);
#pragma unroll
            for (int hb = 0; hb < 2; ++hb) {
                yacc[hb] = (f32x4){0.f, 0.f, 0.f, 0.f};
#pragma unroll
                for (int ks = 0; ks < 4; ++ks) {
                    const bf16x8 hfrag = *(const bf16x8*)(Hb + (hb * 16 + (lane & 15)) * HST + (ks * 32 + 8 * kq) * 2);
                    yacc[hb] = __builtin_amdgcn_mfma_f32_16x16x32_bf16(hfrag, Cf[ks], yacc[hb], 0, 0, 0);
                }
                if (dir == 0) {
                    uint4 uu = make_uint4(0, 0, 0, 0);
                    if (kq < 2) uu = *(const uint4*)(Hb + 32 * HST + (hb * 16 + (lane & 15)) * 32 + kq * 16);
                    yacc[hb] = __builtin_amdgcn_mfma_f32_16x16x32_bf16(__builtin_bit_cast(bf16x8, uu), Df, yacc[hb], 0, 0, 0);
                }
            }
        }
        if (blk + 1 < nblk) {
            const uint4 acur = anext;
            if (blk + 2 < nblk) anext = *(const uint4*)(Ubase + (size_t)tok_of(blk + 2, ai_tok) * ldu);
            scan_block(acur, buf ^ 1);
        }
        if (READOUT) {
            const int h = lane & 15, kq = lane >> 4;
#pragma unroll
            for (int hb = 0; hb < 2; ++hb) {
                const int ob = 2 * bp + hb;
#pragma unroll
                for (int r = 0; r < 4; ++r) {
                    const int tok = tok_of(blk, 4 * kq + r);
                    Y[((size_t)ob * Tlen + tok) * 512 + g * 16 + h] = f2bf(yacc[hb][r]);
                }
            }
        }
    }
    if (S5out) {
        float* ho = S5out + (size_t)((myb * 32 + g) * 2 + dir) * 128;
#pragma unroll
        for (int pt = 0; pt < 2; ++pt) { ho[pt * 32 + p0] = hr[pt]; ho[64 + pt * 32 + p0] = hi[pt]; }
    }
}

template <int CTRL>
DEVI float dpp_add(float v) {
    const int iv = __float_as_int(v);
    const int r = __builtin_amdgcn_update_dpp(0, iv, CTRL, 0xf, 0xf, true);
    return v + __int_as_float(r);
}
DEVI float red8(float v) {
    v = dpp_add<0xB1>(v);
    v = dpp_add<0x4E>(v);
    v = dpp_add<0x141>(v);
    return v;
}

#ifndef DN_DUP
#define DN_DUP -1
#endif
typedef short s16x4 __attribute__((ext_vector_type(4)));
DEVI int pos32(int x) { return ((x >> 2) & 3) * 8 + (x >> 4) * 4 + (x & 3); }
DEVI unsigned cvtpk(float lo, float hi) { return pack2(lo, hi); }
DEVI s16x4 cvt4(const f32x4& v) { uint2 t; t.x = cvtpk(v[0], v[1]); t.y = cvtpk(v[2], v[3]); return __builtin_bit_cast(s16x4, t); }
DEVI bf16x8 cvt8(const f32x4& a, const f32x4& b) { uint4 t; t.x = cvtpk(a[0], a[1]); t.y = cvtpk(a[2], a[3]); t.z = cvtpk(b[0], b[1]); t.w = cvtpk(b[2], b[3]); return __builtin_bit_cast(bf16x8, t); }
DEVI f32x4 mfma16(const s16x4& a, const s16x4& b, const f32x4& c) { return __builtin_amdgcn_mfma_f32_16x16x16bf16_1k(a, b, c, 0, 0, 0); }
DEVI f32x4 mfma32(const bf16x8& a, const bf16x8& b, const f32x4& c) { return __builtin_amdgcn_mfma_f32_16x16x32_bf16(a, b, c, 0, 0, 0); }

DEVI s16x4 lds_tr_read(const unsigned char* p) { return __builtin_amdgcn_ds_read_tr16_b64_v4i16((__attribute__((address_space(3))) s16x4*)p); }
DEVI void lds_barrier() { asm volatile("s_waitcnt lgkmcnt(0)" ::: "memory"); __builtin_amdgcn_s_barrier(); asm volatile("" ::: "memory"); }
template <bool HAS_Q>
DEVI void dn_chunked(const Params& p, const bf16_t* Kg, const bf16_t* Vg, const bf16_t* Qg, int ld, const float* AB, int tokbase, int Tlen,
                     int head, int dir, const float* S0, float* Sout, bf16_t* O, unsigned char* lds) {
    constexpr int RS = 272, TS = 144, BS = 40;
    constexpr int KP_OFF = 0, QP_OFF = 17408, WP_OFF = 34816, KT_OFF = 52224, VT_OFF = 70656, AT_OFF = 89088, AB_OFF = 98304,
                  AF_OFF = 107520, TN_OFF = 111872, TSW_OFF = 114432, TSU_OFF = 116992, GT_OFF = 119552, OT_OFF = 120848;
    float* gt = (float*)(lds + GT_OFF);
    const int tid = threadIdx.x, lane = tid & 63, w = tid >> 6;
    const int m = lane & 15, q = lane >> 4;
    f32x4 S[8];
#pragma unroll
    for (int mt = 0; mt < 8; ++mt) {
        if (S0) {
#pragma unroll
            for (int r = 0; r < 4; ++r) S[mt][r] = S0[(size_t)(16 * mt + 4 * q + r) * 128 + 16 * w + m];
        } else S[mt] = (f32x4){0.f, 0.f, 0.f, 0.f};
    }
    const float aexp = expf(p.in[22][dir * 8 + head]);
    const float dtb = p.in[23][dir * 8 + head];
    const int nch = Tlen >> 6;
    uint4 rk0, rk1, rq0, rq1, rv0, rv1; float rg = 0.f, rb = 0.f;
    rq0 = make_uint4(0, 0, 0, 0); rq1 = rq0;
    auto gload = [&](int ci) {
        const int cb = dir ? (nch - 1 - ci) : ci;
        const size_t tok = (size_t)(tokbase + cb * 64 + (dir ? (63 - lane) : lane));
        const bf16_t* kp = Kg + tok * ld + 16 * w;
        const bf16_t* vp = Vg + tok * ld + 16 * w;
        rk0 = *(const uint4*)kp; rk1 = *(const uint4*)(kp + 8);
        rv0 = *(const uint4*)vp; rv1 = *(const uint4*)(vp + 8);
        if (HAS_Q) { const bf16_t* qp = Qg + tok * ld + 16 * w; rq0 = *(const uint4*)qp; rq1 = *(const uint4*)(qp + 8); }
        if (w == 0) { rg = AB[tok * 32 + (2 * dir) * 8 + head]; rb = AB[tok * 32 + (2 * dir + 1) * 8 + head]; }
    };
    gload(0);
    for (int ci = 0; ci < nch; ++ci) {
        for (int dup0_ = 0; dup0_ < (DN_DUP == 0 ? 2 : 1); ++dup0_)
        {
            const int Bk = w >> 1, tk = w & 1;
            unsigned char* kr = lds + KP_OFF + lane * RS + 2 * (32 * Bk + 4 * tk);
            *(uint2*)(kr + 0)  = make_uint2(rk0.x, rk0.y);
            *(uint2*)(kr + 16) = make_uint2(rk0.z, rk0.w);
            *(uint2*)(kr + 32) = make_uint2(rk1.x, rk1.y);
            *(uint2*)(kr + 48) = make_uint2(rk1.z, rk1.w);
            if (HAS_Q) {
                unsigned char* qr = lds + QP_OFF + lane * RS + 2 * (32 * Bk + 4 * tk);
                *(uint2*)(qr + 0)  = make_uint2(rq0.x, rq0.y);
                *(uint2*)(qr + 16) = make_uint2(rq0.z, rq0.w);
                *(uint2*)(qr + 32) = make_uint2(rq1.x, rq1.y);
                *(uint2*)(qr + 48) = make_uint2(rq1.z, rq1.w);
            }
            {
                unsigned char* vr = lds + VT_OFF + lane * RS + 32 * w;
                *(uint4*)(vr) = rv0; *(uint4*)(vr + 16) = rv1;
            }
            if (w == 0) {
                float g = -aexp * softplus_(rg + dtb);
#pragma unroll
                for (int d = 1; d < 64; d <<= 1) { const float t = __shfl_up(g, d); if (lane >= d) g += t; }
                const float glast = __shfl(g, 63);
                const float beta = sigmoid_(rb), eg = __expf(g);
                gt[lane] = g; gt[64 + lane] = eg; gt[128 + lane] = beta; gt[192 + lane] = __expf(glast - g); gt[256 + lane] = beta * eg;
                if (lane == 0) gt[320] = __expf(glast);
            }
        }
        if (ci + 1 < nch) gload(ci + 1);
        lds_barrier();
        auto gram_job = [&](int type, int t10) {
            const int ct = (t10 >= 6) ? 3 : (t10 >= 3) ? 2 : (t10 >= 1) ? 1 : 0;
            const int st = t10 - ct * (ct + 1) / 2;
            const unsigned char* xa = lds + (type ? QP_OFF : KP_OFF) + (16 * ct + m) * RS + 16 * q;
            const unsigned char* xb = lds + KP_OFF + (16 * st + m) * RS + 16 * q;
            bf16x8 fa[4], fb[4];
#pragma unroll
            for (int B = 0; B < 4; ++B) { fa[B] = *(const bf16x8*)(xa + 64 * B); fb[B] = *(const bf16x8*)(xb + 64 * B); }
            f32x4 acc = (f32x4){0.f, 0.f, 0.f, 0.f};
#pragma unroll
            for (int B = 0; B < 4; ++B) acc = mfma32(fa[B], fb[B], acc);
            const int sidx = 16 * st + m;
            const float gs = gt[sidx];
#pragma unroll
            for (int r = 0; r < 4; ++r) {
                const int c = 16 * ct + 4 * q + r;
                const float dec = __expf(fminf(gt[c] - gs, 0.f));
                if (type == 0) {
                    const float a = (sidx < c) ? gt[128 + c] * acc[r] * dec : 0.f;
                    *(unsigned short*)(lds + AB_OFF + c * TS + 2 * sidx) = f2bf(a);
                    if (ct == st) *(float*)(lds + AF_OFF + ((ct * 16 + (c & 15)) * 17 + m) * 4) = a;
                } else {
                    const float a = (sidx <= c) ? acc[r] * dec : 0.f;
                    *(unsigned short*)(lds + AT_OFF + c * TS + 2 * (32 * (sidx >> 5) + pos32(sidx & 31))) = f2bf(a);
                }
            }
        };
        for (int dup1_ = 0; dup1_ < (DN_DUP == 1 ? 2 : 1); ++dup1_) for (int j = w; j < 10; j += 8) gram_job(0, j);
        lds_barrier();
        if (w == 0) for (int dup2_ = 0; dup2_ < (DN_DUP == 2 ? 2 : 1); ++dup2_) {
            const int r = q, col = m;
            const float* af = (const float*)(lds + AF_OFF) + r * 16 * 17;
            float t[16];
#pragma unroll
            for (int i = 0; i < 16; ++i) t[i] = (i == col) ? 1.f : 0.f;
#pragma unroll
            for (int jj = 0; jj < 15; ++jj) {
#pragma unroll
                for (int i = jj + 1; i < 16; ++i) t[i] -= af[i * 17 + jj] * t[jj];
                if ((jj & 1) == 1) __builtin_amdgcn_sched_barrier(0);
            }
            const float sw = gt[256 + 16 * r + col], su = gt[128 + 16 * r + col];
#pragma unroll
            for (int i = 0; i < 16; ++i) {
                *(unsigned short*)(lds + TN_OFF + (r * 16 + i) * BS + 2 * col) = f2bf(-t[i]);
                *(unsigned short*)(lds + TSW_OFF + (r * 16 + i) * BS + 2 * col) = f2bf(t[i] * sw);
                *(unsigned short*)(lds + TSU_OFF + (r * 16 + i) * BS + 2 * col) = f2bf(t[i] * su);
            }
        } else if (HAS_Q) {
            for (int j = w - 1; j < 10; j += 7) gram_job(1, j);
            for (int idx = tid - 64; idx < 6 * 256; idx += NTHREADS - 64) {
                const int tile = idx >> 8, e = idx & 255;
                const int ct = (tile < 3) ? 0 : (tile < 5) ? 1 : 2;
                const int st = (tile < 3) ? tile + 1 : (tile < 5) ? tile - 1 : 3;
                const int c = 16 * ct + (e >> 4), sidx = 16 * st + (e & 15);
                *(unsigned short*)(lds + AT_OFF + c * TS + 2 * (32 * (sidx >> 5) + pos32(sidx & 31))) = 0;
            }
        }
        lds_barrier();
        f32x4 vn[4];
        for (int dup3_ = 0; dup3_ < (DN_DUP == 3 ? 2 : 1); ++dup3_) {
            const int tq = (lane & 15) >> 2, tp = lane & 3;
            const unsigned char* xtk = lds + KP_OFF + (4 * q + tq) * RS + 2 * (32 * (w >> 1) + 8 * tp + 4 * (w & 1));
            const unsigned char* xtv = lds + VT_OFF + (4 * q + tq) * RS + 2 * (16 * w + 4 * tp);
            s16x4 XbW[4], XbU[4];
            f32x4 XW[4];
#pragma unroll
            for (int r = 0; r < 4; ++r) {
                const s16x4 a_tw = *(const s16x4*)(lds + TSW_OFF + (r * 16 + m) * BS + 8 * q);
                const s16x4 a_tu = *(const s16x4*)(lds + TSU_OFF + (r * 16 + m) * BS + 8 * q);
                const s16x4 b_k = lds_tr_read(xtk + 16 * r * RS);
                const s16x4 b_v = lds_tr_read(xtv + 16 * r * RS);
                XW[r] = mfma16(a_tw, b_k, (f32x4){0.f, 0.f, 0.f, 0.f});
                vn[r] = mfma16(a_tu, b_v, (f32x4){0.f, 0.f, 0.f, 0.f});
                if (r > 0) {
                    f32x4 accW = (f32x4){0.f, 0.f, 0.f, 0.f}, accU = (f32x4){0.f, 0.f, 0.f, 0.f};
#pragma unroll
                    for (int c = 0; c < r; ++c) {
                        const s16x4 a_ab = *(const s16x4*)(lds + AB_OFF + (16 * r + m) * TS + 2 * (16 * c + 4 * q));
                        accW = mfma16(a_ab, XbW[c], accW);
                        accU = mfma16(a_ab, XbU[c], accU);
                    }
                    const s16x4 a_tn = *(const s16x4*)(lds + TN_OFF + (r * 16 + m) * BS + 8 * q);
                    XW[r] = mfma16(a_tn, cvt4(accW), XW[r]);
                    vn[r] = mfma16(a_tn, cvt4(accU), vn[r]);
                }
                XbW[r] = cvt4(XW[r]);
                XbU[r] = cvt4(vn[r]);
            }
            const int colpos = 32 * (w >> 1) + pos32(16 * (w & 1) + m);
#pragma unroll
            for (int r = 0; r < 4; ++r)
#pragma unroll
                for (int rr = 0; rr < 4; ++rr)
                    *(unsigned short*)(lds + WP_OFF + (16 * r + 4 * q + rr) * RS + 2 * colpos) = f2bf(-XW[r][rr]);
        }
        lds_barrier();
        bf16x8 Sf[4];
#pragma unroll
        for (int B = 0; B < 4; ++B) Sf[B] = cvt8(S[2 * B], S[2 * B + 1]);
#pragma unroll
        for (int r = 0; r < 4; ++r) {
            bf16x8 wf[4];
#pragma unroll
            for (int B = 0; B < 4; ++B) wf[B] = *(const bf16x8*)(lds + WP_OFF + (16 * r + m) * RS + 64 * B + 16 * q);
#pragma unroll
            for (int B = 0; B < 4; ++B) vn[r] = mfma32(wf[B], Sf[B], vn[r]);
        }
        if (HAS_Q) {
            const int cb = dir ? (nch - 1 - ci) : ci;
            f32x4 o[4];
#pragma unroll
            for (int r = 0; r < 4; ++r) o[r] = (f32x4){0.f, 0.f, 0.f, 0.f};
#pragma unroll
            for (int r = 0; r < 4; ++r) {
                bf16x8 qf[4];
#pragma unroll
                for (int B = 0; B < 4; ++B) qf[B] = *(const bf16x8*)(lds + QP_OFF + (16 * r + m) * RS + 64 * B + 16 * q);
#pragma unroll
                for (int B = 0; B < 4; ++B) o[r] = mfma32(qf[B], Sf[B], o[r]);
            }
            const bf16x8 Vn0 = cvt8(vn[0], vn[1]), Vn1 = cvt8(vn[2], vn[3]);
            bf16x8 af0[4], af1[2];
#pragma unroll
            for (int r = 0; r < 4; ++r) af0[r] = *(const bf16x8*)(lds + AT_OFF + (16 * r + m) * TS + 16 * q);
#pragma unroll
            for (int r = 2; r < 4; ++r) af1[r - 2] = *(const bf16x8*)(lds + AT_OFF + (16 * r + m) * TS + 64 + 16 * q);
#pragma unroll
            for (int r = 0; r < 4; ++r) {
                const f32x4 egv = *(const f32x4*)(gt + 64 + 16 * r + 4 * q);
                o[r] = o[r] * egv;
            }
#pragma unroll
            for (int r = 0; r < 4; ++r) o[r] = mfma32(af0[r], Vn0, o[r]);
#pragma unroll
            for (int r = 2; r < 4; ++r) o[r] = mfma32(af1[r - 2], Vn1, o[r]);
            unsigned char* ot = lds + OT_OFF + w * 2048;
#pragma unroll
            for (int r = 0; r < 4; ++r)
#pragma unroll
                for (int rr = 0; rr < 4; ++rr) *(unsigned short*)(ot + (16 * r + 4 * q + rr) * 32 + 2 * m) = f2bf(o[r][rr]);
            {
                const uint4 o0 = *(const uint4*)(ot + lane * 32), o1 = *(const uint4*)(ot + lane * 32 + 16);
                const size_t tok = (size_t)(tokbase + cb * 64 + (dir ? (63 - lane) : lane));
                bf16_t* op = O + tok * 1024 + head * 128 + 16 * w;
                *(uint4*)op = o0; *(uint4*)(op + 8) = o1;
            }
        }
        {
            f32x4 vk[4];
#pragma unroll
            for (int r = 0; r < 4; ++r) {
                const f32x4 kdv = *(const f32x4*)(gt + 192 + 16 * r + 4 * q);
                vk[r] = vn[r] * kdv;
            }
            const bf16x8 Vk0 = cvt8(vk[0], vk[1]), Vk1 = cvt8(vk[2], vk[3]);
            const float eS = gt[320];
#pragma unroll
            for (int mt = 0; mt < 8; ++mt) S[mt] = S[mt] * eS;
            const int tq = (lane & 15) >> 2, tp = lane & 3;
#pragma unroll
            for (int hh = 0; hh < 2; ++hh) {
                s16x4 kf[4][4];
#pragma unroll
                for (int mi = 0; mi < 4; ++mi) {
                    const int mt = 4 * hh + mi;
                    const unsigned char* kr = lds + KP_OFF + (4 * q + tq) * RS + 2 * (32 * (mt >> 1) + 8 * tp + 4 * (mt & 1));
                    kf[mi][0] = lds_tr_read(kr); kf[mi][1] = lds_tr_read(kr + 16 * RS); kf[mi][2] = lds_tr_read(kr + 32 * RS); kf[mi][3] = lds_tr_read(kr + 48 * RS);
                }
#pragma unroll
                for (int mi = 0; mi < 4; ++mi) {
                    const uint2 a0 = __builtin_bit_cast(uint2, kf[mi][0]), a1 = __builtin_bit_cast(uint2, kf[mi][1]);
                    S[4 * hh + mi] = mfma32(__builtin_bit_cast(bf16x8, make_uint4(a0.x, a0.y, a1.x, a1.y)), Vk0, S[4 * hh + mi]);
                }
#pragma unroll
                for (int mi = 0; mi < 4; ++mi) {
                    const uint2 a2 = __builtin_bit_cast(uint2, kf[mi][2]), a3 = __builtin_bit_cast(uint2, kf[mi][3]);
                    S[4 * hh + mi] = mfma32(__builtin_bit_cast(bf16x8, make_uint4(a2.x, a2.y, a3.x, a3.y)), Vk1, S[4 * hh + mi]);
                }
            }
        }
        lds_barrier();
    }
    if (Sout) {
#pragma unroll
        for (int mt = 0; mt < 8; ++mt)
#pragma unroll
            for (int r = 0; r < 4; ++r) Sout[(size_t)(16 * mt + 4 * q + r) * 128 + 16 * w + m] = S[mt][r];
    }
}

DEVI void cswap_desc(float& a, float& b) { const float hi = fmaxf(a, b), lo = fminf(a, b); a = hi; b = lo; }
DEVI void sort16_desc(float (&v)[16]) {
#pragma unroll
    for (int k = 2; k <= 16; k <<= 1)
#pragma unroll
        for (int j = k >> 1; j > 0; j >>= 1)
#pragma unroll
            for (int i = 0; i < 16; ++i) {
                const int l = i ^ j;
                if (l > i) {
                    if ((i & k) == 0) cswap_desc(v[i], v[l]); else cswap_desc(v[l], v[i]);
                }
            }
}
DEVI void merge16_desc(float (&a)[16], const float (&b)[16]) {
#pragma unroll
    for (int i = 0; i < 16; ++i) a[i] = fmaxf(a[i], b[15 - i]);
#pragma unroll
    for (int j = 8; j > 0; j >>= 1)
#pragma unroll
        for (int i = 0; i < 16; ++i) {
            const int l = i ^ j;
            if (l > i) cswap_desc(a[i], a[l]);
        }
}

DEVI void phase_topk(const Params& p, const bf16_t* QP, int* IDX, float* GV, unsigned char* lds) {
    constexpr int KST = 272;
    const int tid = threadIdx.x, lane = tid & 63, w = tid >> 6;
    const int nb = gridDim.x;
    const int head = blockIdx.x & 7;
    const int bsub = blockIdx.x >> 3, nsub = (nb + 7 - head) / 8;
    const float* sk = p.in[29] + (size_t)head * 2 * 128 * 128;
    __syncthreads();
    for (int i = tid; i < 256 * 32; i += NTHREADS) {
        const int row = i >> 5, d4 = (i & 31) * 4;
        const float4 v = *(const float4*)(sk + row * 128 + d4);
        uint2 o; o.x = pack2(v.x, v.y); o.y = pack2(v.z, v.w);
        *(uint2*)(lds + row * KST + d4 * 2) = o;
    }
    __syncthreads();
    const int hf = lane >> 5, tl = lane & 31;
    for (int tile = bsub * 8 + w; tile < NT / 32; tile += nsub * 8) {
        const int tok = tile * 32 + tl;
        float L[2][16];
#pragma unroll
        for (int jj = 0; jj < 2; ++jj) {
            const bf16_t* qrow = QP + (size_t)tok * 2048 + head * 256 + jj * 128 + 8 * hf;
            uint4 bq[8];
#pragma unroll
            for (int ks = 0; ks < 8; ++ks) bq[ks] = *(const uint4*)(qrow + ks * 16);
            f32x16 acc[4];
#pragma unroll
            for (int kt = 0; kt < 4; ++kt)
#pragma unroll
                for (int r = 0; r < 16; ++r) acc[kt][r] = 0.f;
#pragma unroll
            for (int ks = 0; ks < 8; ++ks) {
#pragma unroll
                for (int kt = 0; kt < 4; ++kt) {
                    const bf16x8 af = *(const bf16x8*)(lds + (jj * 128 + kt * 32 + tl) * KST + (ks * 16 + 8 * hf) * 2);
                    acc[kt] = __builtin_amdgcn_mfma_f32_32x32x16_bf16(af, __builtin_bit_cast(bf16x8, bq[ks]), acc[kt], 0, 0, 0);
                }
                __builtin_amdgcn_sched_barrier(0);
            }
            float g[4][16];
#pragma unroll
            for (int kt = 0; kt < 4; ++kt) {
#pragma unroll
                for (int r = 0; r < 16; ++r) {
                    const unsigned key = (unsigned)(32 * kt + (r & 3) + 8 * (r >> 2)) + 4u * (unsigned)hf;
                    g[kt][r] = __uint_as_float((__float_as_uint(acc[kt][r]) & 0xffffff80u) | key);
                }
                sort16_desc(g[kt]);
            }
            merge16_desc(g[0], g[1]);
            merge16_desc(g[2], g[3]);
            merge16_desc(g[0], g[2]);
            float o[16];
#pragma unroll
            for (int i = 0; i < 16; ++i) o[i] = __shfl_xor(g[0][i], 32);
            merge16_desc(g[0], o);
#pragma unroll
            for (int i = 0; i < 16; ++i) L[jj][i] = g[0][i];
        }
        float R0[16], G1[16], G2[16], G3a = 0.f, G3b = 0.f;
#pragma unroll
        for (int i = 0; i < 16; ++i) R0[i] = L[0][0] + L[1][i];
        {
            int n = 0;
#pragma unroll
            for (int a2 = 1; a2 < 16; ++a2) {
#pragma unroll
                for (int b2 = 0; b2 < 16 / (a2 + 1); ++b2) {
                    const float c = L[0][a2] + L[1][b2];
                    if (n < 16) G1[n] = c; else if (n < 32) G2[n - 16] = c; else if (n == 32) G3a = c; else G3b = c;
                    ++n;
                }
            }
        }
        sort16_desc(G1);
        sort16_desc(G2);
        merge16_desc(R0, G1);
        merge16_desc(R0, G2);
#pragma unroll
        for (int i = 0; i < 16; ++i) { cswap_desc(R0[i], G3a); }
#pragma unroll
        for (int i = 0; i < 16; ++i) { cswap_desc(R0[i], G3b); }
        const float tau = R0[15];
#pragma unroll
        for (int i = 0; i < 16; ++i) { asm volatile("" : "+v"(L[0][i])); asm volatile("" : "+v"(L[1][i])); }
        unsigned* dst = (hf ? (unsigned*)GV : (unsigned*)IDX) + (size_t)tok * 128 + head * 16;
        unsigned* slab = (unsigned*)(lds + 256 * KST + w * 4096) + lane;
        int pos = 0;
#pragma unroll
        for (int a2 = 0; a2 < 16; ++a2) {
            const unsigned i0 = (__float_as_uint(L[0][a2]) & 127u) << 7;
#pragma unroll
            for (int b2 = 0; b2 < 16 / (a2 + 1); ++b2) {
                const float c = L[0][a2] + L[1][b2];
                if (c >= tau && pos < 16) {
                    const unsigned code = i0 | (__float_as_uint(L[1][b2]) & 127u);
                    slab[pos * 64] = hf ? __float_as_uint(c) : code;
                    ++pos;
                }
            }
        }
        {
            unsigned o[16];
#pragma unroll
            for (int i = 0; i < 16; ++i) o[i] = slab[i * 64];
#pragma unroll
            for (int i = 0; i < 4; ++i) *(uint4*)(dst + 4 * i) = make_uint4(o[4 * i], o[4 * i + 1], o[4 * i + 2], o[4 * i + 3]);
        }
    }
}

typedef float float2_ __attribute__((ext_vector_type(2)));
DEVI float wave_sum_u(float v) {
    v = dpp_add<0xB1>(v); v = dpp_add<0x4E>(v); v = dpp_add<0x141>(v); v = dpp_add<0x140>(v);
    int t = __builtin_amdgcn_update_dpp(0, __float_as_int(v), 0x142, 0xA, 0xF, false); v += __int_as_float(t);
    t = __builtin_amdgcn_update_dpp(0, __float_as_int(v), 0x143, 0xC, 0xF, false); v += __int_as_float(t);
    return readlane_f(v, 63);
}

constexpr float PEER_USCALE = 256.f, PEER_VSCALE = 64.f;


DEVI void convert_table_fp8_sliced(const float* src, unsigned char* dst, float scale, int wid, int nwork) {
    const size_t n16 = (size_t)16384 * 1024 / 16;
    for (size_t i = (size_t)wid; i < n16; i += (size_t)nwork) {
        const size_t e = i >> 6; const int d0 = (int)(i & 63) * 16;
        float4 v[4];
#pragma unroll
        for (int j = 0; j < 4; ++j) v[j] = *(const float4*)(src + e * 1024 + d0 + j * 4);
        unsigned o[4];
#pragma unroll
        for (int j = 0; j < 4; ++j) {
            const float x0 = fminf(fmaxf(v[j].x * scale, -448.f), 448.f), x1 = fminf(fmaxf(v[j].y * scale, -448.f), 448.f);
            const float x2 = fminf(fmaxf(v[j].z * scale, -448.f), 448.f), x3 = fminf(fmaxf(v[j].w * scale, -448.f), 448.f);
            int pk = __builtin_amdgcn_cvt_pk_fp8_f32(x0, x1, 0, false);
            pk = __builtin_amdgcn_cvt_pk_fp8_f32(x2, x3, pk, true);
            o[j] = (unsigned)pk;
        }
        *(uint4*)(dst + ((size_t)(d0 >> 7) * 16384 + e) * 128 + (d0 & 127)) = make_uint4(o[0], o[1], o[2], o[3]);
    }
}
DEVI unsigned peer_xcc_id() { return (unsigned)__builtin_amdgcn_s_getreg((3 << 11) | 20) & 0xFu; }
constexpr int PEER_CHUNK_TOK = 512;
template <class F>
DEVI void peer_claim_loop(unsigned* ctr, unsigned char* lds, F body) {
    const unsigned xcc = peer_xcc_id() & 7u;
    volatile unsigned* bc = (volatile unsigned*)(lds + LDS_BYTES - 64);
    for (unsigned s = 0; s < 8; ++s) {
        const unsigned slice = (xcc + s) & 7u;
        for (;;) {
            __syncthreads();
            if (threadIdx.x == 0) bc[0] = __hip_atomic_fetch_add(&ctr[16 * slice], 1u, __ATOMIC_RELAXED, __HIP_MEMORY_SCOPE_AGENT);
            __syncthreads();
            const unsigned c = bc[0];
            if (c >= (unsigned)(NT / PEER_CHUNK_TOK)) break;
            body((int)slice, (int)c);
        }
    }
}
#define PEER_ISSUE(BUF, IDL, IDH, base) do { _Pragma("unroll") for (int r_ = 0; r_ < 16; ++r_) { \
    const int id_ = __shfl(r_ < 8 ? (IDL) : (IDH), (8 * r_ + es) & 63); \
    BUF[r_] = *(const uint4*)((base) + (size_t)id_ * 128); } } while (0)
typedef _Float16 f16x2_t __attribute__((ext_vector_type(2)));
DEVI float dot16_fp8_f16(const uint4& u, const f16x2_t* h) {
    float d = 0.f;
    const float sc = 1.f / PEER_USCALE;
    d = __builtin_amdgcn_fdot2(__builtin_amdgcn_cvt_scalef32_pk_f16_fp8((int)u.x, sc, false), h[0], d, false);
    d = __builtin_amdgcn_fdot2(__builtin_amdgcn_cvt_scalef32_pk_f16_fp8((int)u.x, sc, true), h[1], d, false);
    d = __builtin_amdgcn_fdot2(__builtin_amdgcn_cvt_scalef32_pk_f16_fp8((int)u.y, sc, false), h[2], d, false);
    d = __builtin_amdgcn_fdot2(__builtin_amdgcn_cvt_scalef32_pk_f16_fp8((int)u.y, sc, true), h[3], d, false);
    d = __builtin_amdgcn_fdot2(__builtin_amdgcn_cvt_scalef32_pk_f16_fp8((int)u.z, sc, false), h[4], d, false);
    d = __builtin_amdgcn_fdot2(__builtin_amdgcn_cvt_scalef32_pk_f16_fp8((int)u.z, sc, true), h[5], d, false);
    d = __builtin_amdgcn_fdot2(__builtin_amdgcn_cvt_scalef32_pk_f16_fp8((int)u.w, sc, false), h[6], d, false);
    d = __builtin_amdgcn_fdot2(__builtin_amdgcn_cvt_scalef32_pk_f16_fp8((int)u.w, sc, true), h[7], d, false);
    return d;
}
DEVI f16x2_t bfpair_to_f16(unsigned w) { return __builtin_bit_cast(f16x2_t, __builtin_amdgcn_cvt_pkrtz(__uint_as_float(w << 16), __uint_as_float(w & 0xffff0000u))); }
template <int CTRL>
DEVI float dpp_get(float v) { return __int_as_float(__builtin_amdgcn_update_dpp(0, __float_as_int(v), CTRL, 0xf, 0xf, true)); }
DEVI void phase_peer_u(const bf16_t* HX2, const int* IDX, float* PART, const unsigned char* U8, unsigned* ctr, unsigned char* lds) {
    const int lane = threadIdx.x & 63, w = threadIdx.x >> 6;
    const int es = lane >> 3, part = lane & 7;
    const bool p0 = lane & 1, p1 = lane & 2, p2 = lane & 4;
    const int rbase = (p0 ? 8 : 0) + (p1 ? 4 : 0) + (p2 ? 2 : 0);
    peer_claim_loop(ctr, lds, [=](int x, int chunk) {
        constexpr int NTW = PEER_CHUNK_TOK / 8;
        const unsigned char* ub = U8 + (size_t)x * 16384 * 128;
        const unsigned loff = 16u * (unsigned)part;
        const int t0 = chunk * PEER_CHUNK_TOK + w * NTW;
        const bf16_t* hb = HX2 + 128 * x + 16 * part;
        uint4 u[16];
        int ilA, ihA, ilB, ihB; uint4 hA0, hA1, hB0, hB1;
#define PU_META(T, IL, IH, H0, H1) do { const int tk_ = t0 + ((T) < NTW ? (T) : NTW - 1); \
        IL = IDX[(size_t)tk_ * 128 + lane] & 16383; IH = IDX[(size_t)tk_ * 128 + 64 + lane] & 16383; \
        H0 = *(const uint4*)(hb + (size_t)tk_ * 1024); H1 = *(const uint4*)(hb + (size_t)tk_ * 1024 + 8); } while (0)
        PU_META(0, ilA, ihA, hA0, hA1);
#pragma unroll
        for (int r = 0; r < 16; ++r) u[r] = *(const uint4*)(ub + ((unsigned)__shfl(r < 8 ? ilA : ihA, (16 * (r >> 1) + 2 * es + (r & 1)) & 63) * 128u + loff));
        PU_META(1, ilB, ihB, hB0, hB1);
#pragma unroll 1
        for (int i = 0; i < NTW; ++i) {
            f16x2_t h[8];
            h[0] = bfpair_to_f16(hA0.x); h[1] = bfpair_to_f16(hA0.y); h[2] = bfpair_to_f16(hA0.z); h[3] = bfpair_to_f16(hA0.w);
            h[4] = bfpair_to_f16(hA1.x); h[5] = bfpair_to_f16(hA1.y); h[6] = bfpair_to_f16(hA1.z); h[7] = bfpair_to_f16(hA1.w);
            float d[16];
#pragma unroll
            for (int r = 0; r < 16; ++r) {
                d[r] = dot16_fp8_f16(u[r], h);
                const unsigned id = (unsigned)__shfl(r < 8 ? ilB : ihB, (16 * (r >> 1) + 2 * es + (r & 1)) & 63);
                u[r] = *(const uint4*)(ub + (id * 128u + loff));
                if ((r & 1) == 1) __builtin_amdgcn_sched_barrier(0);
            }
            float k8[8], k4[4], k2[2];
#pragma unroll
            for (int j = 0; j < 8; ++j) { const float snd = p0 ? d[j] : d[j + 8]; const float kp = p0 ? d[j + 8] : d[j]; k8[j] = kp + dpp_get<0xB1>(snd); }
#pragma unroll
            for (int j = 0; j < 4; ++j) { const float snd = p1 ? k8[j] : k8[j + 4]; const float kp = p1 ? k8[j + 4] : k8[j]; k4[j] = kp + dpp_get<0x4E>(snd); }
#pragma unroll
            for (int j = 0; j < 2; ++j) { const float snd = p2 ? k4[j] : k4[j + 2]; const float kp = p2 ? k4[j + 2] : k4[j]; k2[j] = kp + __shfl_xor(snd, 4); }
            *(float2*)(PART + ((size_t)(t0 + i) * 8 + x) * 128 + 8 * rbase + 2 * es) = make_float2(k2[0], k2[1]);
            ilA = ilB; ihA = ihB; hA0 = hB0; hA1 = hB1;
            PU_META(i + 2, ilB, ihB, hB0, hB1);
        }
#undef PU_META
    });
}
DEVI void phase_peer_w(const float* PART, float* GW) {
    const int lane = threadIdx.x & 63, w = threadIdx.x >> 6;
    for (int tok = blockIdx.x * 8 + w; tok < NT; tok += gridDim.x * 8) {
        float d0 = 0.f, d1 = 0.f;
#pragma unroll
        for (int x = 0; x < 8; ++x) { d0 += PART[((size_t)tok * 8 + x) * 128 + lane]; d1 += PART[((size_t)tok * 8 + x) * 128 + 64 + lane]; }
        float g0 = GW[(size_t)tok * 128 + lane], g1 = GW[(size_t)tok * 128 + 64 + lane];
        float m0 = g0, m1 = g1;
#pragma unroll
        for (int m = 1; m <= 8; m <<= 1) { m0 = fmaxf(m0, __shfl_xor(m0, m)); m1 = fmaxf(m1, __shfl_xor(m1, m)); }
        g0 = __expf(g0 - m0); g1 = __expf(g1 - m1);
        float s0 = g0, s1 = g1;
#pragma unroll
        for (int m = 1; m <= 8; m <<= 1) { s0 += __shfl_xor(s0, m); s1 += __shfl_xor(s1, m); }
        GW[(size_t)tok * 128 + lane] = gelu_(d0) * g0 / s0;
        GW[(size_t)tok * 128 + 64 + lane] = gelu_(d1) * g1 / s1;
    }
}
DEVI void axpy16_fp8_f16(f16x2_t* acc, const uint4& v, f16x2_t w2) {
    const float sc = 1.f / PEER_VSCALE;
    acc[0] = __builtin_amdgcn_cvt_scalef32_pk_f16_fp8((int)v.x, sc, false) * w2 + acc[0];
    acc[1] = __builtin_amdgcn_cvt_scalef32_pk_f16_fp8((int)v.x, sc, true) * w2 + acc[1];
    acc[2] = __builtin_amdgcn_cvt_scalef32_pk_f16_fp8((int)v.y, sc, false) * w2 + acc[2];
    acc[3] = __builtin_amdgcn_cvt_scalef32_pk_f16_fp8((int)v.y, sc, true) * w2 + acc[3];
    acc[4] = __builtin_amdgcn_cvt_scalef32_pk_f16_fp8((int)v.z, sc, false) * w2 + acc[4];
    acc[5] = __builtin_amdgcn_cvt_scalef32_pk_f16_fp8((int)v.z, sc, true) * w2 + acc[5];
    acc[6] = __builtin_amdgcn_cvt_scalef32_pk_f16_fp8((int)v.w, sc, false) * w2 + acc[6];
    acc[7] = __builtin_amdgcn_cvt_scalef32_pk_f16_fp8((int)v.w, sc, true) * w2 + acc[7];
}
DEVI f16x2_t shfl_xor_h2(f16x2_t v, int m) { return __builtin_bit_cast(f16x2_t, __shfl_xor(__builtin_bit_cast(int, v), m)); }
DEVI void phase_peer_v(const int* IDX, const float* GW, bf16_t* PE, const unsigned char* V8, unsigned* ctr, unsigned char* lds) {
    const int lane = threadIdx.x & 63, w = threadIdx.x >> 6;
    const int es = lane >> 3, part = lane & 7;
    const bool b3 = lane & 8, b4 = lane & 16, b5 = lane & 32;
    const int o = (b3 ? 8 : 0) + (b4 ? 4 : 0) + (b5 ? 2 : 0);
    peer_claim_loop(ctr, lds, [=](int x, int chunk) {
        constexpr int NTW = PEER_CHUNK_TOK / 8;
        const unsigned char* vb = V8 + (size_t)x * 16384 * 128;
        const unsigned loff = 16u * (unsigned)part;
        const int t0 = chunk * PEER_CHUNK_TOK + w * NTW;
        uint4 v[8];
        int il, ih, iln; float wl, wh;
        il = IDX[(size_t)t0 * 128 + lane] & 16383; ih = IDX[(size_t)t0 * 128 + 64 + lane] & 16383;
        wl = GW[(size_t)t0 * 128 + lane]; wh = GW[(size_t)t0 * 128 + 64 + lane];
#pragma unroll
        for (int r = 0; r < 8; ++r) v[r] = *(const uint4*)(vb + ((unsigned)__shfl(il, 8 * r + es) * 128u + loff));
#pragma unroll 1
        for (int i = 0; i < NTW; ++i) {
            const int tn = t0 + (i + 1 < NTW ? i + 1 : i);
            iln = IDX[(size_t)tn * 128 + lane] & 16383;
            f16x2_t acc[8];
#pragma unroll
            for (int j = 0; j < 8; ++j) acc[j] = (f16x2_t){(_Float16)0.f, (_Float16)0.f};
#pragma unroll
            for (int r = 0; r < 8; ++r) {
                const float wr = __shfl(wl, 8 * r + es);
                axpy16_fp8_f16(acc, v[r], __builtin_bit_cast(f16x2_t, __builtin_amdgcn_cvt_pkrtz(wr, wr)));
                v[r] = *(const uint4*)(vb + ((unsigned)__shfl(ih, 8 * r + es) * 128u + loff));
            }
            const float wh_c = wh;
            const int ihn = IDX[(size_t)tn * 128 + 64 + lane] & 16383;
            wl = GW[(size_t)tn * 128 + lane]; wh = GW[(size_t)tn * 128 + 64 + lane];
#pragma unroll
            for (int r = 0; r < 8; ++r) {
                const float wr = __shfl(wh_c, 8 * r + es);
                axpy16_fp8_f16(acc, v[r], __builtin_bit_cast(f16x2_t, __builtin_amdgcn_cvt_pkrtz(wr, wr)));
                v[r] = *(const uint4*)(vb + ((unsigned)__shfl(iln, 8 * r + es) * 128u + loff));
            }
            il = iln; ih = ihn;
            f16x2_t k4[4], k2[2], k1;
#pragma unroll
            for (int j = 0; j < 4; ++j) { const f16x2_t snd = b3 ? acc[j] : acc[j + 4]; const f16x2_t kp = b3 ? acc[j + 4] : acc[j]; k4[j] = kp + shfl_xor_h2(snd, 8); }
#pragma unroll
            for (int j = 0; j < 2; ++j) { const f16x2_t snd = b4 ? k4[j] : k4[j + 2]; const f16x2_t kp = b4 ? k4[j + 2] : k4[j]; k2[j] = kp + shfl_xor_h2(snd, 16); }
            { const f16x2_t snd = b5 ? k2[0] : k2[1]; const f16x2_t kp = b5 ? k2[1] : k2[0]; k1 = kp + shfl_xor_h2(snd, 32); }
            *(unsigned*)(PE + (size_t)(t0 + i) * 1024 + 128 * x + 16 * part + o) = pack2((float)k1.x, (float)k1.y);
        }
    });
}
DEVI float4 bf4_to_f4(const uint2& t) { return make_float4(__uint_as_float(t.x << 16), __uint_as_float(t.x & 0xffff0000u), __uint_as_float(t.y << 16), __uint_as_float(t.y & 0xffff0000u)); }
DEVI void phase_peer_final(const Params& p, const bf16_t* X1b, const bf16_t* PE, const float* MOD, float* OUT) {
    const int lane = threadIdx.x & 63, w = threadIdx.x >> 6;
    const float* nw = p.in[9];
    for (int run = blockIdx.x * 8 + w; run < NT / 16; run += gridDim.x * 8) {
        const int row0 = run * 16;
        const float* gate2 = MOD + (size_t)(row0 / TL) * 6144 + 5 * 1024;
        float4 c[4];
#pragma unroll
        for (int i = 0; i < 4; ++i) {
            const int d = lane * 4 + 256 * i;
            const float4 g = *(const float4*)(gate2 + d), nwv = *(const float4*)(nw + d);
            c[i] = make_float4(g.x * nwv.x, g.y * nwv.y, g.z * nwv.z, g.w * nwv.w);
        }
        uint2 na[4], nx[4];
#pragma unroll
        for (int i = 0; i < 4; ++i) {
            na[i] = *(const uint2*)(PE + (size_t)row0 * 1024 + lane * 4 + 256 * i);
            nx[i] = *(const uint2*)(X1b + (size_t)row0 * 1024 + lane * 4 + 256 * i);
        }
#pragma unroll 1
        for (int rr = 0; rr < 16; ++rr) {
            const int tok = row0 + rr;
            float4 a[4], x1[4]; float ss = 0.f;
#pragma unroll
            for (int i = 0; i < 4; ++i) {
                a[i] = bf4_to_f4(na[i]); x1[i] = bf4_to_f4(nx[i]);
                ss += a[i].x * a[i].x + a[i].y * a[i].y + a[i].z * a[i].z + a[i].w * a[i].w;
            }
            if (rr + 1 < 16) {
#pragma unroll
                for (int i = 0; i < 4; ++i) {
                    na[i] = *(const uint2*)(PE + (size_t)(tok + 1) * 1024 + lane * 4 + 256 * i);
                    nx[i] = *(const uint2*)(X1b + (size_t)(tok + 1) * 1024 + lane * 4 + 256 * i);
                }
            }
            ss = wave_sum_u(ss);
            const float r = rsqrtf(ss * (1.f / 1024.f) + 1e-6f);
#pragma unroll
            for (int i = 0; i < 4; ++i) {
                const int d = lane * 4 + 256 * i;
                float4 o;
                o.x = x1[i].x + c[i].x * a[i].x * r; o.y = x1[i].y + c[i].y * a[i].y * r;
                o.z = x1[i].z + c[i].z * a[i].z * r; o.w = x1[i].w + c[i].w * a[i].w * r;
                *(float4*)(OUT + (size_t)tok * 1024 + d) = o;
            }
        }
    }
}

template <bool NORM>
DEVI void conv_wave(const bf16_t* src, int ld_src, int tok0, bool lo_ok, bool hi_ok, int scol,
                    bf16_t* dst, int ld_dst, int dcol, const float* cw, int wch, float oscale) {
    const int lane = threadIdx.x & 63;
    unsigned x[68];
    const bf16_t* sp = src + (size_t)tok0 * ld_src + scol + 2 * lane;
#pragma unroll
    for (int t = 0; t < 64; ++t) x[t + 2] = *(const unsigned*)(sp + (size_t)t * ld_src);
    x[0] = lo_ok ? *(const unsigned*)(sp - 2 * (size_t)ld_src) : 0u;
    x[1] = lo_ok ? *(const unsigned*)(sp - (size_t)ld_src) : 0u;
    x[66] = hi_ok ? *(const unsigned*)(sp + 64 * (size_t)ld_src) : 0u;
    x[67] = hi_ok ? *(const unsigned*)(sp + 65 * (size_t)ld_src) : 0u;
    float w0[5], w1[5];
#pragma unroll
    for (int j = 0; j < 5; ++j) { w0[j] = cw[j * 3072 + wch + 2 * lane]; w1[j] = cw[j * 3072 + wch + 2 * lane + 1]; }
    bf16_t* dp = dst + (size_t)tok0 * ld_dst + dcol + 2 * lane;
#pragma unroll
    for (int t = 0; t < 64; ++t) {
        float a0 = 0.f, a1 = 0.f;
#pragma unroll
        for (int j = 0; j < 5; ++j) {
            a0 += w0[j] * __uint_as_float(x[t + j] << 16);
            a1 += w1[j] * __uint_as_float(x[t + j] & 0xffff0000u);
        }
        a0 = silu_(a0); a1 = silu_(a1);
        float sc = oscale;
        if (NORM) sc = rsqrtf(wave_sum_u(a0 * a0 + a1 * a1) + 1e-6f) * oscale;
        *(unsigned*)(dp + (size_t)t * ld_dst) = pack2(a0 * sc, a1 * sc);
    }
}

namespace pg8 {
#define PG8_LAS __attribute__((address_space(3)))
typedef unsigned short bf16_t;
typedef short bf16x8 __attribute__((ext_vector_type(8)));
typedef float f32x4 __attribute__((ext_vector_type(4)));
typedef unsigned u32x4 __attribute__((ext_vector_type(4)));
constexpr int BM = 256, BK = 64, HALF = 128, HTB = HALF * BK * 2  , STAGE_BYTES = 8 * HTB, NXCD = 8, WGM = 8;

__host__ __device__ __forceinline__ int lds_byte(int r, int c) { const int st = (r >> 4) * 2 + (c >> 5), rr = r & 15, cc = c & 31, ob = rr * 64 + cc * 2; return st * 1024 + (ob ^ (((ob >> 9) & 1) << 5)); }
__host__ __device__ __forceinline__ void stage_rc(int b, int& R, int& C) { const int st = b / 1024, sb = b % 1024, swz = sb ^ (((sb >> 9) & 1) << 5); R = (st >> 1) * 16 + swz / 64; C = (st & 1) * 32 + (swz % 64) / 2; }
__host__ __device__ __forceinline__ int perm32(int rho) { const int n = rho >> 4, i = rho & 15; return 8 * (i >> 2) + 4 * n + (i & 3); }

struct Unit { int pm, pn; };
struct Gemm { const bf16_t* A; const bf16_t* Bt; int M, N, K; };

struct StaticOrder {
    int nM, nN, nwg, G, c;
    __host__ __device__ void init(int M, int N, int G_, int c_) { nM = M / BM; nN = N / BM; nwg = nM * nN; G = G_; c = c_; }
    __host__ __device__ bool next(int i, Unit& u) const {
        const long L = (long)i * G + c; if (L >= nwg) return false;
        int wgid = (int)L; { const int q = nwg / NXCD, r = nwg % NXCD, xcd = wgid % NXCD, off = wgid / NXCD; wgid = (xcd < r ? xcd * (q + 1) : r * (q + 1) + (xcd - r) * q) + off; }
        const int nig = WGM * nN, gid = wgid / nig, fm = gid * WGM, gsz = (nM - fm) < WGM ? (nM - fm) : WGM;
        u.pm = fm + ((wgid % nig) % gsz); u.pn = (wgid % nig) / gsz; return true;
    }
    __device__ __forceinline__ void a_ready(const Unit&) const {}
    __device__ __forceinline__ void done(const Unit&) const {}
};
__device__ __forceinline__ unsigned cvt_pk_bf16(float lo, float hi) { unsigned r; asm volatile("v_cvt_pk_bf16_f32 %0, %1, %2" : "=v"(r) : "v"(lo), "v"(hi)); return r; }
template <class Epi, class Sched, bool ALIGN_EPI = false, bool SP2 = false>
__device__ __forceinline__ void gemm_phase(PG8_LAS unsigned char* lds, const Gemm g, const Sched& S, const Epi& E) {
    const int tid = threadIdx.x, wid = __builtin_amdgcn_readfirstlane(tid >> 6), lane = tid & 63, wr = wid >> 2, wc = wid & 3, fr = lane & 15, fq = lane >> 4;
    const int K = g.K, nt = K / BK;
    unsigned voffA[2], voffB[2];
#pragma unroll
    for (int i = 0; i < 2; ++i) { int R, C; stage_rc(tid * 16 + i * 8192, R, C); const int Rb = Epi::PERM ? ((R & ~31) + perm32(R & 31)) : R;
        voffA[i] = (unsigned)(R * K + C) * 2u; voffB[i] = (unsigned)(Rb * K + C) * 2u; }
    const size_t kstep = (size_t)(BK * 2);
    const size_t hstep = (size_t)HALF * K * 2;
    const size_t tstep = 2 * hstep;
    const unsigned ldsw = (unsigned)wid * 1024u;
    const int aoff = lds_byte(wr * 64 + fr, fq * 8), boff = lds_byte(wc * 32 + fr, fq * 8);
#define PG8_SA(b, h) (((b) * 2 + (h)) * HTB)
#define PG8_SB(b, h) ((4 + (b) * 2 + (h)) * HTB)
#define PG8_STAGE(bufoff, gbase, voff) do { _Pragma("unroll") for (int _i = 0; _i < 2; ++_i) \
        __builtin_amdgcn_global_load_lds((const unsigned*)((const char*)(gbase) + (voff)[_i]), (PG8_LAS unsigned*)(lds + (bufoff) + ldsw + _i * 8192), 16, 0, 0); } while (0)
#define PG8_LDA(dst, b, h) do { _Pragma("unroll") for (int m = 0; m < 4; ++m) _Pragma("unroll") for (int k = 0; k < 2; ++k) dst[m][k] = *(const PG8_LAS bf16x8*)(lds + PG8_SA(b, h) + aoff + m * 2048 + k * 1024); } while (0)
#define PG8_LDB(dst, b, h) do { _Pragma("unroll") for (int n = 0; n < 2; ++n) _Pragma("unroll") for (int k = 0; k < 2; ++k) dst[n][k] = *(const PG8_LAS bf16x8*)(lds + PG8_SB(b, h) + boff + n * 2048 + k * 1024); } while (0)
#define PG8_MMA(ai, bj, At, Bt) do { __builtin_amdgcn_s_setprio(1); _Pragma("unroll") for (int m = 0; m < 4; ++m) _Pragma("unroll") for (int n = 0; n < 2; ++n) _Pragma("unroll") for (int k = 0; k < 2; ++k) \
        acc[ai][bj][m][n] = __builtin_amdgcn_mfma_f32_16x16x32_bf16(Bt[n][k], At[m][k], acc[ai][bj][m][n], 0, 0, 0); __builtin_amdgcn_s_setprio(0); } while (0)
#define PG8_WAIT_V(n) asm volatile("s_waitcnt vmcnt(" #n ")" ::: "memory")
#define PG8_WAIT_L(n) asm volatile("s_waitcnt lgkmcnt(" #n ")" ::: "memory")
#define PG8_BAR __builtin_amdgcn_s_barrier()
#define PG8_SCHED __builtin_amdgcn_sched_barrier(0)
    Unit cur, nxt; int ui = 0;
    if (!S.next(0, cur)) return;
    f32x4 acc[2][2][4][2];
#pragma unroll
    for (int a = 0; a < 2; ++a)
#pragma unroll
        for (int b = 0; b < 2; ++b)
#pragma unroll
            for (int m = 0; m < 4; ++m)
#pragma unroll
                for (int n = 0; n < 2; ++n) acc[a][b][m][n] = (f32x4){0.f, 0.f, 0.f, 0.f};
    bf16x8 At[4][2], B0[2][2], B1[2][2];
    const char* cA = (const char*)g.A + (size_t)cur.pm * tstep; const char* cB = (const char*)g.Bt + (size_t)cur.pn * tstep;
    S.a_ready(cur);
    if constexpr (SP2) {
        PG8_STAGE(PG8_SB(0, 0), cB, voffB); PG8_STAGE(PG8_SB(0, 1), cB + hstep, voffB); PG8_STAGE(PG8_SA(0, 0), cA, voffA); PG8_STAGE(PG8_SA(0, 1), cA + hstep, voffA);
        if (wr == 1) PG8_BAR;
        PG8_WAIT_V(2); PG8_BAR;
        PG8_STAGE(PG8_SB(1, 0), cB + kstep, voffB); PG8_STAGE(PG8_SA(1, 0), cA + kstep, voffA); PG8_STAGE(PG8_SB(1, 1), cB + hstep + kstep, voffB);
        PG8_WAIT_V(6); PG8_BAR;
    } else {
        PG8_STAGE(PG8_SB(0, 0), cB, voffB); PG8_STAGE(PG8_SA(0, 0), cA, voffA); PG8_STAGE(PG8_SB(0, 1), cB + hstep, voffB); PG8_STAGE(PG8_SA(0, 1), cA + hstep, voffA);
        if (wr == 1) PG8_BAR;
        PG8_WAIT_V(4); PG8_BAR;
        PG8_STAGE(PG8_SB(1, 0), cB + kstep, voffB); PG8_STAGE(PG8_SA(1, 0), cA + kstep, voffA); PG8_STAGE(PG8_SB(1, 1), cB + hstep + kstep, voffB);
        PG8_WAIT_V(6); PG8_BAR;
    }
    for (;;) {
        const bool has_next = S.next(ui + 1, nxt);
        const char* nA = has_next ? (const char*)g.A + (size_t)nxt.pm * tstep : cA; const char* nB = has_next ? (const char*)g.Bt + (size_t)nxt.pn * tstep : cB;
        for (int t = 0; t < nt; t += 2) {
            const bool last = (t == nt - 2);
            const char* a1 = cA + (size_t)(t + 1) * kstep;
            const char* a2 = last ? nA : cA + (size_t)(t + 2) * kstep; const char* b2 = last ? nB : cB + (size_t)(t + 2) * kstep;
            const char* a3 = a2 + kstep; const char* b3 = b2 + kstep;
            if (last && has_next) S.a_ready(nxt);
            if constexpr (SP2) {
            PG8_LDB(B0, 0, 0); PG8_LDB(B1, 0, 1); PG8_SCHED; PG8_LDA(At, 0, 0); PG8_STAGE(PG8_SA(1, 1), a1 + hstep, voffA);
            PG8_WAIT_V(8); PG8_WAIT_L(0); PG8_BAR; PG8_MMA(0, 0, At, B0); PG8_MMA(0, 1, At, B1); PG8_BAR; PG8_SCHED;
            PG8_LDA(At, 0, 1); PG8_STAGE(PG8_SB(0, 0), b2, voffB); PG8_STAGE(PG8_SB(0, 1), b2 + hstep, voffB); PG8_STAGE(PG8_SA(0, 0), a2, voffA);
            PG8_WAIT_V(8); PG8_WAIT_L(0); PG8_BAR; PG8_MMA(1, 0, At, B0); PG8_MMA(1, 1, At, B1); PG8_BAR; PG8_SCHED;
            PG8_LDB(B0, 1, 0); PG8_LDB(B1, 1, 1); PG8_SCHED; PG8_LDA(At, 1, 0); PG8_STAGE(PG8_SA(0, 1), a2 + hstep, voffA);
            PG8_WAIT_V(8); PG8_WAIT_L(0); PG8_BAR; PG8_MMA(0, 0, At, B0); PG8_MMA(0, 1, At, B1); PG8_BAR; PG8_SCHED;
            PG8_LDA(At, 1, 1); PG8_STAGE(PG8_SB(1, 0), b3, voffB); PG8_STAGE(PG8_SB(1, 1), b3 + hstep, voffB); PG8_STAGE(PG8_SA(1, 0), a3, voffA);
            PG8_WAIT_V(8); PG8_WAIT_L(0); PG8_BAR; PG8_MMA(1, 0, At, B0); PG8_MMA(1, 1, At, B1); PG8_BAR; PG8_SCHED;
            } else {
            PG8_LDB(B0, 0, 0); PG8_SCHED; PG8_LDA(At, 0, 0); PG8_STAGE(PG8_SA(1, 1), a1 + hstep, voffA);
            PG8_WAIT_L(8); PG8_BAR; PG8_WAIT_L(0); PG8_MMA(0, 0, At, B0); PG8_BAR; PG8_SCHED;
            PG8_LDB(B1, 0, 1); PG8_STAGE(PG8_SB(0, 0), b2, voffB);
            PG8_BAR; PG8_WAIT_L(0); PG8_MMA(0, 1, At, B1); PG8_BAR;
            PG8_LDA(At, 0, 1); PG8_STAGE(PG8_SA(0, 0), a2, voffA);
            PG8_BAR; PG8_WAIT_L(0); PG8_MMA(1, 0, At, B0); PG8_BAR; PG8_SCHED;
            PG8_STAGE(PG8_SB(0, 1), b2 + hstep, voffB);
            PG8_WAIT_V(6); PG8_BAR; PG8_MMA(1, 1, At, B1); PG8_BAR;
            PG8_LDB(B0, 1, 0); PG8_SCHED; PG8_LDA(At, 1, 0); PG8_STAGE(PG8_SA(0, 1), a2 + hstep, voffA);
            PG8_WAIT_L(8); PG8_BAR; PG8_WAIT_L(0); PG8_MMA(0, 0, At, B0); PG8_BAR; PG8_SCHED;
            PG8_LDB(B1, 1, 1); PG8_STAGE(PG8_SB(1, 0), b3, voffB);
            PG8_BAR; PG8_WAIT_L(0); PG8_MMA(0, 1, At, B1); PG8_BAR;
            PG8_LDA(At, 1, 1); PG8_STAGE(PG8_SA(1, 0), a3, voffA);
            PG8_BAR; PG8_WAIT_L(0); PG8_MMA(1, 0, At, B0); PG8_BAR; PG8_SCHED;
            PG8_STAGE(PG8_SB(1, 1), b3 + hstep, voffB);
            PG8_WAIT_V(6); PG8_BAR; PG8_MMA(1, 1, At, B1); PG8_BAR;
            }
        }
        if constexpr (ALIGN_EPI) { if (wr == 0) PG8_BAR; }
        if constexpr (!Epi::AFTER_DRAIN) { E(acc, cur, wr, wc, fr, fq); S.done(cur); }
        if (!has_next) break;
#pragma unroll
        for (int a = 0; a < 2; ++a)
#pragma unroll
            for (int b = 0; b < 2; ++b)
#pragma unroll
                for (int m = 0; m < 4; ++m)
#pragma unroll
                    for (int n = 0; n < 2; ++n) acc[a][b][m][n] = (f32x4){0.f, 0.f, 0.f, 0.f};
        cur = nxt; cA = nA; cB = nB; ++ui;
        if constexpr (ALIGN_EPI) { if (wr == 1) PG8_BAR; }
    }
    PG8_WAIT_V(0);
    if constexpr (!ALIGN_EPI) { if (wr == 0) PG8_BAR; }
    PG8_BAR;
    if constexpr (Epi::AFTER_DRAIN) { E.fused(acc, cur, wr, wc, fr, fq, lds, wid, lane); S.done(cur); }
#undef PG8_SA
#undef PG8_SB
#undef PG8_STAGE
#undef PG8_LDA
#undef PG8_LDB
#undef PG8_MMA
#undef PG8_WAIT_V
#undef PG8_WAIT_L
#undef PG8_BAR
#undef PG8_SCHED
}
__device__ __forceinline__ void unpack8(const u32x4& w, float* f) {
    f[0] = __uint_as_float(w.x << 16); f[1] = __uint_as_float(w.x & 0xffff0000u); f[2] = __uint_as_float(w.y << 16); f[3] = __uint_as_float(w.y & 0xffff0000u);
    f[4] = __uint_as_float(w.z << 16); f[5] = __uint_as_float(w.z & 0xffff0000u); f[6] = __uint_as_float(w.w << 16); f[7] = __uint_as_float(w.w & 0xffff0000u);
}
__device__ __forceinline__ float sigm(float x) { return 1.f / (1.f + __expf(-x)); }
struct EpiStore16 {
    static constexpr bool PERM = true, AFTER_DRAIN = false;
    bf16_t* O; int ldc;
    __device__ __forceinline__ void operator()(const f32x4 (&acc)[2][2][4][2], const Unit& u, int wr, int wc, int fr, int fq) const {
        const int row0 = u.pm * BM + wr * 64 + fr, col0 = u.pn * BM + wc * 32 + 8 * fq;
#pragma unroll
        for (int ai = 0; ai < 2; ++ai)
#pragma unroll
            for (int m = 0; m < 4; ++m) { bf16_t* rowp = O + (size_t)(row0 + ai * HALF + m * 16) * ldc + col0;
#pragma unroll
                for (int bj = 0; bj < 2; ++bj) { const f32x4 v0 = acc[ai][bj][m][0], v1 = acc[ai][bj][m][1];
                    u32x4 w; w.x = cvt_pk_bf16(v0[0], v0[1]); w.y = cvt_pk_bf16(v0[2], v0[3]); w.z = cvt_pk_bf16(v1[0], v1[1]); w.w = cvt_pk_bf16(v1[2], v1[3]);
                    *(u32x4*)(rowp + bj * HALF) = w; } }
    }
};
template <int MODE> struct EpiGate {
    static constexpr bool PERM = true, AFTER_DRAIN = false;
    bf16_t* O; int ldc; const bf16_t* G; int ldg; int goff; const float* bias;
    __device__ __forceinline__ void operator()(const f32x4 (&acc)[2][2][4][2], const Unit& u, int wr, int wc, int fr, int fq) const {
        const int row0 = u.pm * BM + wr * 64 + fr, col0 = u.pn * BM + wc * 32 + 8 * fq;
#pragma unroll
        for (int ai = 0; ai < 2; ++ai)
#pragma unroll
            for (int m = 0; m < 4; ++m) { const size_t row = (size_t)(row0 + ai * HALF + m * 16);
#pragma unroll
                for (int bj = 0; bj < 2; ++bj) { const int col = col0 + bj * HALF; const f32x4 v0 = acc[ai][bj][m][0], v1 = acc[ai][bj][m][1];
                    float a[8] = {v0[0], v0[1], v0[2], v0[3], v1[0], v1[1], v1[2], v1[3]}; float g[8], o[8];
                    unpack8(*(const u32x4*)(G + row * ldg + goff + col), g);
                    if (MODE == 0) {
                        const f32x4 b0 = *(const f32x4*)(bias + col), b1 = *(const f32x4*)(bias + col + 4);
                        const float bb[8] = {b0[0], b0[1], b0[2], b0[3], b1[0], b1[1], b1[2], b1[3]};
#pragma unroll
                        for (int j = 0; j < 8; ++j) o[j] = g[j] * sigm(a[j] + bb[j]);
                    } else if (MODE == 1) {
#pragma unroll
                        for (int j = 0; j < 8; ++j) o[j] = sigm(g[j]) * a[j];
                    } else {
                        float pv[8]; unpack8(*(const u32x4*)(O + row * ldc + col), pv);
#pragma unroll
                        for (int j = 0; j < 8; ++j) o[j] = pv[j] + sigm(g[j]) * a[j];
                    }
                    u32x4 w; w.x = cvt_pk_bf16(o[0], o[1]); w.y = cvt_pk_bf16(o[2], o[3]); w.z = cvt_pk_bf16(o[4], o[5]); w.w = cvt_pk_bf16(o[6], o[7]);
                    *(u32x4*)(O + row * ldc + col) = w; }
                asm volatile("" ::: "memory"); }
    }
};
struct EpiStoreF32 {
    static constexpr bool PERM = false, AFTER_DRAIN = false;
    float* C; int ldc;
    __device__ __forceinline__ void operator()(const f32x4 (&acc)[2][2][4][2], const Unit& u, int wr, int wc, int fr, int fq) const {
        const int row0 = u.pm * BM + wr * 64 + fr, col0 = u.pn * BM + wc * 32 + 4 * fq;
#pragma unroll
        for (int ai = 0; ai < 2; ++ai)
#pragma unroll
            for (int m = 0; m < 4; ++m) { float* rowp = C + (size_t)(row0 + ai * HALF + m * 16) * ldc + col0;
#pragma unroll
                for (int bj = 0; bj < 2; ++bj)
#pragma unroll
                    for (int n = 0; n < 2; ++n) *(f32x4*)(rowp + bj * HALF + n * 16) = acc[ai][bj][m][n]; }
    }
};
}

#define XB_TMO      128
#define XB_XCNT(j)  (256  + 64 * (j))
#define XB_XSUB(j)  (1280 + 64 * (j))
#define XB_XGEN(j)  (2304 + 64 * (j))
#define XB_TOP      3328
#define XB_TOPGEN   3392
#define XCD_BAR_WORDS 3456
#define XB_SPIN_CAP (1u << 22)
#define LAS __attribute__((address_space(3)))
DEVI unsigned xb_ld(unsigned* p)              { return __hip_atomic_load(p, __ATOMIC_RELAXED, __HIP_MEMORY_SCOPE_AGENT); }
DEVI unsigned xb_add(unsigned* p, unsigned v) { return __hip_atomic_fetch_add(p, v, __ATOMIC_RELAXED, __HIP_MEMORY_SCOPE_AGENT); }
DEVI unsigned xb_xcc_id() { return (unsigned)__builtin_amdgcn_s_getreg((3 << 11) | 20) & 0xFu; }
#define XB_SPIN(cond, bar) do { unsigned _sp = 0; while (cond) { __builtin_amdgcn_s_sleep(1); \
    if ((++_sp & 255u) == 0u) { if (xb_ld(&(bar)[XB_TMO])) break; if (_sp > XB_SPIN_CAP) { atomicAdd(&(bar)[XB_TMO], 1u); break; } } } } while (0)
struct XcdBarrier { unsigned* bar; unsigned x; volatile LAS unsigned* st; };
DEVI XcdBarrier xcd_barrier_post(unsigned* bar, volatile LAS unsigned* st) {
    XcdBarrier b; b.bar = bar; b.x = xb_xcc_id(); b.st = st;
    if (threadIdx.x == 0) (void)xb_add(&bar[XB_XCNT(b.x)], 1u);
    return b;
}
DEVI void xcd_barrier_complete(unsigned* bar, unsigned x, unsigned& nloc, unsigned& nx) {
    const unsigned G = gridDim.x * gridDim.y * gridDim.z;
    unsigned sum, cnt, mine, sp = 0u;
    for (;;) {
        sum = 0u; cnt = 0u; mine = 0u;
#pragma unroll
        for (unsigned j = 0; j < 16; ++j) { const unsigned c = xb_ld(&bar[XB_XCNT(j)]); sum += c; cnt += (c > 0u) ? 1u : 0u; mine = (j == x) ? c : mine; }
        if (sum == G) break;
        __builtin_amdgcn_s_sleep(1);
        if ((++sp & 255u) == 0u) { if (xb_ld(&bar[XB_TMO])) break; if (sp > XB_SPIN_CAP) { atomicAdd(&bar[XB_TMO], 1u); break; } }
    }
    nloc = mine > 0u ? mine : 1u; nx = cnt > 0u ? cnt : 1u;
}
DEVI void xcd_barrier(const XcdBarrier& b) {
    asm volatile("s_waitcnt vmcnt(0)" ::: "memory");
    __syncthreads();
    if (threadIdx.x == 0) {
        unsigned* bar = b.bar;
        __builtin_amdgcn_s_waitcnt(0);
        unsigned nloc = b.st[0], nx = b.st[1];
        if (nloc == 0u) { xcd_barrier_complete(bar, b.x, nloc, nx); b.st[0] = nloc; b.st[1] = nx; }
        const unsigned old = xb_add(&bar[XB_XSUB(b.x)], 1u);
        const unsigned gen = old / nloc;
        if (old + 1u == (gen + 1u) * nloc) {
            __builtin_amdgcn_fence(__ATOMIC_RELEASE, "agent");
            asm volatile("s_waitcnt vmcnt(0)" ::: "memory");
            const unsigned og = xb_add(&bar[XB_TOP], 1u);
            const unsigned tg = og / nx;
            if (og + 1u == (tg + 1u) * nx) xb_add(&bar[XB_TOPGEN], 1u);
            else XB_SPIN(xb_ld(&bar[XB_TOPGEN]) == tg, bar);
            __builtin_amdgcn_fence(__ATOMIC_ACQUIRE, "agent");
            xb_add(&bar[XB_XGEN(b.x)], 1u);
            asm volatile("s_waitcnt vmcnt(0)" ::: "memory");
        } else {
            XB_SPIN(xb_ld(&bar[XB_XGEN(b.x)]) == gen, bar);
            __builtin_amdgcn_fence(__ATOMIC_ACQUIRE, "agent");
            asm volatile("s_waitcnt vmcnt(0)" ::: "memory");
        }
    }
    __syncthreads();
}

__global__ void __launch_bounds__(NTHREADS) mega(Params p) {
    extern __shared__ __attribute__((aligned(16))) unsigned char lds[];
    unsigned char* ws = p.ws;
    {
        volatile LAS unsigned* stw = (volatile LAS unsigned*)(lds + LDS_BYTES - 16);
        if (threadIdx.x < 4) stw[threadIdx.x] = 0u;
    }
    __syncthreads();
    XcdBarrier gbar = xcd_barrier_post((unsigned*)(ws + OFF_BAR), (volatile LAS unsigned*)(lds + LDS_BYTES - 16));
    const int tid = threadIdx.x, lane = tid & 63, w = tid >> 6;
    const int nb = gridDim.x, bid = blockIdx.x;
#define MOD ((float*)(p.ws + OFF_MOD))
#define HX ((bf16_t*)((unsigned char*)p.out + DO_HX))
#define HC ((bf16_t*)((unsigned char*)p.out + DO_HC))
#define PROJ1 ((bf16_t*)(p.ws + OFF_PROJ1))
#define PROJC ((bf16_t*)(p.ws + OFF_PROJC))
#define CKV ((bf16_t*)(p.ws + OFF_CKV))
#define AB ((float*)(p.ws + OFF_AB))
#define ABC ((float*)(p.ws + OFF_ABC))
#define S5ST ((float*)(p.ws + OFF_S5ST))
#define DNST ((float*)(p.ws + OFF_DNST))
#define YF ((bf16_t*)(p.ws + OFF_YF))
#define YB ((bf16_t*)(p.ws + OFF_YB))
#define OF ((bf16_t*)(p.ws + OFF_OF))
#define OB ((bf16_t*)(p.ws + OFF_OB))
#define WIN1 ((const bf16_t*)(p.ws + OFF_WIN1))
#define WIN2 ((const bf16_t*)(p.ws + OFF_WIN2))
#ifndef PROBE_PHASE
#define PROBE_PHASE -1
#endif
#define NREP(k) ((k) == PROBE_PHASE ? 2 : 1)
#define IN(k) (p.ph_lo <= (k) && (k) < p.ph_hi)
#define SEAM(k) do { if (rep_ + 1 == NREP(k) && (k) + 1 < p.ph_hi) xcd_barrier(gbar); } while (0)

    if (IN(0)) for (int rep_ = 0; rep_ < NREP(0); ++rep_) {
        phase_adaln(p, MOD, lds);
        __syncthreads();
        phase_weights(p, lds);
        SEAM(0);
    }
    if (IN(1)) for (int rep_ = 0; rep_ < NREP(1); ++rep_) {
        modulate_rows<16>(p.in[0], NT, TL, p.in[6], MOD, MOD + 1024, 6144, HX);
        modulate_rows<2>(p.in[2], NC, TCX, p.in[6], MOD + 16 * 6144, MOD + 16 * 6144 + 1024, 0, HC);
        SEAM(1);
    }
    if (IN(2)) for (int rep_ = 0; rep_ < NREP(2); ++rep_) {
        {
            pg8::Gemm g{HX, WIN1, NT, 3584, 1024}; pg8::StaticOrder S; S.init(NT, 3584, nb, bid); pg8::EpiStore16 E{PROJ1, LD1};
            pg8::gemm_phase<pg8::EpiStore16, pg8::StaticOrder, true, true>((PG8_LAS unsigned char*)lds, g, S, E);
        }
        const int nctxb = nb >= 256 ? 160 : nb;
        if (bid < nctxb) {
            pg8::Gemm g{HC, WIN1, NC, 2560, 1024}; pg8::StaticOrder S; S.init(NC, 2560, nctxb, bid); pg8::EpiStore16 E{PROJC, LDC};
            pg8::gemm_phase<pg8::EpiStore16, pg8::StaticOrder, true, true>((PG8_LAS unsigned char*)lds, g, S, E);
        }
        __syncthreads();
        {
            const int nab = nb - nctxb;
            const int t0 = nab > 0 ? (bid >= nctxb ? bid - nctxb : 256 + 32) : bid;
            const int stride = nab > 0 ? nab : nb;
            for (int t = t0; t < 256 + 32; t += stride) {
                if (t < 256) gemm_tile(HX, 1024, WIN1, 1024, 1024, t * 128, 3584, lds, [=](int row, int col, float v) { if (col < 3584 + 32) AB[(size_t)row * 32 + (col - 3584)] = v; });
                else gemm_tile(HC, 1024, WIN1, 1024, 1024, (t - 256) * 128, 3584, lds, [=](int row, int col, float v) { if (col < 3584 + 32) ABC[(size_t)row * 32 + (col - 3584)] = v; });
            }
        }
        SEAM(2);
    }
    if (IN(3)) for (int rep_ = 0; rep_ < NREP(3); ++rep_) {
        const float* cw = p.in[21];
        const int nlat = NB * 32 * 3 * 8, nctx = NB * 4 * 2 * 8;
        for (int it = w * nb + bid; it < nlat + nctx; it += nb * 8) {
            if (it < nlat) {
                const int head = it & 7, type = (it >> 3) % 3, br = it / 24;
                const int scol = (type == 0 ? 512 : (type == 1 ? 1536 : 2560)) + head * 128;
                if (type == 1) conv_wave<false>(PROJ1, LD1, br * 64, false, false, scol, PROJ1, LD1, scol, cw, type * 1024 + head * 128, 1.f);
                else conv_wave<true>(PROJ1, LD1, br * 64, false, false, scol, PROJ1, LD1, scol, cw, type * 1024 + head * 128, type == 2 ? 0.08838834764831845f : 1.f);
            } else {
                const int i2 = it - nlat;
                const int head = i2 & 7, type = (i2 >> 3) & 1, bt = i2 >> 4;
                const int tt = bt & 3;
                const int scol = (type == 0 ? 512 : 1536) + head * 128;
                if (type == 1) conv_wave<false>(PROJC, LDC, bt * 64, tt > 0, tt < 3, scol, CKV, 2048, type * 1024 + head * 128, cw, type * 1024 + head * 128, 1.f);
                else conv_wave<true>(PROJC, LDC, bt * 64, tt > 0, tt < 3, scol, CKV, 2048, type * 1024 + head * 128, cw, type * 1024 + head * 128, 1.f);
            }
        }
        SEAM(3);
    }
    if (IN(4)) for (int rep_ = 0; rep_ < NREP(4); ++rep_) {
        for (int u = bid; u < 256; u += nb) {
            const int dir = u & 1, head = (u >> 1) & 7, b = u >> 4;
            dn_chunked<false>(p, CKV + head * 128, CKV + 1024 + head * 128, nullptr, 2048, ABC, b * TCX, TCX, head, dir, nullptr,
                   DNST + (size_t)u * 128 * 128, nullptr, lds);
        }
        for (int u = w * nb + bid; u < 512; u += nb * 8) {
            const int dir = u & 1, g = (u >> 1) & 31, bp = u >> 6;
            s5_mfma<false>(p, PROJC, LDC, TCX, bp, g, dir, nullptr, S5ST, nullptr, lds + w * 19456);
        }
        SEAM(4);
    }
    if (IN(5)) for (int rep_ = 0; rep_ < NREP(5); ++rep_) {
        for (int u = bid; u < 256; u += nb) {
            const int dir = u & 1, head = (u >> 1) & 7, b = u >> 4;
            dn_chunked<true>(p, PROJ1 + 512 + head * 128, PROJ1 + 1536 + head * 128, PROJ1 + 2560 + head * 128, LD1, AB, b * TL, TL, head, dir,
                   DNST + (size_t)u * 128 * 128, nullptr, dir ? OB : OF, lds);
        }
        __syncthreads();
        for (int u = w * nb + bid; u < 512; u += nb * 8) {
            const int dir = u & 1, g = (u >> 1) & 31, bp = u >> 6;
            s5_mfma<true>(p, PROJ1, LD1, TL, bp, g, dir, S5ST, nullptr, dir ? YB : YF, lds + w * 19456);
        }
        if (w >= 2) {
            convert_table_fp8_sliced(p.in[30], ws + OFF_UT, PEER_USCALE, bid * 384 + (tid - 128), nb * 384);
            convert_table_fp8_sliced(p.in[31], ws + OFF_UT + (size_t)16384 * 1024, PEER_VSCALE, bid * 384 + (tid - 128), nb * 384);
        }
        __syncthreads();
        SEAM(5);
    }
#define PROJ2 ((bf16_t*)(p.ws + OFF_PROJ2))
#define Y5 ((bf16_t*)(p.ws + OFF_Y5))
    if (IN(6)) for (int rep_ = 0; rep_ < NREP(6); ++rep_) {
        {
            pg8::Gemm g{HX, WIN2, NT, 3072, 1024}; pg8::StaticOrder S; S.init(NT, 3072, nb, bid); pg8::EpiStore16 E{PROJ2, LD2};
            pg8::gemm_phase<pg8::EpiStore16, pg8::StaticOrder, true, true>((PG8_LAS unsigned char*)lds, g, S, E);
        }
        for (size_t i = (size_t)bid * NTHREADS + tid; i < (size_t)NT * 512 / 2; i += (size_t)nb * NTHREADS) {
            const unsigned a = ((const unsigned*)YF)[i], b2 = ((const unsigned*)YB)[i];
            const float y0 = __uint_as_float(a << 16) + __uint_as_float(b2 << 16);
            const float y1 = __uint_as_float(a & 0xffff0000u) + __uint_as_float(b2 & 0xffff0000u);
            ((unsigned*)Y5)[i] = pack2(gelu_(y0), gelu_(y1));
        }
        SEAM(6);
    }
#define Y5G ((bf16_t*)(p.ws + OFF_Y5G))
#define YDN ((bf16_t*)(p.ws + OFF_YDN))
    if (IN(7)) for (int rep_ = 0; rep_ < NREP(7); ++rep_) {
#define GLUW ((const bf16_t*)(p.ws + OFF_GLU))
        const float* glub = p.in[20];
        {
            pg8::Gemm g{Y5, GLUW, NT, 512, 512}; pg8::StaticOrder S; S.init(NT, 512, nb, bid); pg8::EpiGate<0> E{Y5G, 512, Y5, 512, 0, glub};
            pg8::gemm_phase<pg8::EpiGate<0>, pg8::StaticOrder, true, true>((PG8_LAS unsigned char*)lds, g, S, E);
        }
        const float* dnw = p.in[24];
        for (int tok = bid * 8 + w; tok < NT; tok += nb * 8) {
#pragma unroll
            for (int i = 0; i < 2; ++i) {
                const int col = i * 512 + lane * 8;
                const uint4 a = *(const uint4*)(OF + (size_t)tok * 1024 + col);
                const uint4 b2 = *(const uint4*)(OB + (size_t)tok * 1024 + col);
                const uint4 zz = *(const uint4*)(PROJ2 + (size_t)tok * LD2 + col);
                float o[8], z[8];
                o[0] = __uint_as_float(a.x << 16) + __uint_as_float(b2.x << 16); o[1] = __uint_as_float(a.x & 0xffff0000u) + __uint_as_float(b2.x & 0xffff0000u);
                o[2] = __uint_as_float(a.y << 16) + __uint_as_float(b2.y << 16); o[3] = __uint_as_float(a.y & 0xffff0000u) + __uint_as_float(b2.y & 0xffff0000u);
                o[4] = __uint_as_float(a.z << 16) + __uint_as_float(b2.z << 16); o[5] = __uint_as_float(a.z & 0xffff0000u) + __uint_as_float(b2.z & 0xffff0000u);
                o[6] = __uint_as_float(a.w << 16) + __uint_as_float(b2.w << 16); o[7] = __uint_as_float(a.w & 0xffff0000u) + __uint_as_float(b2.w & 0xffff0000u);
                z[0] = __uint_as_float(zz.x << 16); z[1] = __uint_as_float(zz.x & 0xffff0000u);
                z[2] = __uint_as_float(zz.y << 16); z[3] = __uint_as_float(zz.y & 0xffff0000u);
                z[4] = __uint_as_float(zz.z << 16); z[5] = __uint_as_float(zz.z & 0xffff0000u);
                z[6] = __uint_as_float(zz.w << 16); z[7] = __uint_as_float(zz.w & 0xffff0000u);
                float ss = 0.f;
#pragma unroll
                for (int c = 0; c < 8; ++c) ss += o[c] * o[c];
                ss += __shfl_xor(ss, 1); ss += __shfl_xor(ss, 2); ss += __shfl_xor(ss, 4); ss += __shfl_xor(ss, 8);
                const float r = rsqrtf(ss * (1.f / 128.f) + 1e-6f);
                float y[8];
#pragma unroll
                for (int c = 0; c < 8; ++c) y[c] = o[c] * r * dnw[(lane & 15) * 8 + c] * silu_(z[c]);
                uint4 ov;
                ov.x = pack2(y[0], y[1]); ov.y = pack2(y[2], y[3]); ov.z = pack2(y[4], y[5]); ov.w = pack2(y[6], y[7]);
                *(uint4*)(YDN + (size_t)tok * 1024 + col) = ov;
            }
        }
        SEAM(7);
    }
#define MERGED ((bf16_t*)(p.ws + OFF_MERGED))
    if (IN(8)) for (int rep_ = 0; rep_ < NREP(8); ++rep_) {
#define WB5 ((const bf16_t*)(p.ws + OFF_WB5))
#define WBDN ((const bf16_t*)(p.ws + OFF_WBDN))
        {
            pg8::Gemm g{Y5G, WB5, NT, 1024, 512}; pg8::StaticOrder S; S.init(NT, 1024, nb, bid); pg8::EpiGate<1> E{MERGED, 1024, PROJ2, LD2, 1024, nullptr};
            pg8::gemm_phase<pg8::EpiGate<1>, pg8::StaticOrder, true, true>((PG8_LAS unsigned char*)lds, g, S, E);
        }
        {
            pg8::Gemm g{YDN, WBDN, NT, 1024, 1024}; pg8::StaticOrder S; S.init(NT, 1024, nb, bid); pg8::EpiGate<2> E{MERGED, 1024, PROJ2, LD2, 2048, nullptr};
            pg8::gemm_phase<pg8::EpiGate<2>, pg8::StaticOrder, true, true>((PG8_LAS unsigned char*)lds, g, S, E);
        }
        SEAM(8);
    }
    bf16_t* XMIX = (bf16_t*)p.out;
    if (IN(9)) for (int rep_ = 0; rep_ < NREP(9); ++rep_) {
#define WOUT ((const bf16_t*)(p.ws + OFF_WOUT))
        {
            pg8::Gemm g{MERGED, WOUT, NT, 1024, 1024}; pg8::StaticOrder S; S.init(NT, 1024, nb, bid); pg8::EpiStore16 E{XMIX, 1024};
            pg8::gemm_phase<pg8::EpiStore16, pg8::StaticOrder, true, true>((PG8_LAS unsigned char*)lds, g, S, E);
        }
        SEAM(9);
    }
#define X1 ((bf16_t*)(p.ws + OFF_X1))
#define HX2 ((bf16_t*)(p.ws + OFF_HX2))
    if (IN(10)) for (int rep_ = 0; rep_ < NREP(10); ++rep_) {
        const float* x = p.in[0];
        const float* npm = p.in[7];
        const float* npf = p.in[8];
        for (int run = bid * 8 + w; run < NT / 16; run += nb * 8) {
            const int row0 = run * 16;
            const float* mb = MOD + (size_t)(row0 / TL) * 6144;
            float4 c1[4], c2[4], c3[4];
#pragma unroll
            for (int i = 0; i < 4; ++i) {
                const int d = lane * 4 + 256 * i;
                const float4 g = *(const float4*)(mb + 2 * 1024 + d), nw = *(const float4*)(npm + d);
                const float4 gn = *(const float4*)(npf + d), scl = *(const float4*)(mb + 4 * 1024 + d);
                c1[i] = make_float4(g.x * nw.x, g.y * nw.y, g.z * nw.z, g.w * nw.w);
                c2[i] = make_float4(gn.x * (1.f + scl.x), gn.y * (1.f + scl.y), gn.z * (1.f + scl.z), gn.w * (1.f + scl.w));
                c3[i] = *(const float4*)(mb + 3 * 1024 + d);
            }
            uint2 nm[4]; float4 nx[4];
#pragma unroll
            for (int i = 0; i < 4; ++i) {
                nm[i] = *(const uint2*)(XMIX + (size_t)row0 * 1024 + lane * 4 + 256 * i);
                nx[i] = *(const float4*)(x + (size_t)row0 * 1024 + lane * 4 + 256 * i);
            }
#pragma unroll 1
            for (int rr = 0; rr < 16; ++rr) {
                const int row = row0 + rr;
                float4 xm[4], xv[4];
                float ss = 0.f;
#pragma unroll
                for (int i = 0; i < 4; ++i) {
                    xm[i] = make_float4(__uint_as_float(nm[i].x << 16), __uint_as_float(nm[i].x & 0xffff0000u), __uint_as_float(nm[i].y << 16), __uint_as_float(nm[i].y & 0xffff0000u));
                    xv[i] = nx[i];
                    ss += xm[i].x * xm[i].x + xm[i].y * xm[i].y + xm[i].z * xm[i].z + xm[i].w * xm[i].w;
                }
                if (rr + 1 < 16) {
#pragma unroll
                    for (int i = 0; i < 4; ++i) {
                        nm[i] = *(const uint2*)(XMIX + (size_t)(row + 1) * 1024 + lane * 4 + 256 * i);
                        nx[i] = *(const float4*)(x + (size_t)(row + 1) * 1024 + lane * 4 + 256 * i);
                    }
                }
                ss = wave_sum_u(ss);
                const float r = rsqrtf(ss * (1.f / 1024.f) + 1e-6f);
                float4 x1[4];
                float s2 = 0.f;
#pragma unroll
                for (int i = 0; i < 4; ++i) {
                    const int d = lane * 4 + 256 * i;
                    x1[i].x = xv[i].x + c1[i].x * xm[i].x * r;
                    x1[i].y = xv[i].y + c1[i].y * xm[i].y * r;
                    x1[i].z = xv[i].z + c1[i].z * xm[i].z * r;
                    x1[i].w = xv[i].w + c1[i].w * xm[i].w * r;
                    s2 += x1[i].x * x1[i].x + x1[i].y * x1[i].y + x1[i].z * x1[i].z + x1[i].w * x1[i].w;
                    { uint2 t_; t_.x = pack2(x1[i].x, x1[i].y); t_.y = pack2(x1[i].z, x1[i].w); *(uint2*)(X1 + (size_t)row * 1024 + d) = t_; }
                }
                s2 = wave_sum_u(s2);
                const float r2 = rsqrtf(s2 * (1.f / 1024.f) + 1e-6f);
#pragma unroll
                for (int i = 0; i < 4; ++i) {
                    const int d = lane * 4 + 256 * i;
                    uint2 o;
                    o.x = pack2(x1[i].x * r2 * c2[i].x + c3[i].x, x1[i].y * r2 * c2[i].y + c3[i].y);
                    o.y = pack2(x1[i].z * r2 * c2[i].z + c3[i].z, x1[i].w * r2 * c2[i].w + c3[i].w);
                    *(uint2*)(HX2 + (size_t)row * 1024 + d) = o;
                }
            }
        }
        SEAM(10);
    }
#define QP ((bf16_t*)(p.ws + OFF_QP))
    if (IN(11)) for (int rep_ = 0; rep_ < NREP(11); ++rep_) {
#define WQ ((const bf16_t*)(p.ws + OFF_WQ))
        {
            pg8::Gemm g{HX2, WQ, NT, 2048, 1024}; pg8::StaticOrder S; S.init(NT, 2048, nb, bid); pg8::EpiStore16 E{QP, 2048};
            pg8::gemm_phase<pg8::EpiStore16, pg8::StaticOrder, true, true>((PG8_LAS unsigned char*)lds, g, S, E);
        }
        SEAM(11);
    }
#define IDX ((int*)(p.ws + OFF_IDX))
#define GATE ((float*)(p.ws + OFF_GATE))
    if (IN(12)) for (int rep_ = 0; rep_ < NREP(12); ++rep_) {
        phase_topk(p, QP, IDX, GATE, lds);
        SEAM(12);
    }
#define PART ((float*)(p.ws + OFF_QP))
#define pctr ((unsigned*)(p.ws + OFF_BAR))
    if (IN(13)) for (int rep_ = 0; rep_ < NREP(13); ++rep_) {
        phase_peer_u(HX2, IDX, PART, ws + OFF_UT, pctr, lds);
        SEAM(13);
    }
    if (IN(14)) for (int rep_ = 0; rep_ < NREP(14); ++rep_) {
        phase_peer_w(PART, GATE);
        SEAM(14);
    }
    if (IN(15)) for (int rep_ = 0; rep_ < NREP(15); ++rep_) {
        phase_peer_v(IDX, GATE, (bf16_t*)(ws + OFF_QP), ws + OFF_UT + (size_t)16384 * 1024, pctr + 8, lds);
        SEAM(15);
    }
    if (IN(16)) for (int rep_ = 0; rep_ < NREP(16); ++rep_) {
        phase_peer_final(p, X1, (const bf16_t*)(ws + OFF_QP), MOD, p.out);
    }
}

constexpr int NPHASES = 17;

extern "C" void kernel_launch(void* const* d_in, const int* in_sizes, int n_in, void* d_out, int out_size, void* d_ws, size_t ws_size,
                              hipStream_t stream) {
    static int grid_blocks = 0;
    if (grid_blocks == 0) {
        if (n_in != 32 || ws_size < WS_END || out_size != NT * DM) {
            fprintf(stderr, "kernel_launch: unexpected sizes n_in=%d ws=%zu (need %zu) out=%d\n", n_in, ws_size, (size_t)WS_END, out_size);
            grid_blocks = -1;
            return;
        }
        int dev = 0, cus = 0, per_cu = 0;
        hipGetDevice(&dev);
        hipDeviceGetAttribute(&cus, hipDeviceAttributeMultiprocessorCount, dev);
        hipFuncSetAttribute((const void*)mega, hipFuncAttributeMaxDynamicSharedMemorySize, LDS_BYTES);
        hipOccupancyMaxActiveBlocksPerMultiprocessor(&per_cu, (const void*)mega, NTHREADS, LDS_BYTES);
        if (per_cu < 1) { fprintf(stderr, "kernel_launch: occupancy query says %d blocks/CU\n", per_cu); per_cu = 1; }
        grid_blocks = cus;
        fprintf(stderr, "kernel_launch: cus=%d per_cu=%d grid=%d ws=%zu need=%zu\n", cus, per_cu, grid_blocks, ws_size, (size_t)WS_END);
    }
    if (grid_blocks < 0) return;
    Params p{};
    for (int i = 0; i < 32; ++i) p.in[i] = (const float*)d_in[i];
    p.out = (float*)d_out;
    p.ws = (unsigned char*)d_ws;
    p.ph_lo = 0; p.ph_hi = NPHASES;
    void* args[] = {&p};
    if (hipMemsetAsync((unsigned char*)d_ws + OFF_BAR, 0, (size_t)XCD_BAR_WORDS * 4, stream) != hipSuccess) { fprintf(stderr, "kernel_launch: memset of barrier words failed\n"); return; }
    hipError_t e = hipLaunchCooperativeKernel((const void*)mega, dim3(grid_blocks), dim3(NTHREADS), args, LDS_BYTES, stream);
    if (e != hipSuccess) fprintf(stderr, "cooperative launch failed: %s (grid %d)\n", hipGetErrorString(e), grid_blocks);
#if defined(PROBE_EXTRA_PHASE)
    {
        Params q = p; q.ph_lo = PROBE_EXTRA_PHASE; q.ph_hi = PROBE_EXTRA_PHASE + 1;
        void* args2[] = {&q};
        hipLaunchCooperativeKernel((const void*)mega, dim3(grid_blocks), dim3(NTHREADS), args2, LDS_BYTES, stream);
    }
#endif
}
```

```cpp
#include <hip/hip_runtime.h>
#include <hip/hip_bf16.h>
#include <hip/hip_cooperative_groups.h>
#include <cstdio>
namespace cg = cooperative_groups;

typedef unsigned short bf16_t;
using bf16x8 = __attribute__((ext_vector_type(8))) short;
using f32x4 = __attribute__((ext_vector_type(4))) float;
typedef __bf16 bf16x2_t __attribute__((ext_vector_type(2)));
using f32x16 = __attribute__((ext_vector_type(16))) float;

#define DEVI __device__ __forceinline__

constexpr int NB = 16, TL = 2048, DM = 1024, NT = NB * TL, TCX = 256, NC = NB * TCX;
constexpr int LD1 = 3584;
constexpr int LDC = 2560;
constexpr int LD2 = 3072;
constexpr int W1ROWS = 3712;
constexpr int NTHREADS = 512;
constexpr int LDS_BYTES = 139264;

constexpr size_t al256(size_t x) { return (x + 255) & ~(size_t)255; }
constexpr size_t OFF_WIN1 = 0;
constexpr size_t OFF_WIN2 = OFF_WIN1 + al256((size_t)W1ROWS * 1024 * 2);
constexpr size_t OFF_GLU  = OFF_WIN2 + al256((size_t)3072 * 1024 * 2);
constexpr size_t OFF_WB5  = OFF_GLU + al256((size_t)512 * 512 * 2);
constexpr size_t OFF_WBDN = OFF_WB5 + al256((size_t)1024 * 512 * 2);
constexpr size_t OFF_WOUT = OFF_WBDN + al256((size_t)1024 * 1024 * 2);
constexpr size_t OFF_WQ   = OFF_WOUT + al256((size_t)1024 * 1024 * 2);
constexpr size_t OFF_MOD  = OFF_WQ + al256((size_t)2048 * 1024 * 2);
constexpr size_t OFF_AB   = OFF_MOD + al256((size_t)17 * 6144 * 4);
constexpr size_t OFF_ABC  = OFF_AB + al256((size_t)NT * 32 * 4);
constexpr size_t OFF_S5ST = OFF_ABC + al256((size_t)NC * 32 * 4);
constexpr size_t OFF_DNST = OFF_S5ST + al256((size_t)NB * 32 * 2 * 64 * 2 * 4);
constexpr size_t OFF_PROJC = OFF_DNST + al256((size_t)NB * 8 * 2 * 128 * 128 * 4);
constexpr size_t OFF_CKV  = OFF_PROJC + al256((size_t)NC * LDC * 2);
constexpr size_t OFF_YF   = OFF_CKV + al256((size_t)NC * 2048 * 2);
constexpr size_t OFF_YB   = OFF_YF + al256((size_t)NT * 512 * 2);
constexpr size_t OFF_OF   = OFF_YB + al256((size_t)NT * 512 * 2);
constexpr size_t OFF_OB   = OFF_OF + al256((size_t)NT * 1024 * 2);
constexpr size_t OFF_PROJ1 = OFF_OB + al256((size_t)NT * 1024 * 2);
constexpr size_t OFF_BAR  = OFF_PROJ1 + al256((size_t)NT * LD1 * 2);
constexpr size_t WS_END   = OFF_BAR + al256((size_t)3456 * 4);
constexpr size_t OFF_PROJ2 = OFF_PROJ1;
constexpr size_t OFF_X1   = OFF_PROJ1;
constexpr size_t OFF_HX2  = OFF_PROJ1 + al256((size_t)NT * 1024 * 4);
constexpr size_t OFF_Y5   = OFF_YF;
constexpr size_t OFF_Y5G  = OFF_YB;
constexpr size_t OFF_YDN  = OFF_OF;
constexpr size_t OFF_MERGED = OFF_OB;
constexpr size_t OFF_QP   = OFF_OF;
constexpr size_t OFF_IDX  = OFF_YF;
constexpr size_t OFF_GATE = OFF_YB;
constexpr size_t OFF_UT   = OFF_PROJC;
constexpr size_t OFF_VT   = OFF_PROJC;
static_assert(OFF_HX2 + (size_t)NT * 1024 * 2 <= OFF_BAR, "alias overflow");
static_assert(OFF_UT + (size_t)16384 * 1024 * 2 <= OFF_YF, "UT overflow");
static_assert(OFF_VT + (size_t)16384 * 1024 * 2 <= OFF_YF, "VT overflow");
static_assert((size_t)NT * 128 * 4 <= (size_t)NT * 512 * 2, "idx alias");
constexpr size_t DO_HX = 0;
constexpr size_t DO_HC = (size_t)NT * 1024 * 2;

struct Params {
    const float* in[32];
    float* out;
    unsigned char* ws;
    int ph_lo, ph_hi;
};

DEVI float bf2f(bf16_t v) { return __uint_as_float(((unsigned)v) << 16); }
typedef float f32x2_t __attribute__((ext_vector_type(2)));
DEVI unsigned pack2(float a, float b) {
    const f32x2_t v = {a, b};
    return __builtin_bit_cast(unsigned, __builtin_convertvector(v, bf16x2_t));
}
DEVI bf16_t f2bf(float f) { return (bf16_t)(pack2(f, 0.f) & 0xffffu); }
DEVI float sigmoid_(float x) { return 1.f / (1.f + __expf(-x)); }
DEVI float silu_(float x) { return x / (1.f + __expf(-x)); }
DEVI float gelu_(float x) {
    float u = 0.7978845608028654f * (x + 0.044715f * x * x * x);
    return 0.5f * x * (1.f + tanhf(u));
}
DEVI float softplus_(float x) { return x > 20.f ? x : log1pf(__expf(x)); }
DEVI float wave_sum(float v) {
#pragma unroll
    for (int m = 32; m >= 1; m >>= 1) v += __shfl_xor(v, m);
    return v;
}
DEVI float wave_max(float v) {
#pragma unroll
    for (int m = 32; m >= 1; m >>= 1) v = fmaxf(v, __shfl_xor(v, m));
    return v;
}
DEVI float readlane_f(float v, int l) { return __int_as_float(__builtin_amdgcn_readlane(__float_as_int(v), l)); }

template <class Epi>
DEVI void gemm_tile(const bf16_t* A, int lda, const bf16_t* Bt, int ldb, int K, int m0, int n0,
                    unsigned char* lds, Epi epi) {
    constexpr int ST = 144;
    unsigned char* As = lds;
    unsigned char* Bs = lds + 128 * ST;
    const int tid = threadIdx.x, lane = tid & 63, w = tid >> 6, wm = w >> 2, wn = w & 3;
    f32x4 acc[4][2];
#pragma unroll
    for (int mi = 0; mi < 4; ++mi)
#pragma unroll
        for (int ni = 0; ni < 2; ++ni) acc[mi][ni] = (f32x4){0.f, 0.f, 0.f, 0.f};
    uint4 ra0, ra1, rb0, rb1;
    const int nk = K >> 6;
    const int lrow0 = tid >> 3, lkc = (tid & 7) * 8;
    const bf16_t* Ap = A + (size_t)(m0 + lrow0) * lda + lkc;
    const bf16_t* Bp = Bt + (size_t)(n0 + lrow0) * ldb + lkc;
    const size_t a64 = (size_t)64 * lda, b64 = (size_t)64 * ldb;
    ra0 = *(const uint4*)(Ap); ra1 = *(const uint4*)(Ap + a64);
    rb0 = *(const uint4*)(Bp); rb1 = *(const uint4*)(Bp + b64);
    for (int kt = 0; kt < nk; ++kt) {
        __syncthreads();
        *(uint4*)(As + lrow0 * ST + lkc * 2) = ra0;
        *(uint4*)(As + (lrow0 + 64) * ST + lkc * 2) = ra1;
        *(uint4*)(Bs + lrow0 * ST + lkc * 2) = rb0;
        *(uint4*)(Bs + (lrow0 + 64) * ST + lkc * 2) = rb1;
        __syncthreads();
        if (kt + 1 < nk) {
            const int ko = (kt + 1) * 64;
            ra0 = *(const uint4*)(Ap + ko); ra1 = *(const uint4*)(Ap + a64 + ko);
            rb0 = *(const uint4*)(Bp + ko); rb1 = *(const uint4*)(Bp + b64 + ko);
        }
#pragma unroll
        for (int ks = 0; ks < 2; ++ks) {
            bf16x8 af[4], bfr[2];
            const int kb = (ks * 32 + 8 * (lane >> 4)) * 2;
#pragma unroll
            for (int mi = 0; mi < 4; ++mi) af[mi] = *(const bf16x8*)(As + (wm * 64 + mi * 16 + (lane & 15)) * ST + kb);
#pragma unroll
            for (int ni = 0; ni < 2; ++ni) bfr[ni] = *(const bf16x8*)(Bs + (wn * 32 + ni * 16 + (lane & 15)) * ST + kb);
#pragma unroll
            for (int mi = 0; mi < 4; ++mi)
#pragma unroll
                for (int ni = 0; ni < 2; ++ni)
                    acc[mi][ni] = __builtin_amdgcn_mfma_f32_16x16x32_bf16(af[mi], bfr[ni], acc[mi][ni], 0, 0, 0);
        }
    }
#pragma unroll
    for (int mi = 0; mi < 4; ++mi)
#pragma unroll
        for (int ni = 0; ni < 2; ++ni)
#pragma unroll
            for (int r = 0; r < 4; ++r) {
                const int row = m0 + wm * 64 + mi * 16 + (lane >> 4) * 4 + r;
                const int col = n0 + wn * 32 + ni * 16 + (lane & 15);
                epi(row, col, acc[mi][ni][r]);
                if (r == 3) __builtin_amdgcn_sched_barrier(0);
            }
    __syncthreads();
}

DEVI void phase_adaln(const Params& p, float* MOD, unsigned char* lds) {
    float* sc = (float*)lds;
    float* red = sc + 17 * 1024;
    const int tid = threadIdx.x;
    const float* c = p.in[1];
    const float* cctx = p.in[3];
    const float* w_mod = p.in[4];
    const float* b_mod = p.in[5];
    const int nab = (int)gridDim.x < 192 ? (int)gridDim.x : 192;
    if ((int)blockIdx.x >= nab) return;
    for (int i = tid; i < 17 * 1024; i += NTHREADS) {
        int r = i >> 10, d = i & 1023;
        float v = r < 16 ? c[r * 1024 + d] : cctx[d];
        sc[i] = silu_(v);
    }
    __syncthreads();
    for (int item = blockIdx.x; item < 192; item += nab) {
        const int cc = tid & 31, kg = tid >> 5;
        const int col = item * 32 + cc;
        float acc[17];
#pragma unroll
        for (int r = 0; r < 17; ++r) acc[r] = 0.f;
        for (int k8 = kg * 64; k8 < kg * 64 + 64; k8 += 8) {
            float wv[8];
#pragma unroll
            for (int u = 0; u < 8; ++u) wv[u] = w_mod[(size_t)(k8 + u) * 6144 + col];
#pragma unroll
            for (int u = 0; u < 8; ++u)
#pragma unroll
                for (int r = 0; r < 17; ++r) acc[r] += sc[r * 1024 + k8 + u] * wv[u];
        }
#pragma unroll
        for (int r = 0; r < 17; ++r) red[(kg * 17 + r) * 32 + cc] = acc[r];
        __syncthreads();
        for (int o = tid; o < 17 * 32; o += NTHREADS) {
            const int r = o >> 5, c2 = o & 31;
            float s = b_mod[item * 32 + c2];
            for (int g = 0; g < 16; ++g) s += red[(g * 17 + r) * 32 + c2];
            MOD[r * 6144 + item * 32 + c2] = s;
        }
        __syncthreads();
    }
}

DEVI void conv_seg(const float* src, int K, int ldsrc, int col0, int ncols, bf16_t* dst, int drow0, unsigned char* lds, int vb, int nvb) {
    float* tile = (float*)lds;
    const int tid = threadIdx.x;
    const int ntn = (ncols + 63) >> 6, ntk = K >> 6;
    const int r0 = tid >> 4, c4 = (tid & 15) * 4;
    float4 v0, v1;
    auto tload = [&](int t) {
        const int tn = t / ntk, tk = t % ntk;
        const int n0 = tn * 64, k0 = tk * 64;
        v0 = make_float4(0.f, 0.f, 0.f, 0.f); v1 = v0;
        if (n0 + c4 < ncols) {
            v0 = *(const float4*)(src + (size_t)(k0 + r0) * ldsrc + col0 + n0 + c4);
            v1 = *(const float4*)(src + (size_t)(k0 + r0 + 32) * ldsrc + col0 + n0 + c4);
        }
    };
    if (vb < ntn * ntk) tload(vb);
    for (int t = vb; t < ntn * ntk; t += nvb) {
        const int tn = t / ntk, tk = t % ntk;
        const int n0 = tn * 64, k0 = tk * 64;
        __syncthreads();
        tile[r0 * 65 + c4 + 0] = v0.x; tile[r0 * 65 + c4 + 1] = v0.y; tile[r0 * 65 + c4 + 2] = v0.z; tile[r0 * 65 + c4 + 3] = v0.w;
        tile[(r0 + 32) * 65 + c4 + 0] = v1.x; tile[(r0 + 32) * 65 + c4 + 1] = v1.y; tile[(r0 + 32) * 65 + c4 + 2] = v1.z; tile[(r0 + 32) * 65 + c4 + 3] = v1.w;
        __syncthreads();
        if (t + nvb < ntn * ntk) tload(t + nvb);
        {
            const int n = tid >> 3, kq = (tid & 7) * 8;
            if (n0 + n < ncols) {
                uint4 o;
                o.x = pack2(tile[(kq + 0) * 65 + n], tile[(kq + 1) * 65 + n]);
                o.y = pack2(tile[(kq + 2) * 65 + n], tile[(kq + 3) * 65 + n]);
                o.z = pack2(tile[(kq + 4) * 65 + n], tile[(kq + 5) * 65 + n]);
                o.w = pack2(tile[(kq + 6) * 65 + n], tile[(kq + 7) * 65 + n]);
                *(uint4*)(dst + (size_t)(drow0 + n0 + n) * K + k0 + kq) = o;
            }
        }
    }
    __syncthreads();
}

DEVI void phase_weights(const Params& p, unsigned char* lds) {
    unsigned char* ws = p.ws;
    bf16_t* WIN1 = (bf16_t*)(ws + OFF_WIN1);
    bf16_t* WIN2 = (bf16_t*)(ws + OFF_WIN2);
    const int nvb = gridDim.x;
    const int vb = ((int)blockIdx.x + nvb - 192 % nvb) % nvb;
    const float* w_in = p.in[10];
    conv_seg(w_in, 1024, 6688, 0, 2560, WIN1, 0, lds, vb, nvb);
    conv_seg(w_in, 1024, 6688, 2592, 1024, WIN1, 2560, lds, vb, nvb);
    conv_seg(w_in, 1024, 6688, 2560, 32, WIN1, 3584, lds, vb, nvb);
    conv_seg(w_in, 1024, 6688, 3616, 3072, WIN2, 0, lds, vb, nvb);
    conv_seg(p.in[19], 512, 512, 0, 512, (bf16_t*)(ws + OFF_GLU), 0, lds, vb, nvb);
    conv_seg(p.in[25], 512, 1024, 0, 1024, (bf16_t*)(ws + OFF_WB5), 0, lds, vb, nvb);
    conv_seg(p.in[26], 1024, 1024, 0, 1024, (bf16_t*)(ws + OFF_WBDN), 0, lds, vb, nvb);
    conv_seg(p.in[27], 1024, 1024, 0, 1024, (bf16_t*)(ws + OFF_WOUT), 0, lds, vb, nvb);
    conv_seg(p.in[28], 1024, 2048, 0, 2048, (bf16_t*)(ws + OFF_WQ), 0, lds, vb, nvb);
    {
        uint4* z = (uint4*)(WIN1 + (size_t)3616 * 1024);
        const int n16 = 96 * 1024 * 2 / 16;
        for (int i = vb * NTHREADS + threadIdx.x; i < n16; i += nvb * NTHREADS) z[i] = make_uint4(0, 0, 0, 0);
    }
}

template <int RUN>
DEVI void modulate_rows(const float* X, int nrows, int rows_per_batch, const float* gain, const float* shift0, const float* scale0,
                        int bstride, bf16_t* OUT) {
    const int lane = threadIdx.x & 63, w = threadIdx.x >> 6;
    for (int run = blockIdx.x * 8 + w; run < nrows / RUN; run += gridDim.x * 8) {
        const int row0 = run * RUN;
        const int b = row0 / rows_per_batch;
        const float* sh = shift0 + (size_t)b * bstride;
        const float* scl = scale0 + (size_t)b * bstride;
        float4 c1[4], c2[4];
#pragma unroll
        for (int i = 0; i < 4; ++i) {
            const int d = lane * 4 + 256 * i;
            const float4 g = *(const float4*)(gain + d), s = *(const float4*)(scl + d);
            c1[i] = make_float4(g.x * (1.f + s.x), g.y * (1.f + s.y), g.z * (1.f + s.z), g.w * (1.f + s.w));
            c2[i] = *(const float4*)(sh + d);
        }
        float4 nv[4];
#pragma unroll
        for (int i = 0; i < 4; ++i) nv[i] = *(const float4*)(X + (size_t)row0 * 1024 + lane * 4 + 256 * i);
#pragma unroll 1
        for (int rr = 0; rr < RUN; ++rr) {
            const int row = row0 + rr;
            float4 v[4];
            float ss = 0.f;
#pragma unroll
            for (int i = 0; i < 4; ++i) {
                v[i] = nv[i];
                ss += v[i].x * v[i].x + v[i].y * v[i].y + v[i].z * v[i].z + v[i].w * v[i].w;
            }
            if (rr + 1 < RUN) {
#pragma unroll
                for (int i = 0; i < 4; ++i) nv[i] = *(const float4*)(X + (size_t)(row + 1) * 1024 + lane * 4 + 256 * i);
            }
            ss = wave_sum(ss);
            const float r = rsqrtf(ss * (1.f / 1024.f) + 1e-6f);
#pragma unroll
            for (int i = 0; i < 4; ++i) {
                const int d = lane * 4 + 256 * i;
                uint2 o;
                o.x = pack2(v[i].x * r * c1[i].x + c2[i].x, v[i].y * r * c1[i].y + c2[i].y);
                o.y = pack2(v[i].z * r * c1[i].z + c2[i].z, v[i].w * r * c1[i].w + c2[i].w);
                *(uint2*)(OUT + (size_t)row * 1024 + d) = o;
            }
        }
    }
}


template <bool READOUT>
DEVI void s5_mfma(const Params& p, const bf16_t* U, int ldu, int Tlen, int bp, int g, int dir,
                  const float* S5in, float* S5out, bf16_t* Y, unsigned char* wl  ) {
    constexpr int HST = 272;
    unsigned char* Himg = wl;
    const int lane = threadIdx.x & 63;
    const int p0 = lane & 31, hf = lane >> 5;
    const int dg = dir * 32 + g;
    const float step = expf(p.in[13][dg]);
    float ar[2], ai[2], hr[2], hi[2];
    bf16x8 Bf[4];
#pragma unroll
    for (int pt = 0; pt < 2; ++pt) {
        const int pp = dg * 64 + pt * 32 + p0;
        const float lr = p.in[11][pp], li = p.in[12][pp];
        const float mag = expf(lr * step);
        ar[pt] = mag * cosf(li * step); ai[pt] = mag * sinf(li * step);
        const float den = lr * lr + li * li;
        const float fr = ((ar[pt] - 1.f) * lr + ai[pt] * li) / den;
        const float fi = (ai[pt] * lr - (ar[pt] - 1.f) * li) / den;
        bf16x8 bre, bim;
#pragma unroll
        for (int j = 0; j < 8; ++j) {
            const float br = p.in[14][pp * 16 + 8 * hf + j], bi = p.in[15][pp * 16 + 8 * hf + j];
            bre[j] = (short)f2bf(fr * br - fi * bi);
            bim[j] = (short)f2bf(fr * bi + fi * br);
        }
        Bf[pt] = bre; Bf[2 + pt] = bim;
        hr[pt] = 0.f; hi[pt] = 0.f;
    }
    const int myb = 2 * bp + hf;
    if (S5in) {
        const float* h0 = S5in + (size_t)((myb * 32 + g) * 2 + dir) * 128;
#pragma unroll
        for (int pt = 0; pt < 2; ++pt) { hr[pt] = h0[pt * 32 + p0]; hi[pt] = h0[64 + pt * 32 + p0]; }
    }
    bf16x8 Cf[4], Df;
    if (READOUT) {
        const int h = lane & 15, kq = lane >> 4;
#pragma unroll
        for (int ks = 0; ks < 4; ++ks) {
            bf16x8 c;
#pragma unroll
            for (int j = 0; j < 8; ++j) {
                const int pl = ks * 8 + 2 * kq + (j >> 2), tile = j & 3;
                const int pidx = (dg * 16 + h) * 64 + (tile & 1) * 32 + pl;
                const float v = (tile < 2) ? p.in[16][pidx] : -p.in[17][pidx];
                c[j] = (short)f2bf(v);
            }
            Cf[ks] = c;
        }
#pragma unroll
        for (int j = 0; j < 8; ++j) {
            const int k = 8 * kq + j;
            Df[j] = (short)((k == h) ? f2bf(p.in[18][g * 16 + h]) : (bf16_t)0);
        }
    }
    const int m = lane & 31, kh = lane >> 5;
    const int ahf = (m >> 2) & 1, ai_tok = (m & 3) + 4 * (m >> 3);
    const int ab = 2 * bp + ahf;
    const int nblk = Tlen >> 4;
    const bf16_t* Ubase = U + (size_t)ab * Tlen * ldu + g * 16 + 8 * kh;
    auto tok_of = [&](int blk, int i) -> int {
        const int t0 = dir ? (Tlen - 16 * (blk + 1)) : 16 * blk;
        return dir ? (t0 + 15 - i) : (t0 + i);
    };
    auto scan_block = [&](const uint4& acur, int buf) {
        const bf16x8 af = __builtin_bit_cast(bf16x8, acur);
        f32x16 X[4];
#pragma unroll
        for (int t = 0; t < 4; ++t) {
            f32x16 z;
#pragma unroll
            for (int r = 0; r < 16; ++r) z[r] = 0.f;
            X[t] = __builtin_amdgcn_mfma_f32_32x32x16_bf16(af, Bf[t], z, 0, 0, 0);
        }
        unsigned char* Hb = Himg + buf * (32 * HST + 1024);
        if (READOUT && dir == 0) *(uint4*)(Hb + 32 * HST + (ahf * 16 + ai_tok) * 32 + kh * 16) = acur;
#pragma unroll
        for (int r = 0; r < 16; ++r) {
#pragma unroll
            for (int pt = 0; pt < 2; ++pt) {
                const float nr = ar[pt] * hr[pt] - ai[pt] * hi[pt] + X[pt][r];
                const float ni = ar[pt] * hi[pt] + ai[pt] * hr[pt] + X[2 + pt][r];
                hr[pt] = nr; hi[pt] = ni;
                X[pt][r] = nr; X[2 + pt][r] = ni;
            }
            if (READOUT) {
                uint2 o;
                o.x = pack2(X[0][r], X[1][r]);
                o.y = pack2(X[2][r], X[3][r]);
                *(uint2*)(Hb + (hf * 16 + r) * HST + p0 * 8) = o;
            }
        }
    };
    uint4 anext = *(const uint4*)(Ubase + (size_t)tok_of(0, ai_tok) * ldu);
    {
        const uint4 a0 = anext;
        if (nblk > 1) anext = *(const uint4*)(Ubase + (size_t)tok_of(1, ai_tok) * ldu);
        scan_block(a0, 0);
    }
    for (int blk = 0; blk < nblk; ++blk) {
        const int buf = blk & 1;
        f32x4 yacc[2];
        if (READOUT) {
            const int kq = lane >> 4;
            const unsigned char* Hb = Himg + buf * (32 * HST + 1024);
#pragma unroll
            for (int hb = 0; hb < 2; ++hb) {
                yacc[hb] = (f32x4){0.f, 0.f, 0.f, 0.f};
#pragma unroll
                for (int ks = 0; ks < 4; ++ks) {
                    const bf16x8 hfrag = *(const bf16x8*)(Hb + (hb * 16 + (lane & 15)) * HST + (ks * 32 + 8 * kq) * 2);
                    yacc[hb] = __builtin_amdgcn_mfma_f32_16x16x32_bf16(hfrag, Cf[ks], yacc[hb], 0, 0, 0);
                }
                if (dir == 0) {
                    uint4 uu = make_uint4(0, 0, 0, 0);
                    if (kq < 2) uu = *(const uint4*)(Hb + 32 * HST + (hb * 16 + (lane & 15)) * 32 + kq * 16);
                    yacc[hb] = __builtin_amdgcn_mfma_f32_16x16x32_bf16(__builtin_bit_cast(bf16x8, uu), Df, yacc[hb], 0, 0, 0);
                }
            }
        }
        if (blk + 1 < nblk) {
            const uint4 acur = anext;
            if (blk + 2 < nblk) anext = *(const uint4*)(Ubase + (size_t)tok_of(blk + 2, ai_tok) * ldu);
            scan_block(acur, buf ^ 1);
        }
        if (READOUT) {
            const int h = lane & 15, kq = lane >> 4;
#pragma unroll
            for (int hb = 0; hb < 2; ++hb) {
                const int ob = 2 * bp + hb;
#pragma unroll
                for (int r = 0; r < 4; ++r) {
                    const int tok = tok_of(blk, 4 * kq + r);
                    Y[((size_t)ob * Tlen + tok) * 512 + g * 16 + h] = f2bf(yacc[hb][r]);
                }
            }
        }
    }
    if (S5out) {
        float* ho = S5out + (size_t)((myb * 32 + g) * 2 + dir) * 128;
#pragma unroll
        for (int pt = 0; pt < 2; ++pt) { ho[pt * 32 + p0] = hr[pt]; ho[64 + pt * 32 + p0] = hi[pt]; }
    }
}

template <int CTRL>
DEVI float dpp_add(float v) {
    const int iv = __float_as_int(v);
    const int r = __builtin_amdgcn_update_dpp(0, iv, CTRL, 0xf, 0xf, true);
    return v + __int_as_float(r);
}
DEVI float red8(float v) {
    v = dpp_add<0xB1>(v);
    v = dpp_add<0x4E>(v);
    v = dpp_add<0x141>(v);
    return v;
}

#ifndef DN_DUP
#define DN_DUP -1
#endif
typedef short s16x4 __attribute__((ext_vector_type(4)));
DEVI int pos32(int x) { return ((x >> 2) & 3) * 8 + (x >> 4) * 4 + (x & 3); }
DEVI unsigned cvtpk(float lo, float hi) { return pack2(lo, hi); }
DEVI s16x4 cvt4(const f32x4& v) { uint2 t; t.x = cvtpk(v[0], v[1]); t.y = cvtpk(v[2], v[3]); return __builtin_bit_cast(s16x4, t); }
DEVI bf16x8 cvt8(const f32x4& a, const f32x4& b) { uint4 t; t.x = cvtpk(a[0], a[1]); t.y = cvtpk(a[2], a[3]); t.z = cvtpk(b[0], b[1]); t.w = cvtpk(b[2], b[3]); return __builtin_bit_cast(bf16x8, t); }
DEVI f32x4 mfma16(const s16x4& a, const s16x4& b, const f32x4& c) { return __builtin_amdgcn_mfma_f32_16x16x16bf16_1k(a, b, c, 0, 0, 0); }
DEVI f32x4 mfma32(const bf16x8& a, const bf16x8& b, const f32x4& c) { return __builtin_amdgcn_mfma_f32_16x16x32_bf16(a, b, c, 0, 0, 0); }

DEVI s16x4 lds_tr_read(const unsigned char* p) { return __builtin_amdgcn_ds_read_tr16_b64_v4i16((__attribute__((address_space(3))) s16x4*)p); }
DEVI void lds_barrier() { asm volatile("s_waitcnt lgkmcnt(0)" ::: "memory"); __builtin_amdgcn_s_barrier(); asm volatile("" ::: "memory"); }
template <bool HAS_Q>
DEVI void dn_chunked(const Params& p, const bf16_t* Kg, const bf16_t* Vg, const bf16_t* Qg, int ld, const float* AB, int tokbase, int Tlen,
                     int head, int dir, const float* S0, float* Sout, bf16_t* O, unsigned char* lds) {
    constexpr int RS = 272, TS = 144, BS = 40;
    constexpr int KP_OFF = 0, QP_OFF = 17408, WP_OFF = 34816, KT_OFF = 52224, VT_OFF = 70656, AT_OFF = 89088, AB_OFF = 98304,
                  AF_OFF = 107520, TN_OFF = 111872, TSW_OFF = 114432, TSU_OFF = 116992, GT_OFF = 119552, OT_OFF = 120848;
    float* gt = (float*)(lds + GT_OFF);
    const int tid = threadIdx.x, lane = tid & 63, w = tid >> 6;
    const int m = lane & 15, q = lane >> 4;
    f32x4 S[8];
#pragma unroll
    for (int mt = 0; mt < 8; ++mt) {
        if (S0) {
#pragma unroll
            for (int r = 0; r < 4; ++r) S[mt][r] = S0[(size_t)(16 * mt + 4 * q + r) * 128 + 16 * w + m];
        } else S[mt] = (f32x4){0.f, 0.f, 0.f, 0.f};
    }
    const float aexp = expf(p.in[22][dir * 8 + head]);
    const float dtb = p.in[23][dir * 8 + head];
    const int nch = Tlen >> 6;
    uint4 rk0, rk1, rq0, rq1, rv0, rv1; float rg = 0.f, rb = 0.f;
    rq0 = make_uint4(0, 0, 0, 0); rq1 = rq0;
    auto gload = [&](int ci) {
        const int cb = dir ? (nch - 1 - ci) : ci;
        const size_t tok = (size_t)(tokbase + cb * 64 + (dir ? (63 - lane) : lane));
        const bf16_t* kp = Kg + tok * ld + 16 * w;
        const bf16_t* vp = Vg + tok * ld + 16 * w;
        rk0 = *(const uint4*)kp; rk1 = *(const uint4*)(kp + 8);
        rv0 = *(const uint4*)vp; rv1 = *(const uint4*)(vp + 8);
        if (HAS_Q) { const bf16_t* qp = Qg + tok * ld + 16 * w; rq0 = *(const uint4*)qp; rq1 = *(const uint4*)(qp + 8); }
        if (w == 0) { rg = AB[tok * 32 + (2 * dir) * 8 + head]; rb = AB[tok * 32 + (2 * dir + 1) * 8 + head]; }
    };
    gload(0);
    for (int ci = 0; ci < nch; ++ci) {
        for (int dup0_ = 0; dup0_ < (DN_DUP == 0 ? 2 : 1); ++dup0_)
        {
            const int Bk = w >> 1, tk = w & 1;
            unsigned char* kr = lds + KP_OFF + lane * RS + 2 * (32 * Bk + 4 * tk);
            *(uint2*)(kr + 0)  = make_uint2(rk0.x, rk0.y);
            *(uint2*)(kr + 16) = make_uint2(rk0.z, rk0.w);
            *(uint2*)(kr + 32) = make_uint2(rk1.x, rk1.y);
            *(uint2*)(kr + 48) = make_uint2(rk1.z, rk1.w);
            if (HAS_Q) {
                unsigned char* qr = lds + QP_OFF + lane * RS + 2 * (32 * Bk + 4 * tk);
                *(uint2*)(qr + 0)  = make_uint2(rq0.x, rq0.y);
                *(uint2*)(qr + 16) = make_uint2(rq0.z, rq0.w);
                *(uint2*)(qr + 32) = make_uint2(rq1.x, rq1.y);
                *(uint2*)(qr + 48) = make_uint2(rq1.z, rq1.w);
            }
            {
                unsigned char* vr = lds + VT_OFF + lane * RS + 32 * w;
                *(uint4*)(vr) = rv0; *(uint4*)(vr + 16) = rv1;
            }
            if (w == 0) {
                float g = -aexp * softplus_(rg + dtb);
#pragma unroll
                for (int d = 1; d < 64; d <<= 1) { const float t = __shfl_up(g, d); if (lane >= d) g += t; }
                const float glast = __shfl(g, 63);
                const float beta = sigmoid_(rb), eg = __expf(g);
                gt[lane] = g; gt[64 + lane] = eg; gt[128 + lane] = beta; gt[192 + lane] = __expf(glast - g); gt[256 + lane] = beta * eg;
                if (lane == 0) gt[320] = __expf(glast);
            }
        }
        if (ci + 1 < nch) gload(ci + 1);
        lds_barrier();
        auto gram_job = [&](int type, int t10) {
            const int ct = (t10 >= 6) ? 3 : (t10 >= 3) ? 2 : (t10 >= 1) ? 1 : 0;
            const int st = t10 - ct * (ct + 1) / 2;
            const unsigned char* xa = lds + (type ? QP_OFF : KP_OFF) + (16 * ct + m) * RS + 16 * q;
            const unsigned char* xb = lds + KP_OFF + (16 * st + m) * RS + 16 * q;
            bf16x8 fa[4], fb[4];
#pragma unroll
            for (int B = 0; B < 4; ++B) { fa[B] = *(const bf16x8*)(xa + 64 * B); fb[B] = *(const bf16x8*)(xb + 64 * B); }
            f32x4 acc = (f32x4){0.f, 0.f, 0.f, 0.f};
#pragma unroll
            for (int B = 0; B < 4; ++B) acc = mfma32(fa[B], fb[B], acc);
            const int sidx = 16 * st + m;
            const float gs = gt[sidx];
#pragma unroll
            for (int r = 0; r < 4; ++r) {
                const int c = 16 * ct + 4 * q + r;
                const float dec = __expf(fminf(gt[c] - gs, 0.f));
                if (type == 0) {
                    const float a = (sidx < c) ? gt[128 + c] * acc[r] * dec : 0.f;
                    *(unsigned short*)(lds + AB_OFF + c * TS + 2 * sidx) = f2bf(a);
                    if (ct == st) *(float*)(lds + AF_OFF + ((ct * 16 + (c & 15)) * 17 + m) * 4) = a;
                } else {
                    const float a = (sidx <= c) ? acc[r] * dec : 0.f;
                    *(unsigned short*)(lds + AT_OFF + c * TS + 2 * (32 * (sidx >> 5) + pos32(sidx & 31))) = f2bf(a);
                }
            }
        };
        for (int dup1_ = 0; dup1_ < (DN_DUP == 1 ? 2 : 1); ++dup1_) for (int j = w; j < 10; j += 8) gram_job(0, j);
        lds_barrier();
        if (w == 0) for (int dup2_ = 0; dup2_ < (DN_DUP == 2 ? 2 : 1); ++dup2_) {
            const int r = q, col = m;
            const float* af = (const float*)(lds + AF_OFF) + r * 16 * 17;
            float t[16];
#pragma unroll
            for (int i = 0; i < 16; ++i) t[i] = (i == col) ? 1.f : 0.f;
#pragma unroll
            for (int jj = 0; jj < 15; ++jj) {
#pragma unroll
                for (int i = jj + 1; i < 16; ++i) t[i] -= af[i * 17 + jj] * t[jj];
                if ((jj & 1) == 1) __builtin_amdgcn_sched_barrier(0);
            }
            const float sw = gt[256 + 16 * r + col], su = gt[128 + 16 * r + col];
#pragma unroll
            for (int i = 0; i < 16; ++i) {
                *(unsigned short*)(lds + TN_OFF + (r * 16 + i) * BS + 2 * col) = f2bf(-t[i]);
                *(unsigned short*)(lds + TSW_OFF + (r * 16 + i) * BS + 2 * col) = f2bf(t[i] * sw);
                *(unsigned short*)(lds + TSU_OFF + (r * 16 + i) * BS + 2 * col) = f2bf(t[i] * su);
            }
        } else if (HAS_Q) {
            for (int j = w - 1; j < 10; j += 7) gram_job(1, j);
            for (int idx = tid - 64; idx < 6 * 256; idx += NTHREADS - 64) {
                const int tile = idx >> 8, e = idx & 255;
                const int ct = (tile < 3) ? 0 : (tile < 5) ? 1 : 2;
                const int st = (tile < 3) ? tile + 1 : (tile < 5) ? tile - 1 : 3;
                const int c = 16 * ct + (e >> 4), sidx = 16 * st + (e & 15);
                *(unsigned short*)(lds + AT_OFF + c * TS + 2 * (32 * (sidx >> 5) + pos32(sidx & 31))) = 0;
            }
        }
        lds_barrier();
        f32x4 vn[4];
        for (int dup3_ = 0; dup3_ < (DN_DUP == 3 ? 2 : 1); ++dup3_) {
            const int tq = (lane & 15) >> 2, tp = lane & 3;
            const unsigned char* xtk = lds + KP_OFF + (4 * q + tq) * RS + 2 * (32 * (w >> 1) + 8 * tp + 4 * (w & 1));
            const unsigned char* xtv = lds + VT_OFF + (4 * q + tq) * RS + 2 * (16 * w + 4 * tp);
            s16x4 XbW[4], XbU[4];
            f32x4 XW[4];
#pragma unroll
            for (int r = 0; r < 4; ++r) {
                const s16x4 a_tw = *(const s16x4*)(lds + TSW_OFF + (r * 16 + m) * BS + 8 * q);
                const s16x4 a_tu = *(const s16x4*)(lds + TSU_OFF + (r * 16 + m) * BS + 8 * q);
                const s16x4 b_k = lds_tr_read(xtk + 16 * r * RS);
                const s16x4 b_v = lds_tr_read(xtv + 16 * r * RS);
                XW[r] = mfma16(a_tw, b_k, (f32x4){0.f, 0.f, 0.f, 0.f});
                vn[r] = mfma16(a_tu, b_v, (f32x4){0.f, 0.f, 0.f, 0.f});
                if (r > 0) {
                    f32x4 accW = (f32x4){0.f, 0.f, 0.f, 0.f}, accU = (f32x4){0.f, 0.f, 0.f, 0.f};
#pragma unroll
                    for (int c = 0; c < r; ++c) {
                        const s16x4 a_ab = *(const s16x4*)(lds + AB_OFF + (16 * r + m) * TS + 2 * (16 * c + 4 * q));
                        accW = mfma16(a_ab, XbW[c], accW);
                        accU = mfma16(a_ab, XbU[c], accU);
                    }
                    const s16x4 a_tn = *(const s16x4*)(lds + TN_OFF + (r * 16 + m) * BS + 8 * q);
                    XW[r] = mfma16(a_tn, cvt4(accW), XW[r]);
                    vn[r] = mfma16(a_tn, cvt4(accU), vn[r]);
                }
                XbW[r] = cvt4(XW[r]);
                XbU[r] = cvt4(vn[r]);
            }
            const int colpos = 32 * (w >> 1) + pos32(16 * (w & 1) + m);
#pragma unroll
            for (int r = 0; r < 4; ++r)
#pragma unroll
                for (int rr = 0; rr < 4; ++rr)
                    *(unsigned short*)(lds + WP_OFF + (16 * r + 4 * q + rr) * RS + 2 * colpos) = f2bf(-XW[r][rr]);
        }
        lds_barrier();
        bf16x8 Sf[4];
#pragma unroll
        for (int B = 0; B < 4; ++B) Sf[B] = cvt8(S[2 * B], S[2 * B + 1]);
#pragma unroll
        for (int r = 0; r < 4; ++r) {
            bf16x8 wf[4];
#pragma unroll
            for (int B = 0; B < 4; ++B) wf[B] = *(const bf16x8*)(lds + WP_OFF + (16 * r + m) * RS + 64 * B + 16 * q);
#pragma unroll
            for (int B = 0; B < 4; ++B) vn[r] = mfma32(wf[B], Sf[B], vn[r]);
        }
        if (HAS_Q) {
            const int cb = dir ? (nch - 1 - ci) : ci;
            f32x4 o[4];
#pragma unroll
            for (int r = 0; r < 4; ++r) o[r] = (f32x4){0.f, 0.f, 0.f, 0.f};
#pragma unroll
            for (int r = 0; r < 4; ++r) {
                bf16x8 qf[4];
#pragma unroll
                for (int B = 0; B < 4; ++B) qf[B] = *(const bf16x8*)(lds + QP_OFF + (16 * r + m) * RS + 64 * B + 16 * q);
#pragma unroll
                for (int B = 0; B < 4; ++B) o[r] = mfma32(qf[B], Sf[B], o[r]);
            }
            const bf16x8 Vn0 = cvt8(vn[0], vn[1]), Vn1 = cvt8(vn[2], vn[3]);
            bf16x8 af0[4], af1[2];
#pragma unroll
            for (int r = 0; r < 4; ++r) af0[r] = *(const bf16x8*)(lds + AT_OFF + (16 * r + m) * TS + 16 * q);
#pragma unroll
            for (int r = 2; r < 4; ++r) af1[r - 2] = *(const bf16x8*)(lds + AT_OFF + (16 * r + m) * TS + 64 + 16 * q);
#pragma unroll
            for (int r = 0; r < 4; ++r) {
                const f32x4 egv = *(const f32x4*)(gt + 64 + 16 * r + 4 * q);
                o[r] = o[r] * egv;
            }
#pragma unroll
            for (int r = 0; r < 4; ++r) o[r] = mfma32(af0[r], Vn0, o[r]);
#pragma unroll
            for (int r = 2; r < 4; ++r) o[r] = mfma32(af1[r - 2], Vn1, o[r]);
            unsigned char* ot = lds + OT_OFF + w * 2048;
#pragma unroll
            for (int r = 0; r < 4; ++r)
#pragma unroll
                for (int rr = 0; rr < 4; ++rr) *(unsigned short*)(ot + (16 * r + 4 * q + rr) * 32 + 2 * m) = f2bf(o[r][rr]);
            {
                const uint4 o0 = *(const uint4*)(ot + lane * 32), o1 = *(const uint4*)(ot + lane * 32 + 16);
                const size_t tok = (size_t)(tokbase + cb * 64 + (dir ? (63 - lane) : lane));
                bf16_t* op = O + tok * 1024 + head * 128 + 16 * w;
                *(uint4*)op = o0; *(uint4*)(op + 8) = o1;
            }
        }
        {
            f32x4 vk[4];
#pragma unroll
            for (int r = 0; r < 4; ++r) {
                const f32x4 kdv = *(const f32x4*)(gt + 192 + 16 * r + 4 * q);
                vk[r] = vn[r] * kdv;
            }
            const bf16x8 Vk0 = cvt8(vk[0], vk[1]), Vk1 = cvt8(vk[2], vk[3]);
            const float eS = gt[320];
#pragma unroll
            for (int mt = 0; mt < 8; ++mt) S[mt] = S[mt] * eS;
            const int tq = (lane & 15) >> 2, tp = lane & 3;
#pragma unroll
            for (int hh = 0; hh < 2; ++hh) {
                s16x4 kf[4][4];
#pragma unroll
                for (int mi = 0; mi < 4; ++mi) {
                    const int mt = 4 * hh + mi;
                    const unsigned char* kr = lds + KP_OFF + (4 * q + tq) * RS + 2 * (32 * (mt >> 1) + 8 * tp + 4 * (mt & 1));
                    kf[mi][0] = lds_tr_read(kr); kf[mi][1] = lds_tr_read(kr + 16 * RS); kf[mi][2] = lds_tr_read(kr + 32 * RS); kf[mi][3] = lds_tr_read(kr + 48 * RS);
                }
#pragma unroll
                for (int mi = 0; mi < 4; ++mi) {
                    const uint2 a0 = __builtin_bit_cast(uint2, kf[mi][0]), a1 = __builtin_bit_cast(uint2, kf[mi][1]);
                    S[4 * hh + mi] = mfma32(__builtin_bit_cast(bf16x8, make_uint4(a0.x, a0.y, a1.x, a1.y)), Vk0, S[4 * hh + mi]);
                }
#pragma unroll
                for (int mi = 0; mi < 4; ++mi) {
                    const uint2 a2 = __builtin_bit_cast(uint2, kf[mi][2]), a3 = __builtin_bit_cast(uint2, kf[mi][3]);
                    S[4 * hh + mi] = mfma32(__builtin_bit_cast(bf16x8, make_uint4(a2.x, a2.y, a3.x, a3.y)), Vk1, S[4 * hh + mi]);
                }
            }
        }
        lds_barrier();
    }
    if (Sout) {
#pragma unroll
        for (int mt = 0; mt < 8; ++mt)
#pragma unroll
            for (int r = 0; r < 4; ++r) Sout[(size_t)(16 * mt + 4 * q + r) * 128 + 16 * w + m] = S[mt][r];
    }
}

DEVI void cswap_desc(float& a, float& b) { const float hi = fmaxf(a, b), lo = fminf(a, b); a = hi; b = lo; }
DEVI void sort16_desc(float (&v)[16]) {
#pragma unroll
    for (int k = 2; k <= 16; k <<= 1)
#pragma unroll
        for (int j = k >> 1; j > 0; j >>= 1)
#pragma unroll
            for (int i = 0; i < 16; ++i) {
                const int l = i ^ j;
                if (l > i) {
                    if ((i & k) == 0) cswap_desc(v[i], v[l]); else cswap_desc(v[l], v[i]);
                }
            }
}
DEVI void merge16_desc(float (&a)[16], const float (&b)[16]) {
#pragma unroll
    for (int i = 0; i < 16; ++i) a[i] = fmaxf(a[i], b[15 - i]);
#pragma unroll
    for (int j = 8; j > 0; j >>= 1)
#pragma unroll
        for (int i = 0; i < 16; ++i) {
            const int l = i ^ j;
            if (l > i) cswap_desc(a[i], a[l]);
        }
}

DEVI void phase_topk(const Params& p, const bf16_t* QP, int* IDX, float* GV, unsigned char* lds) {
    constexpr int KST = 272;
    const int tid = threadIdx.x, lane = tid & 63, w = tid >> 6;
    const int nb = gridDim.x;
    const int head = blockIdx.x & 7;
    const int bsub = blockIdx.x >> 3, nsub = (nb + 7 - head) / 8;
    const float* sk = p.in[29] + (size_t)head * 2 * 128 * 128;
    __syncthreads();
    for (int i = tid; i < 256 * 32; i += NTHREADS) {
        const int row = i >> 5, d4 = (i & 31) * 4;
        const float4 v = *(const float4*)(sk + row * 128 + d4);
        uint2 o; o.x = pack2(v.x, v.y); o.y = pack2(v.z, v.w);
        *(uint2*)(lds + row * KST + d4 * 2) = o;
    }
    __syncthreads();
    const int hf = lane >> 5, tl = lane & 31;
    for (int tile = bsub * 8 + w; tile < NT / 32; tile += nsub * 8) {
        const int tok = tile * 32 + tl;
        float L[2][16];
#pragma unroll
        for (int jj = 0; jj < 2; ++jj) {
            const bf16_t* qrow = QP + (size_t)tok * 2048 + head * 256 + jj * 128 + 8 * hf;
            uint4 bq[8];
#pragma unroll
            for (int ks = 0; ks < 8; ++ks) bq[ks] = *(const uint4*)(qrow + ks * 16);
            f32x16 acc[4];
#pragma unroll
            for (int kt = 0; kt < 4; ++kt)
#pragma unroll
                for (int r = 0; r < 16; ++r) acc[kt][r] = 0.f;
#pragma unroll
            for (int ks = 0; ks < 8; ++ks) {
#pragma unroll
                for (int kt = 0; kt < 4; ++kt) {
                    const bf16x8 af = *(const bf16x8*)(lds + (jj * 128 + kt * 32 + tl) * KST + (ks * 16 + 8 * hf) * 2);
                    acc[kt] = __builtin_amdgcn_mfma_f32_32x32x16_bf16(af, __builtin_bit_cast(bf16x8, bq[ks]), acc[kt], 0, 0, 0);
                }
                __builtin_amdgcn_sched_barrier(0);
            }
            float g[4][16];
#pragma unroll
            for (int kt = 0; kt < 4; ++kt) {
#pragma unroll
                for (int r = 0; r < 16; ++r) {
                    const unsigned key = (unsigned)(32 * kt + (r & 3) + 8 * (r >> 2)) + 4u * (unsigned)hf;
                    g[kt][r] = __uint_as_float((__float_as_uint(acc[kt][r]) & 0xffffff80u) | key);
                }
                sort16_desc(g[kt]);
            }
            merge16_desc(g[0], g[1]);
            merge16_desc(g[2], g[3]);
            merge16_desc(g[0], g[2]);
            float o[16];
#pragma unroll
            for (int i = 0; i < 16; ++i) o[i] = __shfl_xor(g[0][i], 32);
            merge16_desc(g[0], o);
#pragma unroll
            for (int i = 0; i < 16; ++i) L[jj][i] = g[0][i];
        }
        float R0[16], G1[16], G2[16], G3a = 0.f, G3b = 0.f;
#pragma unroll
        for (int i = 0; i < 16; ++i) R0[i] = L[0][0] + L[1][i];
        {
            int n = 0;
#pragma unroll
            for (int a2 = 1; a2 < 16; ++a2) {
#pragma unroll
                for (int b2 = 0; b2 < 16 / (a2 + 1); ++b2) {
                    const float c = L[0][a2] + L[1][b2];
                    if (n < 16) G1[n] = c; else if (n < 32) G2[n - 16] = c; else if (n == 32) G3a = c; else G3b = c;
                    ++n;
                }
            }
        }
        sort16_desc(G1);
        sort16_desc(G2);
        merge16_desc(R0, G1);
        merge16_desc(R0, G2);
#pragma unroll
        for (int i = 0; i < 16; ++i) { cswap_desc(R0[i], G3a); }
#pragma unroll
        for (int i = 0; i < 16; ++i) { cswap_desc(R0[i], G3b); }
        const float tau = R0[15];
#pragma unroll
        for (int i = 0; i < 16; ++i) { asm volatile("" : "+v"(L[0][i])); asm volatile("" : "+v"(L[1][i])); }
        unsigned* dst = (hf ? (unsigned*)GV : (unsigned*)IDX) + (size_t)tok * 128 + head * 16;
        unsigned* slab = (unsigned*)(lds + 256 * KST + w * 4096) + lane;
        int pos = 0;
#pragma unroll
        for (int a2 = 0; a2 < 16; ++a2) {
            const unsigned i0 = (__float_as_uint(L[0][a2]) & 127u) << 7;
#pragma unroll
            for (int b2 = 0; b2 < 16 / (a2 + 1); ++b2) {
                const float c = L[0][a2] + L[1][b2];
                if (c >= tau && pos < 16) {
                    const unsigned code = i0 | (__float_as_uint(L[1][b2]) & 127u);
                    slab[pos * 64] = hf ? __float_as_uint(c) : code;
                    ++pos;
                }
            }
        }
        {
            unsigned o[16];
#pragma unroll
            for (int i = 0; i < 16; ++i) o[i] = slab[i * 64];
#pragma unroll
            for (int i = 0; i < 4; ++i) *(uint4*)(dst + 4 * i) = make_uint4(o[4 * i], o[4 * i + 1], o[4 * i + 2], o[4 * i + 3]);
        }
    }
}

typedef float float2_ __attribute__((ext_vector_type(2)));
DEVI float wave_sum_u(float v) {
    v = dpp_add<0xB1>(v); v = dpp_add<0x4E>(v); v = dpp_add<0x141>(v); v = dpp_add<0x140>(v);
    int t = __builtin_amdgcn_update_dpp(0, __float_as_int(v), 0x142, 0xA, 0xF, false); v += __int_as_float(t);
    t = __builtin_amdgcn_update_dpp(0, __float_as_int(v), 0x143, 0xC, 0xF, false); v += __int_as_float(t);
    return readlane_f(v, 63);
}

constexpr float PEER_USCALE = 256.f, PEER_VSCALE = 64.f;


DEVI void convert_table_fp8_sliced(const float* src, unsigned char* dst, float scale, int wid, int nwork) {
    const size_t n16 = (size_t)16384 * 1024 / 16;
    for (size_t i = (size_t)wid; i < n16; i += (size_t)nwork) {
        const size_t e = i >> 6; const int d0 = (int)(i & 63) * 16;
        float4 v[4];
#pragma unroll
        for (int j = 0; j < 4; ++j) v[j] = *(const float4*)(src + e * 1024 + d0 + j * 4);
        unsigned o[4];
#pragma unroll
        for (int j = 0; j < 4; ++j) {
            const float x0 = fminf(fmaxf(v[j].x * scale, -448.f), 448.f), x1 = fminf(fmaxf(v[j].y * scale, -448.f), 448.f);
            const float x2 = fminf(fmaxf(v[j].z * scale, -448.f), 448.f), x3 = fminf(fmaxf(v[j].w * scale, -448.f), 448.f);
            int pk = __builtin_amdgcn_cvt_pk_fp8_f32(x0, x1, 0, false);
            pk = __builtin_amdgcn_cvt_pk_fp8_f32(x2, x3, pk, true);
            o[j] = (unsigned)pk;
        }
        *(uint4*)(dst + ((size_t)(d0 >> 7) * 16384 + e) * 128 + (d0 & 127)) = make_uint4(o[0], o[1], o[2], o[3]);
    }
}
DEVI unsigned peer_xcc_id() { return (unsigned)__builtin_amdgcn_s_getreg((3 << 11) | 20) & 0xFu; }
constexpr int PEER_CHUNK_TOK = 512;
template <class F>
DEVI void peer_claim_loop(unsigned* ctr, unsigned char* lds, F body) {
    const unsigned xcc = peer_xcc_id() & 7u;
    volatile unsigned* bc = (volatile unsigned*)(lds + LDS_BYTES - 64);
    for (unsigned s = 0; s < 8; ++s) {
        const unsigned slice = (xcc + s) & 7u;
        for (;;) {
            __syncthreads();
            if (threadIdx.x == 0) bc[0] = __hip_atomic_fetch_add(&ctr[16 * slice], 1u, __ATOMIC_RELAXED, __HIP_MEMORY_SCOPE_AGENT);
            __syncthreads();
            const unsigned c = bc[0];
            if (c >= (unsigned)(NT / PEER_CHUNK_TOK)) break;
            body((int)slice, (int)c);
        }
    }
}
#define PEER_ISSUE(BUF, IDL, IDH, base) do { _Pragma("unroll") for (int r_ = 0; r_ < 16; ++r_) { \
    const int id_ = __shfl(r_ < 8 ? (IDL) : (IDH), (8 * r_ + es) & 63); \
    BUF[r_] = *(const uint4*)((base) + (size_t)id_ * 128); } } while (0)
typedef _Float16 f16x2_t __attribute__((ext_vector_type(2)));
DEVI float dot16_fp8_f16(const uint4& u, const f16x2_t* h) {
    float d = 0.f;
    const float sc = 1.f / PEER_USCALE;
    d = __builtin_amdgcn_fdot2(__builtin_amdgcn_cvt_scalef32_pk_f16_fp8((int)u.x, sc, false), h[0], d, false);
    d = __builtin_amdgcn_fdot2(__builtin_amdgcn_cvt_scalef32_pk_f16_fp8((int)u.x, sc, true), h[1], d, false);
    d = __builtin_amdgcn_fdot2(__builtin_amdgcn_cvt_scalef32_pk_f16_fp8((int)u.y, sc, false), h[2], d, false);
    d = __builtin_amdgcn_fdot2(__builtin_amdgcn_cvt_scalef32_pk_f16_fp8((int)u.y, sc, true), h[3], d, false);
    d = __builtin_amdgcn_fdot2(__builtin_amdgcn_cvt_scalef32_pk_f16_fp8((int)u.z, sc, false), h[4], d, false);
    d = __builtin_amdgcn_fdot2(__builtin_amdgcn_cvt_scalef32_pk_f16_fp8((int)u.z, sc, true), h[5], d, false);
    d = __builtin_amdgcn_fdot2(__builtin_amdgcn_cvt_scalef32_pk_f16_fp8((int)u.w, sc, false), h[6], d, false);
    d = __builtin_amdgcn_fdot2(__builtin_amdgcn_cvt_scalef32_pk_f16_fp8((int)u.w, sc, true), h[7], d, false);
    return d;
}
DEVI f16x2_t bfpair_to_f16(unsigned w) { return __builtin_bit_cast(f16x2_t, __builtin_amdgcn_cvt_pkrtz(__uint_as_float(w << 16), __uint_as_float(w & 0xffff0000u))); }
template <int CTRL>
DEVI float dpp_get(float v) { return __int_as_float(__builtin_amdgcn_update_dpp(0, __float_as_int(v), CTRL, 0xf, 0xf, true)); }
DEVI void phase_peer_u(const bf16_t* HX2, const int* IDX, float* PART, const unsigned char* U8, unsigned* ctr, unsigned char* lds) {
    const int lane = threadIdx.x & 63, w = threadIdx.x >> 6;
    const int es = lane >> 3, part = lane & 7;
    const bool p0 = lane & 1, p1 = lane & 2, p2 = lane & 4;
    const int rbase = (p0 ? 8 : 0) + (p1 ? 4 : 0) + (p2 ? 2 : 0);
    peer_claim_loop(ctr, lds, [=](int x, int chunk) {
        constexpr int NTW = PEER_CHUNK_TOK / 8;
        const unsigned char* ub = U8 + (size_t)x * 16384 * 128;
        const unsigned loff = 16u * (unsigned)part;
        const int t0 = chunk * PEER_CHUNK_TOK + w * NTW;
        const bf16_t* hb = HX2 + 128 * x + 16 * part;
        uint4 u[16];
        int ilA, ihA, ilB, ihB; uint4 hA0, hA1, hB0, hB1;
#define PU_META(T, IL, IH, H0, H1) do { const int tk_ = t0 + ((T) < NTW ? (T) : NTW - 1); \
        IL = IDX[(size_t)tk_ * 128 + lane] & 16383; IH = IDX[(size_t)tk_ * 128 + 64 + lane] & 16383; \
        H0 = *(const uint4*)(hb + (size_t)tk_ * 1024); H1 = *(const uint4*)(hb + (size_t)tk_ * 1024 + 8); } while (0)
        PU_META(0, ilA, ihA, hA0, hA1);
#pragma unroll
        for (int r = 0; r < 16; ++r) u[r] = *(const uint4*)(ub + ((unsigned)__shfl(r < 8 ? ilA : ihA, (16 * (r >> 1) + 2 * es + (r & 1)) & 63) * 128u + loff));
        PU_META(1, ilB, ihB, hB0, hB1);
#pragma unroll 1
        for (int i = 0; i < NTW; ++i) {
            f16x2_t h[8];
            h[0] = bfpair_to_f16(hA0.x); h[1] = bfpair_to_f16(hA0.y); h[2] = bfpair_to_f16(hA0.z); h[3] = bfpair_to_f16(hA0.w);
            h[4] = bfpair_to_f16(hA1.x); h[5] = bfpair_to_f16(hA1.y); h[6] = bfpair_to_f16(hA1.z); h[7] = bfpair_to_f16(hA1.w);
            float d[16];
#pragma unroll
            for (int r = 0; r < 16; ++r) {
                d[r] = dot16_fp8_f16(u[r], h);
                const unsigned id = (unsigned)__shfl(r < 8 ? ilB : ihB, (16 * (r >> 1) + 2 * es + (r & 1)) & 63);
                u[r] = *(const uint4*)(ub + (id * 128u + loff));
                if ((r & 1) == 1) __builtin_amdgcn_sched_barrier(0);
            }
            float k8[8], k4[4], k2[2];
#pragma unroll
            for (int j = 0; j < 8; ++j) { const float snd = p0 ? d[j] : d[j + 8]; const float kp = p0 ? d[j + 8] : d[j]; k8[j] = kp + dpp_get<0xB1>(snd); }
#pragma unroll
            for (int j = 0; j < 4; ++j) { const float snd = p1 ? k8[j] : k8[j + 4]; const float kp = p1 ? k8[j + 4] : k8[j]; k4[j] = kp + dpp_get<0x4E>(snd); }
#pragma unroll
            for (int j = 0; j < 2; ++j) { const float snd = p2 ? k4[j] : k4[j + 2]; const float kp = p2 ? k4[j + 2] : k4[j]; k2[j] = kp + __shfl_xor(snd, 4); }
            *(float2*)(PART + ((size_t)(t0 + i) * 8 + x) * 128 + 8 * rbase + 2 * es) = make_float2(k2[0], k2[1]);
            ilA = ilB; ihA = ihB; hA0 = hB0; hA1 = hB1;
            PU_META(i + 2, ilB, ihB, hB0, hB1);
        }
#undef PU_META
    });
}
DEVI void phase_peer_w(const float* PART, float* GW) {
    const int lane = threadIdx.x & 63, w = threadIdx.x >> 6;
    for (int tok = blockIdx.x * 8 + w; tok < NT; tok += gridDim.x * 8) {
        float d0 = 0.f, d1 = 0.f;
#pragma unroll
        for (int x = 0; x < 8; ++x) { d0 += PART[((size_t)tok * 8 + x) * 128 + lane]; d1 += PART[((size_t)tok * 8 + x) * 128 + 64 + lane]; }
        float g0 = GW[(size_t)tok * 128 + lane], g1 = GW[(size_t)tok * 128 + 64 + lane];
        float m0 = g0, m1 = g1;
#pragma unroll
        for (int m = 1; m <= 8; m <<= 1) { m0 = fmaxf(m0, __shfl_xor(m0, m)); m1 = fmaxf(m1, __shfl_xor(m1, m)); }
        g0 = __expf(g0 - m0); g1 = __expf(g1 - m1);
        float s0 = g0, s1 = g1;
#pragma unroll
        for (int m = 1; m <= 8; m <<= 1) { s0 += __shfl_xor(s0, m); s1 += __shfl_xor(s1, m); }
        GW[(size_t)tok * 128 + lane] = gelu_(d0) * g0 / s0;
        GW[(size_t)tok * 128 + 64 + lane] = gelu_(d1) * g1 / s1;
    }
}
DEVI void axpy16_fp8_f16(f16x2_t* acc, const uint4& v, f16x2_t w2) {
    const float sc = 1.f / PEER_VSCALE;
    acc[0] = __builtin_amdgcn_cvt_scalef32_pk_f16_fp8((int)v.x, sc, false) * w2 + acc[0];
    acc[1] = __builtin_amdgcn_cvt_scalef32_pk_f16_fp8((int)v.x, sc, true) * w2 + acc[1];
    acc[2] = __builtin_amdgcn_cvt_scalef32_pk_f16_fp8((int)v.y, sc, false) * w2 + acc[2];
    acc[3] = __builtin_amdgcn_cvt_scalef32_pk_f16_fp8((int)v.y, sc, true) * w2 + acc[3];
    acc[4] = __builtin_amdgcn_cvt_scalef32_pk_f16_fp8((int)v.z, sc, false) * w2 + acc[4];
    acc[5] = __builtin_amdgcn_cvt_scalef32_pk_f16_fp8((int)v.z, sc, true) * w2 + acc[5];
    acc[6] = __builtin_amdgcn_cvt_scalef32_pk_f16_fp8((int)v.w, sc, false) * w2 + acc[6];
    acc[7] = __builtin_amdgcn_cvt_scalef32_pk_f16_fp8((int)v.w, sc, true) * w2 + acc[7];
}
DEVI f16x2_t shfl_xor_h2(f16x2_t v, int m) { return __builtin_bit_cast(f16x2_t, __shfl_xor(__builtin_bit_cast(int, v), m)); }
DEVI void phase_peer_v(const int* IDX, const float* GW, bf16_t* PE, const unsigned char* V8, unsigned* ctr, unsigned char* lds) {
    const int lane = threadIdx.x & 63, w = threadIdx.x >> 6;
    const int es = lane >> 3, part = lane & 7;
    const bool b3 = lane & 8, b4 = lane & 16, b5 = lane & 32;
    const int o = (b3 ? 8 : 0) + (b4 ? 4 : 0) + (b5 ? 2 : 0);
    peer_claim_loop(ctr, lds, [=](int x, int chunk) {
        constexpr int NTW = PEER_CHUNK_TOK / 8;
        const unsigned char* vb = V8 + (size_t)x * 16384 * 128;
        const unsigned loff = 16u * (unsigned)part;
        const int t0 = chunk * PEER_CHUNK_TOK + w * NTW;
        uint4 v[8];
        int il, ih, iln; float wl, wh;
        il = IDX[(size_t)t0 * 128 + lane] & 16383; ih = IDX[(size_t)t0 * 128 + 64 + lane] & 16383;
        wl = GW[(size_t)t0 * 128 + lane]; wh = GW[(size_t)t0 * 128 + 64 + lane];
#pragma unroll
        for (int r = 0; r < 8; ++r) v[r] = *(const uint4*)(vb + ((unsigned)__shfl(il, 8 * r + es) * 128u + loff));
#pragma unroll 1
        for (int i = 0; i < NTW; ++i) {
            const int tn = t0 + (i + 1 < NTW ? i + 1 : i);
            iln = IDX[(size_t)tn * 128 + lane] & 16383;
            f16x2_t acc[8];
#pragma unroll
            for (int j = 0; j < 8; ++j) acc[j] = (f16x2_t){(_Float16)0.f, (_Float16)0.f};
#pragma unroll
            for (int r = 0; r < 8; ++r) {
                const float wr = __shfl(wl, 8 * r + es);
                axpy16_fp8_f16(acc, v[r], __builtin_bit_cast(f16x2_t, __builtin_amdgcn_cvt_pkrtz(wr, wr)));
                v[r] = *(const uint4*)(vb + ((unsigned)__shfl(ih, 8 * r + es) * 128u + loff));
            }
            const float wh_c = wh;
            const int ihn = IDX[(size_t)tn * 128 + 64 + lane] & 16383;
            wl = GW[(size_t)tn * 128 + lane]; wh = GW[(size_t)tn * 128 + 64 + lane];
#pragma unroll
            for (int r = 0; r < 8; ++r) {
                const float wr = __shfl(wh_c, 8 * r + es);
                axpy16_fp8_f16(acc, v[r], __builtin_bit_cast(f16x2_t, __builtin_amdgcn_cvt_pkrtz(wr, wr)));
                v[r] = *(const uint4*)(vb + ((unsigned)__shfl(iln, 8 * r + es) * 128u + loff));
            }
            il = iln; ih = ihn;
            f16x2_t k4[4], k2[2], k1;
#pragma unroll
            for (int j = 0; j < 4; ++j) { const f16x2_t snd = b3 ? acc[j] : acc[j + 4]; const f16x2_t kp = b3 ? acc[j + 4] : acc[j]; k4[j] = kp + shfl_xor_h2(snd, 8); }
#pragma unroll
            for (int j = 0; j < 2; ++j) { const f16x2_t snd = b4 ? k4[j] : k4[j + 2]; const f16x2_t kp = b4 ? k4[j + 2] : k4[j]; k2[j] = kp + shfl_xor_h2(snd, 16); }
            { const f16x2_t snd = b5 ? k2[0] : k2[1]; const f16x2_t kp = b5 ? k2[1] : k2[0]; k1 = kp + shfl_xor_h2(snd, 32); }
            *(unsigned*)(PE + (size_t)(t0 + i) * 1024 + 128 * x + 16 * part + o) = pack2((float)k1.x, (float)k1.y);
        }
    });
}
DEVI float4 bf4_to_f4(const uint2& t) { return make_float4(__uint_as_float(t.x << 16), __uint_as_float(t.x & 0xffff0000u), __uint_as_float(t.y << 16), __uint_as_float(t.y & 0xffff0000u)); }
DEVI void phase_peer_final(const Params& p, const bf16_t* X1b, const bf16_t* PE, const float* MOD, float* OUT) {
    const int lane = threadIdx.x & 63, w = threadIdx.x >> 6;
    const float* nw = p.in[9];
    for (int run = blockIdx.x * 8 + w; run < NT / 16; run += gridDim.x * 8) {
        const int row0 = run * 16;
        const float* gate2 = MOD + (size_t)(row0 / TL) * 6144 + 5 * 1024;
        float4 c[4];
#pragma unroll
        for (int i = 0; i < 4; ++i) {
            const int d = lane * 4 + 256 * i;
            const float4 g = *(const float4*)(gate2 + d), nwv = *(const float4*)(nw + d);
            c[i] = make_float4(g.x * nwv.x, g.y * nwv.y, g.z * nwv.z, g.w * nwv.w);
        }
        uint2 na[4], nx[4];
#pragma unroll
        for (int i = 0; i < 4; ++i) {
            na[i] = *(const uint2*)(PE + (size_t)row0 * 1024 + lane * 4 + 256 * i);
            nx[i] = *(const uint2*)(X1b + (size_t)row0 * 1024 + lane * 4 + 256 * i);
        }
#pragma unroll 1
        for (int rr = 0; rr < 16; ++rr) {
            const int tok = row0 + rr;
            float4 a[4], x1[4]; float ss = 0.f;
#pragma unroll
            for (int i = 0; i < 4; ++i) {
                a[i] = bf4_to_f4(na[i]); x1[i] = bf4_to_f4(nx[i]);
                ss += a[i].x * a[i].x + a[i].y * a[i].y + a[i].z * a[i].z + a[i].w * a[i].w;
            }
            if (rr + 1 < 16) {
#pragma unroll
                for (int i = 0; i < 4; ++i) {
                    na[i] = *(const uint2*)(PE + (size_t)(tok + 1) * 1024 + lane * 4 + 256 * i);
                    nx[i] = *(const uint2*)(X1b + (size_t)(tok + 1) * 1024 + lane * 4 + 256 * i);
                }
            }
            ss = wave_sum_u(ss);
            const float r = rsqrtf(ss * (1.f / 1024.f) + 1e-6f);
#pragma unroll
            for (int i = 0; i < 4; ++i) {
                const int d = lane * 4 + 256 * i;
                float4 o;
                o.x = x1[i].x + c[i].x * a[i].x * r; o.y = x1[i].y + c[i].y * a[i].y * r;
                o.z = x1[i].z + c[i].z * a[i].z * r; o.w = x1[i].w + c[i].w * a[i].w * r;
                *(float4*)(OUT + (size_t)tok * 1024 + d) = o;
            }
        }
    }
}

template <bool NORM>
DEVI void conv_wave(const bf16_t* src, int ld_src, int tok0, bool lo_ok, bool hi_ok, int scol,
                    bf16_t* dst, int ld_dst, int dcol, const float* cw, int wch, float oscale) {
    const int lane = threadIdx.x & 63;
    unsigned x[68];
    const bf16_t* sp = src + (size_t)tok0 * ld_src + scol + 2 * lane;
#pragma unroll
    for (int t = 0; t < 64; ++t) x[t + 2] = *(const unsigned*)(sp + (size_t)t * ld_src);
    x[0] = lo_ok ? *(const unsigned*)(sp - 2 * (size_t)ld_src) : 0u;
    x[1] = lo_ok ? *(const unsigned*)(sp - (size_t)ld_src) : 0u;
    x[66] = hi_ok ? *(const unsigned*)(sp + 64 * (size_t)ld_src) : 0u;
    x[67] = hi_ok ? *(const unsigned*)(sp + 65 * (size_t)ld_src) : 0u;
    float w0[5], w1[5];
#pragma unroll
    for (int j = 0; j < 5; ++j) { w0[j] = cw[j * 3072 + wch + 2 * lane]; w1[j] = cw[j * 3072 + wch + 2 * lane + 1]; }
    bf16_t* dp = dst + (size_t)tok0 * ld_dst + dcol + 2 * lane;
#pragma unroll
    for (int t = 0; t < 64; ++t) {
        float a0 = 0.f, a1 = 0.f;
#pragma unroll
        for (int j = 0; j < 5; ++j) {
            a0 += w0[j] * __uint_as_float(x[t + j] << 16);
            a1 += w1[j] * __uint_as_float(x[t + j] & 0xffff0000u);
        }
        a0 = silu_(a0); a1 = silu_(a1);
        float sc = oscale;
        if (NORM) sc = rsqrtf(wave_sum_u(a0 * a0 + a1 * a1) + 1e-6f) * oscale;
        *(unsigned*)(dp + (size_t)t * ld_dst) = pack2(a0 * sc, a1 * sc);
    }
}

namespace pg8 {
#define PG8_LAS __attribute__((address_space(3)))
typedef unsigned short bf16_t;
typedef short bf16x8 __attribute__((ext_vector_type(8)));
typedef float f32x4 __attribute__((ext_vector_type(4)));
typedef unsigned u32x4 __attribute__((ext_vector_type(4)));
constexpr int BM = 256, BK = 64, HALF = 128, HTB = HALF * BK * 2  , STAGE_BYTES = 8 * HTB, NXCD = 8, WGM = 8;

__host__ __device__ __forceinline__ int lds_byte(int r, int c) { const int st = (r >> 4) * 2 + (c >> 5), rr = r & 15, cc = c & 31, ob = rr * 64 + cc * 2; return st * 1024 + (ob ^ (((ob >> 9) & 1) << 5)); }
__host__ __device__ __forceinline__ void stage_rc(int b, int& R, int& C) { const int st = b / 1024, sb = b % 1024, swz = sb ^ (((sb >> 9) & 1) << 5); R = (st >> 1) * 16 + swz / 64; C = (st & 1) * 32 + (swz % 64) / 2; }
__host__ __device__ __forceinline__ int perm32(int rho) { const int n = rho >> 4, i = rho & 15; return 8 * (i >> 2) + 4 * n + (i & 3); }

struct Unit { int pm, pn; };
struct Gemm { const bf16_t* A; const bf16_t* Bt; int M, N, K; };

struct StaticOrder {
    int nM, nN, nwg, G, c;
    __host__ __device__ void init(int M, int N, int G_, int c_) { nM = M / BM; nN = N / BM; nwg = nM * nN; G = G_; c = c_; }
    __host__ __device__ bool next(int i, Unit& u) const {
        const long L = (long)i * G + c; if (L >= nwg) return false;
        int wgid = (int)L; { const int q = nwg / NXCD, r = nwg % NXCD, xcd = wgid % NXCD, off = wgid / NXCD; wgid = (xcd < r ? xcd * (q + 1) : r * (q + 1) + (xcd - r) * q) + off; }
        const int nig = WGM * nN, gid = wgid / nig, fm = gid * WGM, gsz = (nM - fm) < WGM ? (nM - fm) : WGM;
        u.pm = fm + ((wgid % nig) % gsz); u.pn = (wgid % nig) / gsz; return true;
    }
    __device__ __forceinline__ void a_ready(const Unit&) const {}
    __device__ __forceinline__ void done(const Unit&) const {}
};
__device__ __forceinline__ unsigned cvt_pk_bf16(float lo, float hi) { unsigned r; asm volatile("v_cvt_pk_bf16_f32 %0, %1, %2" : "=v"(r) : "v"(lo), "v"(hi)); return r; }
template <class Epi, class Sched, bool ALIGN_EPI = false, bool SP2 = false>
__device__ __forceinline__ void gemm_phase(PG8_LAS unsigned char* lds, const Gemm g, const Sched& S, const Epi& E) {
    const int tid = threadIdx.x, wid = __builtin_amdgcn_readfirstlane(tid >> 6), lane = tid & 63, wr = wid >> 2, wc = wid & 3, fr = lane & 15, fq = lane >> 4;
    const int K = g.K, nt = K / BK;
    unsigned voffA[2], voffB[2];
#pragma unroll
    for (int i = 0; i < 2; ++i) { int R, C; stage_rc(tid * 16 + i * 8192, R, C); const int Rb = Epi::PERM ? ((R & ~31) + perm32(R & 31)) : R;
        voffA[i] = (unsigned)(R * K + C) * 2u; voffB[i] = (unsigned)(Rb * K + C) * 2u; }
    const size_t kstep = (size_t)(BK * 2);
    const size_t hstep = (size_t)HALF * K * 2;
    const size_t tstep = 2 * hstep;
    const unsigned ldsw = (unsigned)wid * 1024u;
    const int aoff = lds_byte(wr * 64 + fr, fq * 8), boff = lds_byte(wc * 32 + fr, fq * 8);
#define PG8_SA(b, h) (((b) * 2 + (h)) * HTB)
#define PG8_SB(b, h) ((4 + (b) * 2 + (h)) * HTB)
#define PG8_STAGE(bufoff, gbase, voff) do { _Pragma("unroll") for (int _i = 0; _i < 2; ++_i) \
        __builtin_amdgcn_global_load_lds((const unsigned*)((const char*)(gbase) + (voff)[_i]), (PG8_LAS unsigned*)(lds + (bufoff) + ldsw + _i * 8192), 16, 0, 0); } while (0)
#define PG8_LDA(dst, b, h) do { _Pragma("unroll") for (int m = 0; m < 4; ++m) _Pragma("unroll") for (int k = 0; k < 2; ++k) dst[m][k] = *(const PG8_LAS bf16x8*)(lds + PG8_SA(b, h) + aoff + m * 2048 + k * 1024); } while (0)
#define PG8_LDB(dst, b, h) do { _Pragma("unroll") for (int n = 0; n < 2; ++n) _Pragma("unroll") for (int k = 0; k < 2; ++k) dst[n][k] = *(const PG8_LAS bf16x8*)(lds + PG8_SB(b, h) + boff + n * 2048 + k * 1024); } while (0)
#define PG8_MMA(ai, bj, At, Bt) do { __builtin_amdgcn_s_setprio(1); _Pragma("unroll") for (int m = 0; m < 4; ++m) _Pragma("unroll") for (int n = 0; n < 2; ++n) _Pragma("unroll") for (int k = 0; k < 2; ++k) \
        acc[ai][bj][m][n] = __builtin_amdgcn_mfma_f32_16x16x32_bf16(Bt[n][k], At[m][k], acc[ai][bj][m][n], 0, 0, 0); __builtin_amdgcn_s_setprio(0); } while (0)
#define PG8_WAIT_V(n) asm volatile("s_waitcnt vmcnt(" #n ")" ::: "memory")
#define PG8_WAIT_L(n) asm volatile("s_waitcnt lgkmcnt(" #n ")" ::: "memory")
#define PG8_BAR __builtin_amdgcn_s_barrier()
#define PG8_SCHED __builtin_amdgcn_sched_barrier(0)
    Unit cur, nxt; int ui = 0;
    if (!S.next(0, cur)) return;
    f32x4 acc[2][2][4][2];
#pragma unroll
    for (int a = 0; a < 2; ++a)
#pragma unroll
        for (int b = 0; b < 2; ++b)
#pragma unroll
            for (int m = 0; m < 4; ++m)
#pragma unroll
                for (int n = 0; n < 2; ++n) acc[a][b][m][n] = (f32x4){0.f, 0.f, 0.f, 0.f};
    bf16x8 At[4][2], B0[2][2], B1[2][2];
    const char* cA = (const char*)g.A + (size_t)cur.pm * tstep; const char* cB = (const char*)g.Bt + (size_t)cur.pn * tstep;
    S.a_ready(cur);
    if constexpr (SP2) {
        PG8_STAGE(PG8_SB(0, 0), cB, voffB); PG8_STAGE(PG8_SB(0, 1), cB + hstep, voffB); PG8_STAGE(PG8_SA(0, 0), cA, voffA); PG8_STAGE(PG8_SA(0, 1), cA + hstep, voffA);
        if (wr == 1) PG8_BAR;
        PG8_WAIT_V(2); PG8_BAR;
        PG8_STAGE(PG8_SB(1, 0), cB + kstep, voffB); PG8_STAGE(PG8_SA(1, 0), cA + kstep, voffA); PG8_STAGE(PG8_SB(1, 1), cB + hstep + kstep, voffB);
        PG8_WAIT_V(6); PG8_BAR;
    } else {
        PG8_STAGE(PG8_SB(0, 0), cB, voffB); PG8_STAGE(PG8_SA(0, 0), cA, voffA); PG8_STAGE(PG8_SB(0, 1), cB + hstep, voffB); PG8_STAGE(PG8_SA(0, 1), cA + hstep, voffA);
        if (wr == 1) PG8_BAR;
        PG8_WAIT_V(4); PG8_BAR;
        PG8_STAGE(PG8_SB(1, 0), cB + kstep, voffB); PG8_STAGE(PG8_SA(1, 0), cA + kstep, voffA); PG8_STAGE(PG8_SB(1, 1), cB + hstep + kstep, voffB);
        PG8_WAIT_V(6); PG8_BAR;
    }
    for (;;) {
        const bool has_next = S.next(ui + 1, nxt);
        const char* nA = has_next ? (const char*)g.A + (size_t)nxt.pm * tstep : cA; const char* nB = has_next ? (const char*)g.Bt + (size_t)nxt.pn * tstep : cB;
        for (int t = 0; t < nt; t += 2) {
            const bool last = (t == nt - 2);
            const char* a1 = cA + (size_t)(t + 1) * kstep;
            const char* a2 = last ? nA : cA + (size_t)(t + 2) * kstep; const char* b2 = last ? nB : cB + (size_t)(t + 2) * kstep;
            const char* a3 = a2 + kstep; const char* b3 = b2 + kstep;
            if (last && has_next) S.a_ready(nxt);
            if constexpr (SP2) {
            PG8_LDB(B0, 0, 0); PG8_LDB(B1, 0, 1); PG8_SCHED; PG8_LDA(At, 0, 0); PG8_STAGE(PG8_SA(1, 1), a1 + hstep, voffA);
            PG8_WAIT_V(8); PG8_WAIT_L(0); PG8_BAR; PG8_MMA(0, 0, At, B0); PG8_MMA(0, 1, At, B1); PG8_BAR; PG8_SCHED;
            PG8_LDA(At, 0, 1); PG8_STAGE(PG8_SB(0, 0), b2, voffB); PG8_STAGE(PG8_SB(0, 1), b2 + hstep, voffB); PG8_STAGE(PG8_SA(0, 0), a2, voffA);
            PG8_WAIT_V(8); PG8_WAIT_L(0); PG8_BAR; PG8_MMA(1, 0, At, B0); PG8_MMA(1, 1, At, B1); PG8_BAR; PG8_SCHED;
            PG8_LDB(B0, 1, 0); PG8_LDB(B1, 1, 1); PG8_SCHED; PG8_LDA(At, 1, 0); PG8_STAGE(PG8_SA(0, 1), a2 + hstep, voffA);
            PG8_WAIT_V(8); PG8_WAIT_L(0); PG8_BAR; PG8_MMA(0, 0, At, B0); PG8_MMA(0, 1, At, B1); PG8_BAR; PG8_SCHED;
            PG8_LDA(At, 1, 1); PG8_STAGE(PG8_SB(1, 0), b3, voffB); PG8_STAGE(PG8_SB(1, 1), b3 + hstep, voffB); PG8_STAGE(PG8_SA(1, 0), a3, voffA);
            PG8_WAIT_V(8); PG8_WAIT_L(0); PG8_BAR; PG8_MMA(1, 0, At, B0); PG8_MMA(1, 1, At, B1); PG8_BAR; PG8_SCHED;
            } else {
            PG8_LDB(B0, 0, 0); PG8_SCHED; PG8_LDA(At, 0, 0); PG8_STAGE(PG8_SA(1, 1), a1 + hstep, voffA);
            PG8_WAIT_L(8); PG8_BAR; PG8_WAIT_L(0); PG8_MMA(0, 0, At, B0); PG8_BAR; PG8_SCHED;
            PG8_LDB(B1, 0, 1); PG8_STAGE(PG8_SB(0, 0), b2, voffB);
            PG8_BAR; PG8_WAIT_L(0); PG8_MMA(0, 1, At, B1); PG8_BAR;
            PG8_LDA(At, 0, 1); PG8_STAGE(PG8_SA(0, 0), a2, voffA);
            PG8_BAR; PG8_WAIT_L(0); PG8_MMA(1, 0, At, B0); PG8_BAR; PG8_SCHED;
            PG8_STAGE(PG8_SB(0, 1), b2 + hstep, voffB);
            PG8_WAIT_V(6); PG8_BAR; PG8_MMA(1, 1, At, B1); PG8_BAR;
            PG8_LDB(B0, 1, 0); PG8_SCHED; PG8_LDA(At, 1, 0); PG8_STAGE(PG8_SA(0, 1), a2 + hstep, voffA);
            PG8_WAIT_L(8); PG8_BAR; PG8_WAIT_L(0); PG8_MMA(0, 0, At, B0); PG8_BAR; PG8_SCHED;
            PG8_LDB(B1, 1, 1); PG8_STAGE(PG8_SB(1, 0), b3, voffB);
            PG8_BAR; PG8_WAIT_L(0); PG8_MMA(0, 1, At, B1); PG8_BAR;
            PG8_LDA(At, 1, 1); PG8_STAGE(PG8_SA(1, 0), a3, voffA);
            PG8_BAR; PG8_WAIT_L(0); PG8_MMA(1, 0, At, B0); PG8_BAR; PG8_SCHED;
            PG8_STAGE(PG8_SB(1, 1), b3 + hstep, voffB);
            PG8_WAIT_V(6); PG8_BAR; PG8_MMA(1, 1, At, B1); PG8_BAR;
            }
        }
        if constexpr (ALIGN_EPI) { if (wr == 0) PG8_BAR; }
        if constexpr (!Epi::AFTER_DRAIN) { E(acc, cur, wr, wc, fr, fq); S.done(cur); }
        if (!has_next) break;
#pragma unroll
        for (int a = 0; a < 2; ++a)
#pragma unroll
            for (int b = 0; b < 2; ++b)
#pragma unroll
                for (int m = 0; m < 4; ++m)
#pragma unroll
                    for (int n = 0; n < 2; ++n) acc[a][b][m][n] = (f32x4){0.f, 0.f, 0.f, 0.f};
        cur = nxt; cA = nA; cB = nB; ++ui;
        if constexpr (ALIGN_EPI) { if (wr == 1) PG8_BAR; }
    }
    PG8_WAIT_V(0);
    if constexpr (!ALIGN_EPI) { if (wr == 0) PG8_BAR; }
    PG8_BAR;
    if constexpr (Epi::AFTER_DRAIN) { E.fused(acc, cur, wr, wc, fr, fq, lds, wid, lane); S.done(cur); }
#undef PG8_SA
#undef PG8_SB
#undef PG8_STAGE
#undef PG8_LDA
#undef PG8_LDB
#undef PG8_MMA
#undef PG8_WAIT_V
#undef PG8_WAIT_L
#undef PG8_BAR
#undef PG8_SCHED
}
__device__ __forceinline__ void unpack8(const u32x4& w, float* f) {
    f[0] = __uint_as_float(w.x << 16); f[1] = __uint_as_float(w.x & 0xffff0000u); f[2] = __uint_as_float(w.y << 16); f[3] = __uint_as_float(w.y & 0xffff0000u);
    f[4] = __uint_as_float(w.z << 16); f[5] = __uint_as_float(w.z & 0xffff0000u); f[6] = __uint_as_float(w.w << 16); f[7] = __uint_as_float(w.w & 0xffff0000u);
}
__device__ __forceinline__ float sigm(float x) { return 1.f / (1.f + __expf(-x)); }
struct EpiStore16 {
    static constexpr bool PERM = true, AFTER_DRAIN = false;
    bf16_t* O; int ldc;
    __device__ __forceinline__ void operator()(const f32x4 (&acc)[2][2][4][2], const Unit& u, int wr, int wc, int fr, int fq) const {
        const int row0 = u.pm * BM + wr * 64 + fr, col0 = u.pn * BM + wc * 32 + 8 * fq;
#pragma unroll
        for (int ai = 0; ai < 2; ++ai)
#pragma unroll
            for (int m = 0; m < 4; ++m) { bf16_t* rowp = O + (size_t)(row0 + ai * HALF + m * 16) * ldc + col0;
#pragma unroll
                for (int bj = 0; bj < 2; ++bj) { const f32x4 v0 = acc[ai][bj][m][0], v1 = acc[ai][bj][m][1];
                    u32x4 w; w.x = cvt_pk_bf16(v0[0], v0[1]); w.y = cvt_pk_bf16(v0[2], v0[3]); w.z = cvt_pk_bf16(v1[0], v1[1]); w.w = cvt_pk_bf16(v1[2], v1[3]);
                    *(u32x4*)(rowp + bj * HALF) = w; } }
    }
};
template <int MODE> struct EpiGate {
    static constexpr bool PERM = true, AFTER_DRAIN = false;
    bf16_t* O; int ldc; const bf16_t* G; int ldg; int goff; const float* bias;
    __device__ __forceinline__ void operator()(const f32x4 (&acc)[2][2][4][2], const Unit& u, int wr, int wc, int fr, int fq) const {
        const int row0 = u.pm * BM + wr * 64 + fr, col0 = u.pn * BM + wc * 32 + 8 * fq;
#pragma unroll
        for (int ai = 0; ai < 2; ++ai)
#pragma unroll
            for (int m = 0; m < 4; ++m) { const size_t row = (size_t)(row0 + ai * HALF + m * 16);
#pragma unroll
                for (int bj = 0; bj < 2; ++bj) { const int col = col0 + bj * HALF; const f32x4 v0 = acc[ai][bj][m][0], v1 = acc[ai][bj][m][1];
                    float a[8] = {v0[0], v0[1], v0[2], v0[3], v1[0], v1[1], v1[2], v1[3]}; float g[8], o[8];
                    unpack8(*(const u32x4*)(G + row * ldg + goff + col), g);
                    if (MODE == 0) {
                        const f32x4 b0 = *(const f32x4*)(bias + col), b1 = *(const f32x4*)(bias + col + 4);
                        const float bb[8] = {b0[0], b0[1], b0[2], b0[3], b1[0], b1[1], b1[2], b1[3]};
#pragma unroll
                        for (int j = 0; j < 8; ++j) o[j] = g[j] * sigm(a[j] + bb[j]);
                    } else if (MODE == 1) {
#pragma unroll
                        for (int j = 0; j < 8; ++j) o[j] = sigm(g[j]) * a[j];
                    } else {
                        float pv[8]; unpack8(*(const u32x4*)(O + row * ldc + col), pv);
#pragma unroll
                        for (int j = 0; j < 8; ++j) o[j] = pv[j] + sigm(g[j]) * a[j];
                    }
                    u32x4 w; w.x = cvt_pk_bf16(o[0], o[1]); w.y = cvt_pk_bf16(o[2], o[3]); w.z = cvt_pk_bf16(o[4], o[5]); w.w = cvt_pk_bf16(o[6], o[7]);
                    *(u32x4*)(O + row * ldc + col) = w; }
                asm volatile("" ::: "memory"); }
    }
};
struct EpiStoreF32 {
    static constexpr bool PERM = false, AFTER_DRAIN = false;
    float* C; int ldc;
    __device__ __forceinline__ void operator()(const f32x4 (&acc)[2][2][4][2], const Unit& u, int wr, int wc, int fr, int fq) const {
        const int row0 = u.pm * BM + wr * 64 + fr, col0 = u.pn * BM + wc * 32 + 4 * fq;
#pragma unroll
        for (int ai = 0; ai < 2; ++ai)
#pragma unroll
            for (int m = 0; m < 4; ++m) { float* rowp = C + (size_t)(row0 + ai * HALF + m * 16) * ldc + col0;
#pragma unroll
                for (int bj = 0; bj < 2; ++bj)
#pragma unroll
                    for (int n = 0; n < 2; ++n) *(f32x4*)(rowp + bj * HALF + n * 16) = acc[ai][bj][m][n]; }
    }
};
}

#define XB_TMO      128
#define XB_XCNT(j)  (256  + 64 * (j))
#define XB_XSUB(j)  (1280 + 64 * (j))
#define XB_XGEN(j)  (2304 + 64 * (j))
#define XB_TOP      3328
#define XB_TOPGEN   3392
#define XCD_BAR_WORDS 3456
#define XB_SPIN_CAP (1u << 22)
#define LAS __attribute__((address_space(3)))
DEVI unsigned xb_ld(unsigned* p)              { return __hip_atomic_load(p, __ATOMIC_RELAXED, __HIP_MEMORY_SCOPE_AGENT); }
DEVI unsigned xb_add(unsigned* p, unsigned v) { return __hip_atomic_fetch_add(p, v, __ATOMIC_RELAXED, __HIP_MEMORY_SCOPE_AGENT); }
DEVI unsigned xb_xcc_id() { return (unsigned)__builtin_amdgcn_s_getreg((3 << 11) | 20) & 0xFu; }
#define XB_SPIN(cond, bar) do { unsigned _sp = 0; while (cond) { __builtin_amdgcn_s_sleep(1); \
    if ((++_sp & 255u) == 0u) { if (xb_ld(&(bar)[XB_TMO])) break; if (_sp > XB_SPIN_CAP) { atomicAdd(&(bar)[XB_TMO], 1u); break; } } } } while (0)
struct XcdBarrier { unsigned* bar; unsigned x; volatile LAS unsigned* st; };
DEVI XcdBarrier xcd_barrier_post(unsigned* bar, volatile LAS unsigned* st) {
    XcdBarrier b; b.bar = bar; b.x = xb_xcc_id(); b.st = st;
    if (threadIdx.x == 0) (void)xb_add(&bar[XB_XCNT(b.x)], 1u);
    return b;
}
DEVI void xcd_barrier_complete(unsigned* bar, unsigned x, unsigned& nloc, unsigned& nx) {
    const unsigned G = gridDim.x * gridDim.y * gridDim.z;
    unsigned sum, cnt, mine, sp = 0u;
    for (;;) {
        sum = 0u; cnt = 0u; mine = 0u;
#pragma unroll
        for (unsigned j = 0; j < 16; ++j) { const unsigned c = xb_ld(&bar[XB_XCNT(j)]); sum += c; cnt += (c > 0u) ? 1u : 0u; mine = (j == x) ? c : mine; }
        if (sum == G) break;
        __builtin_amdgcn_s_sleep(1);
        if ((++sp & 255u) == 0u) { if (xb_ld(&bar[XB_TMO])) break; if (sp > XB_SPIN_CAP) { atomicAdd(&bar[XB_TMO], 1u); break; } }
    }
    nloc = mine > 0u ? mine : 1u; nx = cnt > 0u ? cnt : 1u;
}
DEVI void xcd_barrier(const XcdBarrier& b) {
    asm volatile("s_waitcnt vmcnt(0)" ::: "memory");
    __syncthreads();
    if (threadIdx.x == 0) {
        unsigned* bar = b.bar;
        __builtin_amdgcn_s_waitcnt(0);
        unsigned nloc = b.st[0], nx = b.st[1];
        if (nloc == 0u) { xcd_barrier_complete(bar, b.x, nloc, nx); b.st[0] = nloc; b.st[1] = nx; }
        const unsigned old = xb_add(&bar[XB_XSUB(b.x)], 1u);
        const unsigned gen = old / nloc;
        if (old + 1u == (gen + 1u) * nloc) {
            __builtin_amdgcn_fence(__ATOMIC_RELEASE, "agent");
            asm volatile("s_waitcnt vmcnt(0)" ::: "memory");
            const unsigned og = xb_add(&bar[XB_TOP], 1u);
            const unsigned tg = og / nx;
            if (og + 1u == (tg + 1u) * nx) xb_add(&bar[XB_TOPGEN], 1u);
            else XB_SPIN(xb_ld(&bar[XB_TOPGEN]) == tg, bar);
            __builtin_amdgcn_fence(__ATOMIC_ACQUIRE, "agent");
            xb_add(&bar[XB_XGEN(b.x)], 1u);
            asm volatile("s_waitcnt vmcnt(0)" ::: "memory");
        } else {
            XB_SPIN(xb_ld(&bar[XB_XGEN(b.x)]) == gen, bar);
            __builtin_amdgcn_fence(__ATOMIC_ACQUIRE, "agent");
            asm volatile("s_waitcnt vmcnt(0)" ::: "memory");
        }
    }
    __syncthreads();
}

__global__ void __launch_bounds__(NTHREADS) mega(Params p) {
    extern __shared__ __attribute__((aligned(16))) unsigned char lds[];
    unsigned char* ws = p.ws;
    {
        volatile LAS unsigned* stw = (volatile LAS unsigned*)(lds + LDS_BYTES - 16);
        if (threadIdx.x < 4) stw[threadIdx.x] = 0u;
    }
    __syncthreads();
    XcdBarrier gbar = xcd_barrier_post((unsigned*)(ws + OFF_BAR), (volatile LAS unsigned*)(lds + LDS_BYTES - 16));
    const int tid = threadIdx.x, lane = tid & 63, w = tid >> 6;
    const int nb = gridDim.x, bid = blockIdx.x;
#define MOD ((float*)(p.ws + OFF_MOD))
#define HX ((bf16_t*)((unsigned char*)p.out + DO_HX))
#define HC ((bf16_t*)((unsigned char*)p.out + DO_HC))
#define PROJ1 ((bf16_t*)(p.ws + OFF_PROJ1))
#define PROJC ((bf16_t*)(p.ws + OFF_PROJC))
#define CKV ((bf16_t*)(p.ws + OFF_CKV))
#define AB ((float*)(p.ws + OFF_AB))
#define ABC ((float*)(p.ws + OFF_ABC))
#define S5ST ((float*)(p.ws + OFF_S5ST))
#define DNST ((float*)(p.ws + OFF_DNST))
#define YF ((bf16_t*)(p.ws + OFF_YF))
#define YB ((bf16_t*)(p.ws + OFF_YB))
#define OF ((bf16_t*)(p.ws + OFF_OF))
#define OB ((bf16_t*)(p.ws + OFF_OB))
#define WIN1 ((const bf16_t*)(p.ws + OFF_WIN1))
#define WIN2 ((const bf16_t*)(p.ws + OFF_WIN2))
#ifndef PROBE_PHASE
#define PROBE_PHASE -1
#endif
#define NREP(k) ((k) == PROBE_PHASE ? 2 : 1)
#define IN(k) (p.ph_lo <= (k) && (k) < p.ph_hi)
#define SEAM(k) do { if (rep_ + 1 == NREP(k) && (k) + 1 < p.ph_hi) xcd_barrier(gbar); } while (0)

    if (IN(0)) for (int rep_ = 0; rep_ < NREP(0); ++rep_) {
        phase_adaln(p, MOD, lds);
        __syncthreads();
        phase_weights(p, lds);
        SEAM(0);
    }
    if (IN(1)) for (int rep_ = 0; rep_ < NREP(1); ++rep_) {
        modulate_rows<16>(p.in[0], NT, TL, p.in[6], MOD, MOD + 1024, 6144, HX);
        modulate_rows<2>(p.in[2], NC, TCX, p.in[6], MOD + 16 * 6144, MOD + 16 * 6144 + 1024, 0, HC);
        SEAM(1);
    }
    if (IN(2)) for (int rep_ = 0; rep_ < NREP(2); ++rep_) {
        {
            pg8::Gemm g{HX, WIN1, NT, 3584, 1024}; pg8::StaticOrder S; S.init(NT, 3584, nb, bid); pg8::EpiStore16 E{PROJ1, LD1};
            pg8::gemm_phase<pg8::EpiStore16, pg8::StaticOrder, true, true>((PG8_LAS unsigned char*)lds, g, S, E);
        }
        const int nctxb = nb >= 256 ? 160 : nb;
        if (bid < nctxb) {
            pg8::Gemm g{HC, WIN1, NC, 2560, 1024}; pg8::StaticOrder S; S.init(NC, 2560, nctxb, bid); pg8::EpiStore16 E{PROJC, LDC};
            pg8::gemm_phase<pg8::EpiStore16, pg8::StaticOrder, true, true>((PG8_LAS unsigned char*)lds, g, S, E);
        }
        __syncthreads();
        {
            const int nab = nb - nctxb;
            const int t0 = nab > 0 ? (bid >= nctxb ? bid - nctxb : 256 + 32) : bid;
            const int stride = nab > 0 ? nab : nb;
            for (int t = t0; t < 256 + 32; t += stride) {
                if (t < 256) gemm_tile(HX, 1024, WIN1, 1024, 1024, t * 128, 3584, lds, [=](int row, int col, float v) { if (col < 3584 + 32) AB[(size_t)row * 32 + (col - 3584)] = v; });
                else gemm_tile(HC, 1024, WIN1, 1024, 1024, (t - 256) * 128, 3584, lds, [=](int row, int col, float v) { if (col < 3584 + 32) ABC[(size_t)row * 32 + (col - 3584)] = v; });
            }
        }
        SEAM(2);
    }
    if (IN(3)) for (int rep_ = 0; rep_ < NREP(3); ++rep_) {
        if (w < 2) {
            for (int u = w * nb + bid; u < 512; u += nb * 2) {
                const int dir = u & 1, g = (u >> 1) & 31, bp = u >> 6;
                s5_mfma<false>(p, PROJC, LDC, TCX, bp, g, dir, nullptr, S5ST, nullptr, lds + w * 19456);
                s5_mfma<true>(p, PROJ1, LD1, TL, bp, g, dir, S5ST, nullptr, dir ? YB : YF, lds + w * 19456);
            }
        } else {
            const float* cw = p.in[21];
            const int nlat = NB * 32 * 3 * 8, nctx = NB * 4 * 2 * 8;
            for (int it = (w - 2) * nb + bid; it < nlat + nctx; it += nb * 6) {
                if (it < nlat) {
                    const int head = it & 7, type = (it >> 3) % 3, br = it / 24;
                    const int scol = (type == 0 ? 512 : (type == 1 ? 1536 : 2560)) + head * 128;
                    if (type == 1) conv_wave<false>(PROJ1, LD1, br * 64, false, false, scol, PROJ1, LD1, scol, cw, type * 1024 + head * 128, 1.f);
                    else conv_wave<true>(PROJ1, LD1, br * 64, false, false, scol, PROJ1, LD1, scol, cw, type * 1024 + head * 128, type == 2 ? 0.08838834764831845f : 1.f);
                } else {
                    const int i2 = it - nlat;
                    const int head = i2 & 7, type = (i2 >> 3) & 1, bt = i2 >> 4;
                    const int tt = bt & 3;
                    const int scol = (type == 0 ? 512 : 1536) + head * 128;
                    if (type == 1) conv_wave<false>(PROJC, LDC, bt * 64, tt > 0, tt < 3, scol, CKV, 2048, type * 1024 + head * 128, cw, type * 1024 + head * 128, 1.f);
                    else conv_wave<true>(PROJC, LDC, bt * 64, tt > 0, tt < 3, scol, CKV, 2048, type * 1024 + head * 128, cw, type * 1024 + head * 128, 1.f);
                }
            }
        }
        SEAM(3);
    }
    if (IN(4)) for (int rep_ = 0; rep_ < NREP(4); ++rep_) {
        for (int u = bid; u < 256; u += nb) {
            const int dir = u & 1, head = (u >> 1) & 7, b = u >> 4;
            dn_chunked<false>(p, CKV + head * 128, CKV + 1024 + head * 128, nullptr, 2048, ABC, b * TCX, TCX, head, dir, nullptr,
                   DNST + (size_t)u * 128 * 128, nullptr, lds);
        }
        convert_table_fp8_sliced(p.in[30], (unsigned char*)p.out + DO_HC, PEER_USCALE, bid * NTHREADS + tid, nb * NTHREADS);
        convert_table_fp8_sliced(p.in[31], (unsigned char*)p.out + DO_HC + (size_t)16384 * 1024, PEER_VSCALE, bid * NTHREADS + tid, nb * NTHREADS);
        SEAM(4);
    }
    if (IN(5)) for (int rep_ = 0; rep_ < NREP(5); ++rep_) {
        for (int u = bid; u < 256; u += nb) {
            const int dir = u & 1, head = (u >> 1) & 7, b = u >> 4;
            dn_chunked<true>(p, PROJ1 + 512 + head * 128, PROJ1 + 1536 + head * 128, PROJ1 + 2560 + head * 128, LD1, AB, b * TL, TL, head, dir,
                   DNST + (size_t)u * 128 * 128, nullptr, dir ? OB : OF, lds);
        }
        SEAM(5);
    }
#define PROJ2 ((bf16_t*)(p.ws + OFF_PROJ2))
#define Y5 ((bf16_t*)(p.ws + OFF_Y5))
    if (IN(6)) for (int rep_ = 0; rep_ < NREP(6); ++rep_) {
        {
            pg8::Gemm g{HX, WIN2, NT, 3072, 1024}; pg8::StaticOrder S; S.init(NT, 3072, nb, bid); pg8::EpiStore16 E{PROJ2, LD2};
            pg8::gemm_phase<pg8::EpiStore16, pg8::StaticOrder, true, true>((PG8_LAS unsigned char*)lds, g, S, E);
        }
        for (size_t i = (size_t)bid * NTHREADS + tid; i < (size_t)NT * 512 / 2; i += (size_t)nb * NTHREADS) {
            const unsigned a = ((const unsigned*)YF)[i], b2 = ((const unsigned*)YB)[i];
            const float y0 = __uint_as_float(a << 16) + __uint_as_float(b2 << 16);
            const float y1 = __uint_as_float(a & 0xffff0000u) + __uint_as_float(b2 & 0xffff0000u);
            ((unsigned*)Y5)[i] = pack2(gelu_(y0), gelu_(y1));
        }
        SEAM(6);
    }
#define Y5G ((bf16_t*)(p.ws + OFF_Y5G))
#define YDN ((bf16_t*)(p.ws + OFF_YDN))
    if (IN(7)) for (int rep_ = 0; rep_ < NREP(7); ++rep_) {
#define GLUW ((const bf16_t*)(p.ws + OFF_GLU))
        const float* glub = p.in[20];
        {
            pg8::Gemm g{Y5, GLUW, NT, 512, 512}; pg8::StaticOrder S; S.init(NT, 512, nb, bid); pg8::EpiGate<0> E{Y5G, 512, Y5, 512, 0, glub};
            pg8::gemm_phase<pg8::EpiGate<0>, pg8::StaticOrder, true, true>((PG8_LAS unsigned char*)lds, g, S, E);
        }
        const float* dnw = p.in[24];
        for (int tok = bid * 8 + w; tok < NT; tok += nb * 8) {
#pragma unroll
            for (int i = 0; i < 2; ++i) {
                const int col = i * 512 + lane * 8;
                const uint4 a = *(const uint4*)(OF + (size_t)tok * 1024 + col);
                const uint4 b2 = *(const uint4*)(OB + (size_t)tok * 1024 + col);
                const uint4 zz = *(const uint4*)(PROJ2 + (size_t)tok * LD2 + col);
                float o[8], z[8];
                o[0] = __uint_as_float(a.x << 16) + __uint_as_float(b2.x << 16); o[1] = __uint_as_float(a.x & 0xffff0000u) + __uint_as_float(b2.x & 0xffff0000u);
                o[2] = __uint_as_float(a.y << 16) + __uint_as_float(b2.y << 16); o[3] = __uint_as_float(a.y & 0xffff0000u) + __uint_as_float(b2.y & 0xffff0000u);
                o[4] = __uint_as_float(a.z << 16) + __uint_as_float(b2.z << 16); o[5] = __uint_as_float(a.z & 0xffff0000u) + __uint_as_float(b2.z & 0xffff0000u);
                o[6] = __uint_as_float(a.w << 16) + __uint_as_float(b2.w << 16); o[7] = __uint_as_float(a.w & 0xffff0000u) + __uint_as_float(b2.w & 0xffff0000u);
                z[0] = __uint_as_float(zz.x << 16); z[1] = __uint_as_float(zz.x & 0xffff0000u);
                z[2] = __uint_as_float(zz.y << 16); z[3] = __uint_as_float(zz.y & 0xffff0000u);
                z[4] = __uint_as_float(zz.z << 16); z[5] = __uint_as_float(zz.z & 0xffff0000u);
                z[6] = __uint_as_float(zz.w << 16); z[7] = __uint_as_float(zz.w & 0xffff0000u);
                float ss = 0.f;
#pragma unroll
                for (int c = 0; c < 8; ++c) ss += o[c] * o[c];
                ss += __shfl_xor(ss, 1); ss += __shfl_xor(ss, 2); ss += __shfl_xor(ss, 4); ss += __shfl_xor(ss, 8);
                const float r = rsqrtf(ss * (1.f / 128.f) + 1e-6f);
                float y[8];
#pragma unroll
                for (int c = 0; c < 8; ++c) y[c] = o[c] * r * dnw[(lane & 15) * 8 + c] * silu_(z[c]);
                uint4 ov;
                ov.x = pack2(y[0], y[1]); ov.y = pack2(y[2], y[3]); ov.z = pack2(y[4], y[5]); ov.w = pack2(y[6], y[7]);
                *(uint4*)(YDN + (size_t)tok * 1024 + col) = ov;
            }
        }
        SEAM(7);
    }
#define MERGED ((bf16_t*)(p.ws + OFF_MERGED))
    if (IN(8)) for (int rep_ = 0; rep_ < NREP(8); ++rep_) {
#define WB5 ((const bf16_t*)(p.ws + OFF_WB5))
#define WBDN ((const bf16_t*)(p.ws + OFF_WBDN))
        {
            pg8::Gemm g{Y5G, WB5, NT, 1024, 512}; pg8::StaticOrder S; S.init(NT, 1024, nb, bid); pg8::EpiGate<1> E{MERGED, 1024, PROJ2, LD2, 1024, nullptr};
            pg8::gemm_phase<pg8::EpiGate<1>, pg8::StaticOrder, true, true>((PG8_LAS unsigned char*)lds, g, S, E);
        }
        {
            pg8::Gemm g{YDN, WBDN, NT, 1024, 1024}; pg8::StaticOrder S; S.init(NT, 1024, nb, bid); pg8::EpiGate<2> E{MERGED, 1024, PROJ2, LD2, 2048, nullptr};
            pg8::gemm_phase<pg8::EpiGate<2>, pg8::StaticOrder, true, true>((PG8_LAS unsigned char*)lds, g, S, E);
        }
        SEAM(8);
    }
    bf16_t* XMIX = (bf16_t*)p.out;
    if (IN(9)) for (int rep_ = 0; rep_ < NREP(9); ++rep_) {
#define WOUT ((const bf16_t*)(p.ws + OFF_WOUT))
        {
            pg8::Gemm g{MERGED, WOUT, NT, 1024, 1024}; pg8::StaticOrder S; S.init(NT, 1024, nb, bid); pg8::EpiStore16 E{XMIX, 1024};
            pg8::gemm_phase<pg8::EpiStore16, pg8::StaticOrder, true, true>((PG8_LAS unsigned char*)lds, g, S, E);
        }
        SEAM(9);
    }
#define X1 ((bf16_t*)(p.ws + OFF_X1))
#define HX2 ((bf16_t*)(p.ws + OFF_HX2))
    if (IN(10)) for (int rep_ = 0; rep_ < NREP(10); ++rep_) {
        const float* x = p.in[0];
        const float* npm = p.in[7];
        const float* npf = p.in[8];
        for (int run = bid * 8 + w; run < NT / 16; run += nb * 8) {
            const int row0 = run * 16;
            const float* mb = MOD + (size_t)(row0 / TL) * 6144;
            float4 c1[4], c2[4], c3[4];
#pragma unroll
            for (int i = 0; i < 4; ++i) {
                const int d = lane * 4 + 256 * i;
                const float4 g = *(const float4*)(mb + 2 * 1024 + d), nw = *(const float4*)(npm + d);
                const float4 gn = *(const float4*)(npf + d), scl = *(const float4*)(mb + 4 * 1024 + d);
                c1[i] = make_float4(g.x * nw.x, g.y * nw.y, g.z * nw.z, g.w * nw.w);
                c2[i] = make_float4(gn.x * (1.f + scl.x), gn.y * (1.f + scl.y), gn.z * (1.f + scl.z), gn.w * (1.f + scl.w));
                c3[i] = *(const float4*)(mb + 3 * 1024 + d);
            }
            uint2 nm[4]; float4 nx[4];
#pragma unroll
            for (int i = 0; i < 4; ++i) {
                nm[i] = *(const uint2*)(XMIX + (size_t)row0 * 1024 + lane * 4 + 256 * i);
                nx[i] = *(const float4*)(x + (size_t)row0 * 1024 + lane * 4 + 256 * i);
            }
#pragma unroll 1
            for (int rr = 0; rr < 16; ++rr) {
                const int row = row0 + rr;
                float4 xm[4], xv[4];
                float ss = 0.f;
#pragma unroll
                for (int i = 0; i < 4; ++i) {
                    xm[i] = make_float4(__uint_as_float(nm[i].x << 16), __uint_as_float(nm[i].x & 0xffff0000u), __uint_as_float(nm[i].y << 16), __uint_as_float(nm[i].y & 0xffff0000u));
                    xv[i] = nx[i];
                    ss += xm[i].x * xm[i].x + xm[i].y * xm[i].y + xm[i].z * xm[i].z + xm[i].w * xm[i].w;
                }
                if (rr + 1 < 16) {
#pragma unroll
                    for (int i = 0; i < 4; ++i) {
                        nm[i] = *(const uint2*)(XMIX + (size_t)(row + 1) * 1024 + lane * 4 + 256 * i);
                        nx[i] = *(const float4*)(x + (size_t)(row + 1) * 1024 + lane * 4 + 256 * i);
                    }
                }
                ss = wave_sum_u(ss);
                const float r = rsqrtf(ss * (1.f / 1024.f) + 1e-6f);
                float4 x1[4];
                float s2 = 0.f;
#pragma unroll
                for (int i = 0; i < 4; ++i) {
                    const int d = lane * 4 + 256 * i;
                    x1[i].x = xv[i].x + c1[i].x * xm[i].x * r;
                    x1[i].y = xv[i].y + c1[i].y * xm[i].y * r;
                    x1[i].z = xv[i].z + c1[i].z * xm[i].z * r;
                    x1[i].w = xv[i].w + c1[i].w * xm[i].w * r;
                    s2 += x1[i].x * x1[i].x + x1[i].y * x1[i].y + x1[i].z * x1[i].z + x1[i].w * x1[i].w;
                    { uint2 t_; t_.x = pack2(x1[i].x, x1[i].y); t_.y = pack2(x1[i].z, x1[i].w); *(uint2*)(X1 + (size_t)row * 1024 + d) = t_; }
                }
                s2 = wave_sum_u(s2);
                const float r2 = rsqrtf(s2 * (1.f / 1024.f) + 1e-6f);
#pragma unroll
                for (int i = 0; i < 4; ++i) {
                    const int d = lane * 4 + 256 * i;
                    uint2 o;
                    o.x = pack2(x1[i].x * r2 * c2[i].x + c3[i].x, x1[i].y * r2 * c2[i].y + c3[i].y);
                    o.y = pack2(x1[i].z * r2 * c2[i].z + c3[i].z, x1[i].w * r2 * c2[i].w + c3[i].w);
                    *(uint2*)(HX2 + (size_t)row * 1024 + d) = o;
                }
            }
        }
        SEAM(10);
    }
#define QP ((bf16_t*)(p.ws + OFF_QP))
    if (IN(11)) for (int rep_ = 0; rep_ < NREP(11); ++rep_) {
#define WQ ((const bf16_t*)(p.ws + OFF_WQ))
        {
            pg8::Gemm g{HX2, WQ, NT, 2048, 1024}; pg8::StaticOrder S; S.init(NT, 2048, nb, bid); pg8::EpiStore16 E{QP, 2048};
            pg8::gemm_phase<pg8::EpiStore16, pg8::StaticOrder, true, true>((PG8_LAS unsigned char*)lds, g, S, E);
        }
        SEAM(11);
    }
#define IDX ((int*)(p.ws + OFF_IDX))
#define GATE ((float*)(p.ws + OFF_GATE))
    if (IN(12)) for (int rep_ = 0; rep_ < NREP(12); ++rep_) {
        phase_topk(p, QP, IDX, GATE, lds);
        SEAM(12);
    }
#define PART ((float*)(p.ws + OFF_QP))
#define pctr ((unsigned*)(p.ws + OFF_BAR))
    if (IN(13)) for (int rep_ = 0; rep_ < NREP(13); ++rep_) {
        phase_peer_u(HX2, IDX, PART, (unsigned char*)p.out + DO_HC, pctr, lds);
        SEAM(13);
    }
    if (IN(14)) for (int rep_ = 0; rep_ < NREP(14); ++rep_) {
        phase_peer_w(PART, GATE);
        SEAM(14);
    }
    if (IN(15)) for (int rep_ = 0; rep_ < NREP(15); ++rep_) {
        phase_peer_v(IDX, GATE, (bf16_t*)(ws + OFF_QP), (unsigned char*)p.out + DO_HC + (size_t)16384 * 1024, pctr + 8, lds);
        SEAM(15);
    }
    if (IN(16)) for (int rep_ = 0; rep_ < NREP(16); ++rep_) {
        phase_peer_final(p, X1, (const bf16_t*)(ws + OFF_QP), MOD, p.out);
    }
}

constexpr int NPHASES = 17;

extern "C" void kernel_launch(void* const* d_in, const int* in_sizes, int n_in, void* d_out, int out_size, void* d_ws, size_t ws_size,
                              hipStream_t stream) {
    static int grid_blocks = 0;
    if (grid_blocks == 0) {
        if (n_in != 32 || ws_size < WS_END || out_size != NT * DM) {
            fprintf(stderr, "kernel_launch: unexpected sizes n_in=%d ws=%zu (need %zu) out=%d\n", n_in, ws_size, (size_t)WS_END, out_size);
            grid_blocks = -1;
            return;
        }
        int dev = 0, cus = 0, per_cu = 0;
        hipGetDevice(&dev);
        hipDeviceGetAttribute(&cus, hipDeviceAttributeMultiprocessorCount, dev);
        hipFuncSetAttribute((const void*)mega, hipFuncAttributeMaxDynamicSharedMemorySize, LDS_BYTES);
        hipOccupancyMaxActiveBlocksPerMultiprocessor(&per_cu, (const void*)mega, NTHREADS, LDS_BYTES);
        if (per_cu < 1) { fprintf(stderr, "kernel_launch: occupancy query says %d blocks/CU\n", per_cu); per_cu = 1; }
        grid_blocks = cus;
        fprintf(stderr, "kernel_launch: cus=%d per_cu=%d grid=%d ws=%zu need=%zu\n", cus, per_cu, grid_blocks, ws_size, (size_t)WS_END);
    }
    if (grid_blocks < 0) return;
    Params p{};
    for (int i = 0; i < 32; ++i) p.in[i] = (const float*)d_in[i];
    p.out = (float*)d_out;
    p.ws = (unsigned char*)d_ws;
    p.ph_lo = 0; p.ph_hi = NPHASES;
    void* args[] = {&p};
    if (hipMemsetAsync((unsigned char*)d_ws + OFF_BAR, 0, (size_t)XCD_BAR_WORDS * 4, stream) != hipSuccess) { fprintf(stderr, "kernel_launch: memset of barrier words failed\n"); return; }
    hipError_t e = hipLaunchCooperativeKernel((const void*)mega, dim3(grid_blocks), dim3(NTHREADS), args, LDS_BYTES, stream);
    if (e != hipSuccess) fprintf(stderr, "cooperative launch failed: %s (grid %d)\n", hipGetErrorString(e), grid_blocks);
#if defined(PROBE_EXTRA_PHASE)
    {
        Params q = p; q.ph_lo = PROBE_EXTRA_PHASE; q.ph_hi = PROBE_EXTRA_PHASE + 1;
        void* args2[] = {&q};
        hipLaunchCooperativeKernel((const void*)mega, dim3(grid_blocks), dim3(NTHREADS), args2, LDS_BYTES, stream);
    }
#endif
}
```

```cpp
#include <hip/hip_runtime.h>
#include <hip/hip_bf16.h>
#include <hip/hip_cooperative_groups.h>
#include <cstdio>
namespace cg = cooperative_groups;

typedef unsigned short bf16_t;
using bf16x8 = __attribute__((ext_vector_type(8))) short;
using f32x4 = __attribute__((ext_vector_type(4))) float;
typedef __bf16 bf16x2_t __attribute__((ext_vector_type(2)));
using f32x16 = __attribute__((ext_vector_type(16))) float;

#define DEVI __device__ __forceinline__

constexpr int NB = 16, TL = 2048, DM = 1024, NT = NB * TL, TCX = 256, NC = NB * TCX;
constexpr int LD1 = 3584;
constexpr int LDC = 2560;
constexpr int LD2 = 3072;
constexpr int W1ROWS = 3712;
constexpr int NTHREADS = 512;
constexpr int LDS_BYTES = 139264;

constexpr size_t al256(size_t x) { return (x + 255) & ~(size_t)255; }
constexpr size_t OFF_WIN1 = 0;
constexpr size_t OFF_WIN2 = OFF_WIN1 + al256((size_t)W1ROWS * 1024 * 2);
constexpr size_t OFF_GLU  = OFF_WIN2 + al256((size_t)3072 * 1024 * 2);
constexpr size_t OFF_WB5  = OFF_GLU + al256((size_t)512 * 512 * 2);
constexpr size_t OFF_WBDN = OFF_WB5 + al256((size_t)1024 * 512 * 2);
constexpr size_t OFF_WOUT = OFF_WBDN + al256((size_t)1024 * 1024 * 2);
constexpr size_t OFF_WQ   = OFF_WOUT + al256((size_t)1024 * 1024 * 2);
constexpr size_t OFF_MOD  = OFF_WQ + al256((size_t)2048 * 1024 * 2);
constexpr size_t OFF_AB   = OFF_MOD + al256((size_t)17 * 6144 * 4);
constexpr size_t OFF_ABC  = OFF_AB + al256((size_t)NT * 32 * 4);
constexpr size_t OFF_S5ST = OFF_ABC + al256((size_t)NC * 32 * 4);
constexpr size_t OFF_DNST = OFF_S5ST + al256((size_t)NB * 32 * 2 * 64 * 2 * 4);
constexpr size_t OFF_PROJC = OFF_DNST + al256((size_t)NB * 8 * 2 * 128 * 128 * 4);
constexpr size_t OFF_CKV  = OFF_PROJC + al256((size_t)NC * LDC * 2);
constexpr size_t OFF_YF   = OFF_CKV + al256((size_t)NC * 2048 * 2);
constexpr size_t OFF_YB   = OFF_YF + al256((size_t)NT * 512 * 2);
constexpr size_t OFF_OF   = OFF_YB + al256((size_t)NT * 512 * 2);
constexpr size_t OFF_OB   = OFF_OF + al256((size_t)NT * 1024 * 2);
constexpr size_t OFF_PROJ1 = OFF_OB + al256((size_t)NT * 1024 * 2);
constexpr size_t OFF_BAR  = OFF_PROJ1 + al256((size_t)NT * LD1 * 2);
constexpr size_t WS_END   = OFF_BAR + al256((size_t)3456 * 4);
constexpr size_t OFF_PROJ2 = OFF_PROJ1;
constexpr size_t OFF_X1   = OFF_PROJ1;
constexpr size_t OFF_HX2  = OFF_PROJ1 + al256((size_t)NT * 1024 * 4);
constexpr size_t OFF_Y5   = OFF_YF;
constexpr size_t OFF_Y5G  = OFF_YB;
constexpr size_t OFF_YDN  = OFF_OF;
constexpr size_t OFF_MERGED = OFF_OB;
constexpr size_t OFF_QP   = OFF_OF;
constexpr size_t OFF_IDX  = OFF_YF;
constexpr size_t OFF_GATE = OFF_YB;
constexpr size_t OFF_UT   = OFF_PROJC;
constexpr size_t OFF_VT   = OFF_PROJC;
static_assert(OFF_HX2 + (size_t)NT * 1024 * 2 <= OFF_BAR, "alias overflow");
static_assert(OFF_UT + (size_t)16384 * 1024 * 2 <= OFF_YF, "UT overflow");
static_assert(OFF_VT + (size_t)16384 * 1024 * 2 <= OFF_YF, "VT overflow");
static_assert((size_t)NT * 128 * 4 <= (size_t)NT * 512 * 2, "idx alias");
constexpr size_t DO_HX = 0;
constexpr size_t DO_HC = (size_t)NT * 1024 * 2;

struct Params {
    const float* in[32];
    float* out;
    unsigned char* ws;
    int ph_lo, ph_hi;
};

DEVI float bf2f(bf16_t v) { return __uint_as_float(((unsigned)v) << 16); }
typedef float f32x2_t __attribute__((ext_vector_type(2)));
DEVI unsigned pack2(float a, float b) {
    const f32x2_t v = {a, b};
    return __builtin_bit_cast(unsigned, __builtin_convertvector(v, bf16x2_t));
}
DEVI bf16_t f2bf(float f) { return (bf16_t)(pack2(f, 0.f) & 0xffffu); }
DEVI float sigmoid_(float x) { return 1.f / (1.f + __expf(-x)); }
DEVI float silu_(float x) { return x / (1.f + __expf(-x)); }
DEVI float gelu_(float x) {
    float u = 0.7978845608028654f * (x + 0.044715f * x * x * x);
    return 0.5f * x * (1.f + tanhf(u));
}
DEVI float softplus_(float x) { return x > 20.f ? x : log1pf(__expf(x)); }
DEVI float wave_sum(float v) {
#pragma unroll
    for (int m = 32; m >= 1; m >>= 1) v += __shfl_xor(v, m);
    return v;
}
DEVI float wave_max(float v) {
#pragma unroll
    for (int m = 32; m >= 1; m >>= 1) v = fmaxf(v, __shfl_xor(v, m));
    return v;
}
DEVI float readlane_f(float v, int l) { return __int_as_float(__builtin_amdgcn_readlane(__float_as_int(v), l)); }

template <class Epi>
DEVI void gemm_tile(const bf16_t* A, int lda, const bf16_t* Bt, int ldb, int K, int m0, int n0,
                    unsigned char* lds, Epi epi) {
    constexpr int ST = 144;
    unsigned char* As = lds;
    unsigned char* Bs = lds + 128 * ST;
    const int tid = threadIdx.x, lane = tid & 63, w = tid >> 6, wm = w >> 2, wn = w & 3;
    f32x4 acc[4][2];
#pragma unroll
    for (int mi = 0; mi < 4; ++mi)
#pragma unroll
        for (int ni = 0; ni < 2; ++ni) acc[mi][ni] = (f32x4){0.f, 0.f, 0.f, 0.f};
    uint4 ra0, ra1, rb0, rb1;
    const int nk = K >> 6;
    const int lrow0 = tid >> 3, lkc = (tid & 7) * 8;
    const bf16_t* Ap = A + (size_t)(m0 + lrow0) * lda + lkc;
    const bf16_t* Bp = Bt + (size_t)(n0 + lrow0) * ldb + lkc;
    const size_t a64 = (size_t)64 * lda, b64 = (size_t)64 * ldb;
    ra0 = *(const uint4*)(Ap); ra1 = *(const uint4*)(Ap + a64);
    rb0 = *(const uint4*)(Bp); rb1 = *(const uint4*)(Bp + b64);
    for (int kt = 0; kt < nk; ++kt) {
        __syncthreads();
        *(uint4*)(As + lrow0 * ST + lkc * 2) = ra0;
        *(uint4*)(As + (lrow0 + 64) * ST + lkc * 2) = ra1;
        *(uint4*)(Bs + lrow0 * ST + lkc * 2) = rb0;
        *(uint4*)(Bs + (lrow0 + 64) * ST + lkc * 2) = rb1;
        __syncthreads();
        if (kt + 1 < nk) {
            const int ko = (kt + 1) * 64;
            ra0 = *(const uint4*)(Ap + ko); ra1 = *(const uint4*)(Ap + a64 + ko);
            rb0 = *(const uint4*)(Bp + ko); rb1 = *(const uint4*)(Bp + b64 + ko);
        }
#pragma unroll
        for (int ks = 0; ks < 2; ++ks) {
            bf16x8 af[4], bfr[2];
            const int kb = (ks * 32 + 8 * (lane >> 4)) * 2;
#pragma unroll
            for (int mi = 0; mi < 4; ++mi) af[mi] = *(const bf16x8*)(As + (wm * 64 + mi * 16 + (lane & 15)) * ST + kb);
#pragma unroll
            for (int ni = 0; ni < 2; ++ni) bfr[ni] = *(const bf16x8*)(Bs + (wn * 32 + ni * 16 + (lane & 15)) * ST + kb);
#pragma unroll
            for (int mi = 0; mi < 4; ++mi)
#pragma unroll
                for (int ni = 0; ni < 2; ++ni)
                    acc[mi][ni] = __builtin_amdgcn_mfma_f32_16x16x32_bf16(af[mi], bfr[ni], acc[mi][ni], 0, 0, 0);
        }
    }
#pragma unroll
    for (int mi = 0; mi < 4; ++mi)
#pragma unroll
        for (int ni = 0; ni < 2; ++ni)
#pragma unroll
            for (int r = 0; r < 4; ++r) {
                const int row = m0 + wm * 64 + mi * 16 + (lane >> 4) * 4 + r;
                const int col = n0 + wn * 32 + ni * 16 + (lane & 15);
                epi(row, col, acc[mi][ni][r]);
                if (r == 3) __builtin_amdgcn_sched_barrier(0);
            }
    __syncthreads();
}

DEVI void phase_adaln(const Params& p, float* MOD, unsigned char* lds) {
    float* sc = (float*)lds;
    float* red = sc + 17 * 1024;
    const int tid = threadIdx.x;
    const float* c = p.in[1];
    const float* cctx = p.in[3];
    const float* w_mod = p.in[4];
    const float* b_mod = p.in[5];
    const int nab = (int)gridDim.x < 192 ? (int)gridDim.x : 192;
    if ((int)blockIdx.x >= nab) return;
    for (int i = tid; i < 17 * 1024; i += NTHREADS) {
        int r = i >> 10, d = i & 1023;
        float v = r < 16 ? c[r * 1024 + d] : cctx[d];
        sc[i] = silu_(v);
    }
    __syncthreads();
    for (int item = blockIdx.x; item < 192; item += nab) {
        const int cc = tid & 31, kg = tid >> 5;
        const int col = item * 32 + cc;
        float acc[17];
#pragma unroll
        for (int r = 0; r < 17; ++r) acc[r] = 0.f;
        for (int k8 = kg * 64; k8 < kg * 64 + 64; k8 += 8) {
            float wv[8];
#pragma unroll
            for (int u = 0; u < 8; ++u) wv[u] = w_mod[(size_t)(k8 + u) * 6144 + col];
#pragma unroll
            for (int u = 0; u < 8; ++u)
#pragma unroll
                for (int r = 0; r < 17; ++r) acc[r] += sc[r * 1024 + k8 + u] * wv[u];
        }
#pragma unroll
        for (int r = 0; r < 17; ++r) red[(kg * 17 + r) * 32 + cc] = acc[r];
        __syncthreads();
        for (int o = tid; o < 17 * 32; o += NTHREADS) {
            const int r = o >> 5, c2 = o & 31;
            float s = b_mod[item * 32 + c2];
            for (int g = 0; g < 16; ++g) s += red[(g * 17 + r) * 32 + c2];
            MOD[r * 6144 + item * 32 + c2] = s;
        }
        __syncthreads();
    }
}

DEVI void conv_seg(const float* src, int K, int ldsrc, int col0, int ncols, bf16_t* dst, int drow0, unsigned char* lds, int vb, int nvb) {
    float* tile = (float*)lds;
    const int tid = threadIdx.x;
    const int ntn = (ncols + 63) >> 6, ntk = K >> 6;
    const int r0 = tid >> 4, c4 = (tid & 15) * 4;
    float4 v0, v1;
    auto tload = [&](int t) {
        const int tn = t / ntk, tk = t % ntk;
        const int n0 = tn * 64, k0 = tk * 64;
        v0 = make_float4(0.f, 0.f, 0.f, 0.f); v1 = v0;
        if (n0 + c4 < ncols) {
            v0 = *(const float4*)(src + (size_t)(k0 + r0) * ldsrc + col0 + n0 + c4);
            v1 = *(const float4*)(src + (size_t)(k0 + r0 + 32) * ldsrc + col0 + n0 + c4);
        }
    };
    if (vb < ntn * ntk) tload(vb);
    for (int t = vb; t < ntn * ntk; t += nvb) {
        const int tn = t / ntk, tk = t % ntk;
        const int n0 = tn * 64, k0 = tk * 64;
        __syncthreads();
        tile[r0 * 65 + c4 + 0] = v0.x; tile[r0 * 65 + c4 + 1] = v0.y; tile[r0 * 65 + c4 + 2] = v0.z; tile[r0 * 65 + c4 + 3] = v0.w;
        tile[(r0 + 32) * 65 + c4 + 0] = v1.x; tile[(r0 + 32) * 65 + c4 + 1] = v1.y; tile[(r0 + 32) * 65 + c4 + 2] = v1.z; tile[(r0 + 32) * 65 + c4 + 3] = v1.w;
        __syncthreads();
        if (t + nvb < ntn * ntk) tload(t + nvb);
        {
            const int n = tid >> 3, kq = (tid & 7) * 8;
            if (n0 + n < ncols) {
                uint4 o;
                o.x = pack2(tile[(kq + 0) * 65 + n], tile[(kq + 1) * 65 + n]);
                o.y = pack2(tile[(kq + 2) * 65 + n], tile[(kq + 3) * 65 + n]);
                o.z = pack2(tile[(kq + 4) * 65 + n], tile[(kq + 5) * 65 + n]);
                o.w = pack2(tile[(kq + 6) * 65 + n], tile[(kq + 7) * 65 + n]);
                *(uint4*)(dst + (size_t)(drow0 + n0 + n) * K + k0 + kq) = o;
            }
        }
    }
    __syncthreads();
}

DEVI void phase_weights(const Params& p, unsigned char* lds) {
    unsigned char* ws = p.ws;
    bf16_t* WIN1 = (bf16_t*)(ws + OFF_WIN1);
    bf16_t* WIN2 = (bf16_t*)(ws + OFF_WIN2);
    const int nvb = gridDim.x;
    const int vb = ((int)blockIdx.x + nvb - 192 % nvb) % nvb;
    const float* w_in = p.in[10];
    conv_seg(w_in, 1024, 6688, 0, 2560, WIN1, 0, lds, vb, nvb);
    conv_seg(w_in, 1024, 6688, 2592, 1024, WIN1, 2560, lds, vb, nvb);
    conv_seg(w_in, 1024, 6688, 2560, 32, WIN1, 3584, lds, vb, nvb);
    conv_seg(w_in, 1024, 6688, 3616, 3072, WIN2, 0, lds, vb, nvb);
    conv_seg(p.in[19], 512, 512, 0, 512, (bf16_t*)(ws + OFF_GLU), 0, lds, vb, nvb);
    conv_seg(p.in[25], 512, 1024, 0, 1024, (bf16_t*)(ws + OFF_WB5), 0, lds, vb, nvb);
    conv_seg(p.in[26], 1024, 1024, 0, 1024, (bf16_t*)(ws + OFF_WBDN), 0, lds, vb, nvb);
    conv_seg(p.in[27], 1024, 1024, 0, 1024, (bf16_t*)(ws + OFF_WOUT), 0, lds, vb, nvb);
    conv_seg(p.in[28], 1024, 2048, 0, 2048, (bf16_t*)(ws + OFF_WQ), 0, lds, vb, nvb);
    {
        uint4* z = (uint4*)(WIN1 + (size_t)3616 * 1024);
        const int n16 = 96 * 1024 * 2 / 16;
        for (int i = vb * NTHREADS + threadIdx.x; i < n16; i += nvb * NTHREADS) z[i] = make_uint4(0, 0, 0, 0);
    }
}

template <int RUN>
DEVI void modulate_rows(const float* X, int nrows, int rows_per_batch, const float* gain, const float* shift0, const float* scale0,
                        int bstride, bf16_t* OUT) {
    const int lane = threadIdx.x & 63, w = threadIdx.x >> 6;
    for (int run = blockIdx.x * 8 + w; run < nrows / RUN; run += gridDim.x * 8) {
        const int row0 = run * RUN;
        const int b = row0 / rows_per_batch;
        const float* sh = shift0 + (size_t)b * bstride;
        const float* scl = scale0 + (size_t)b * bstride;
        float4 c1[4], c2[4];
#pragma unroll
        for (int i = 0; i < 4; ++i) {
            const int d = lane * 4 + 256 * i;
            const float4 g = *(const float4*)(gain + d), s = *(const float4*)(scl + d);
            c1[i] = make_float4(g.x * (1.f + s.x), g.y * (1.f + s.y), g.z * (1.f + s.z), g.w * (1.f + s.w));
            c2[i] = *(const float4*)(sh + d);
        }
        float4 nv[4];
#pragma unroll
        for (int i = 0; i < 4; ++i) nv[i] = *(const float4*)(X + (size_t)row0 * 1024 + lane * 4 + 256 * i);
#pragma unroll 1
        for (int rr = 0; rr < RUN; ++rr) {
            const int row = row0 + rr;
            float4 v[4];
            float ss = 0.f;
#pragma unroll
            for (int i = 0; i < 4; ++i) {
                v[i] = nv[i];
                ss += v[i].x * v[i].x + v[i].y * v[i].y + v[i].z * v[i].z + v[i].w * v[i].w;
            }
            if (rr + 1 < RUN) {
#pragma unroll
                for (int i = 0; i < 4; ++i) nv[i] = *(const float4*)(X + (size_t)(row + 1) * 1024 + lane * 4 + 256 * i);
            }
            ss = wave_sum(ss);
            const float r = rsqrtf(ss * (1.f / 1024.f) + 1e-6f);
#pragma unroll
            for (int i = 0; i < 4; ++i) {
                const int d = lane * 4 + 256 * i;
                uint2 o;
                o.x = pack2(v[i].x * r * c1[i].x + c2[i].x, v[i].y * r * c1[i].y + c2[i].y);
                o.y = pack2(v[i].z * r * c1[i].z + c2[i].z, v[i].w * r * c1[i].w + c2[i].w);
                *(uint2*)(OUT + (size_t)row * 1024 + d) = o;
            }
        }
    }
}


template <bool READOUT>
DEVI void s5_mfma(const Params& p, const bf16_t* U, int ldu, int Tlen, int bp, int g, int dir,
                  const float* S5in, float* S5out, bf16_t* Y, unsigned char* wl  ) {
    constexpr int HST = 272;
    unsigned char* Himg = wl;
    const int lane = threadIdx.x & 63;
    const int p0 = lane & 31, hf = lane >> 5;
    const int dg = dir * 32 + g;
    const float step = expf(p.in[13][dg]);
    float ar[2], ai[2], hr[2], hi[2];
    bf16x8 Bf[4];
#pragma unroll
    for (int pt = 0; pt < 2; ++pt) {
        const int pp = dg * 64 + pt * 32 + p0;
        const float lr = p.in[11][pp], li = p.in[12][pp];
        const float mag = expf(lr * step);
        ar[pt] = mag * cosf(li * step); ai[pt] = mag * sinf(li * step);
        const float den = lr * lr + li * li;
        const float fr = ((ar[pt] - 1.f) * lr + ai[pt] * li) / den;
        const float fi = (ai[pt] * lr - (ar[pt] - 1.f) * li) / den;
        bf16x8 bre, bim;
#pragma unroll
        for (int j = 0; j < 8; ++j) {
            const float br = p.in[14][pp * 16 + 8 * hf + j], bi = p.in[15][pp * 16 + 8 * hf + j];
            bre[j] = (short)f2bf(fr * br - fi * bi);
            bim[j] = (short)f2bf(fr * bi + fi * br);
        }
        Bf[pt] = bre; Bf[2 + pt] = bim;
        hr[pt] = 0.f; hi[pt] = 0.f;
    }
    const int myb = 2 * bp + hf;
    if (S5in) {
        const float* h0 = S5in + (size_t)((myb * 32 + g) * 2 + dir) * 128;
#pragma unroll
        for (int pt = 0; pt < 2; ++pt) { hr[pt] = h0[pt * 32 + p0]; hi[pt] = h0[64 + pt * 32 + p0]; }
    }
    bf16x8 Cf[4], Df;
    if (READOUT) {
        const int h = lane & 15, kq = lane >> 4;
#pragma unroll
        for (int ks = 0; ks < 4; ++ks) {
            bf16x8 c;
#pragma unroll
            for (int j = 0; j < 8; ++j) {
                const int pl = ks * 8 + 2 * kq + (j >> 2), tile = j & 3;
                const int pidx = (dg * 16 + h) * 64 + (tile & 1) * 32 + pl;
                const float v = (tile < 2) ? p.in[16][pidx] : -p.in[17][pidx];
                c[j] = (short)f2bf(v);
            }
            Cf[ks] = c;
        }
#pragma unroll
        for (int j = 0; j < 8; ++j) {
            const int k = 8 * kq + j;
            Df[j] = (short)((k == h) ? f2bf(p.in[18][g * 16 + h]) : (bf16_t)0);
        }
    }
    const int m = lane & 31, kh = lane >> 5;
    const int ahf = (m >> 2) & 1, ai_tok = (m & 3) + 4 * (m >> 3);
    const int ab = 2 * bp + ahf;
    const int nblk = Tlen >> 4;
    const bf16_t* Ubase = U + (size_t)ab * Tlen * ldu + g * 16 + 8 * kh;
    auto tok_of = [&](int blk, int i) -> int {
        const int t0 = dir ? (Tlen - 16 * (blk + 1)) : 16 * blk;
        return dir ? (t0 + 15 - i) : (t0 + i);
    };
    auto scan_block = [&](const uint4& acur, int buf) {
        const bf16x8 af = __builtin_bit_cast(bf16x8, acur);
        f32x16 X[4];
#pragma unroll
        for (int t = 0; t < 4; ++t) {
            f32x16 z;
#pragma unroll
            for (int r = 0; r < 16; ++r) z[r] = 0.f;
            X[t] = __builtin_amdgcn_mfma_f32_32x32x16_bf16(af, Bf[t], z, 0, 0, 0);
        }
        unsigned char* Hb = Himg + buf * (32 * HST + 1024);
        if (READOUT && dir == 0) *(uint4*)(Hb + 32 * HST + (ahf * 16 + ai_tok) * 32 + kh * 16) = acur;
#pragma unroll
        for (int r = 0; r < 16; ++r) {
#pragma unroll
            for (int pt = 0; pt < 2; ++pt) {
                const float nr = ar[pt] * hr[pt] - ai[pt] * hi[pt] + X[pt][r];
                const float ni = ar[pt] * hi[pt] + ai[pt] * hr[pt] + X[2 + pt][r];
                hr[pt] = nr; hi[pt] = ni;
                X[pt][r] = nr; X[2 + pt][r] = ni;
            }
            if (READOUT) {
                uint2 o;
                o.x = pack2(X[0][r], X[1][r]);
                o.y = pack2(X[2][r], X[3][r]);
                *(uint2*)(Hb + (hf * 16 + r) * HST + p0 * 8) = o;
            }
        }
    };
    uint4 anext = *(const uint4*)(Ubase + (size_t)tok_of(0, ai_tok) * ldu);
    {
        const uint4 a0 = anext;
        if (nblk > 1) anext = *(const uint4*)(Ubase + (size_t)tok_of(1, ai_tok) * ldu);
        scan_block(a0, 0);
    }
    for (int blk = 0; blk < nblk; ++blk) {
        const int buf = blk & 1;
        f32x4 yacc[2];
        if (READOUT) {
            const int kq = lane >> 4;
            const unsigned char* Hb = Himg + buf * (32 * HST + 1024);
#pragma unroll
            for (int hb = 0; hb < 2; ++hb) {
                yacc[hb] = (f32x4){0.f, 0.f, 0.f, 0.f};
#pragma unroll
                for (int ks = 0; ks < 4; ++ks) {
                    const bf16x8 hfrag = *(const bf16x8*)(Hb + (hb * 16 + (lane & 15)) * HST + (ks * 32 + 8 * kq) * 2);
                    yacc[hb] = __builtin_amdgcn_mfma_f32_16x16x32_bf16(hfrag, Cf[ks], yacc[hb], 0, 0, 0);
                }
                if (dir == 0) {
                    uint4 uu = make_uint4(0, 0, 0, 0);
                    if (kq < 2) uu = *(const uint4*)(Hb + 32 * HST + (hb * 16 + (lane & 15)) * 32 + kq * 16);
                    yacc[hb] = __builtin_amdgcn_mfma_f32_16x16x32_bf16(__builtin_bit_cast(bf16x8, uu), Df, yacc[hb], 0, 0, 0);
                }
            }
        }
        if (blk + 1 < nblk) {
            const uint4 acur = anext;
            if (blk + 2 < nblk) anext = *(const uint4*)(Ubase + (size_t)tok_of(blk + 2, ai_tok) * ldu);
            scan_block(acur, buf ^ 1);
        }
        if (READOUT) {
            const int h = lane & 15, kq = lane >> 4;
#pragma unroll
            for (int hb = 0; hb < 2; ++hb) {
                const int ob = 2 * bp + hb;
#pragma unroll
                for (int r = 0; r < 4; ++r) {
                    const int tok = tok_of(blk, 4 * kq + r);
                    Y[((size_t)ob * Tlen + tok) * 512 + g * 16 + h] = f2bf(yacc[hb][r]);
                }
            }
        }
    }
    if (S5out) {
        float* ho = S5out + (size_t)((myb * 32 + g) * 2 + dir) * 128;
#pragma unroll
        for (int pt = 0; pt < 2; ++pt) { ho[pt * 32 + p0] = hr[pt]; ho[64 + pt * 32 + p0] = hi[pt]; }
    }
}

template <int CTRL>
DEVI float dpp_add(float v) {
    const int iv = __float_as_int(v);
    const int r = __builtin_amdgcn_update_dpp(0, iv, CTRL, 0xf, 0xf, true);
    return v + __int_as_float(r);
}
DEVI float red8(float v) {
    v = dpp_add<0xB1>(v);
    v = dpp_add<0x4E>(v);
    v = dpp_add<0x141>(v);
    return v;
}

#ifndef DN_DUP
#define DN_DUP -1
#endif
typedef short s16x4 __attribute__((ext_vector_type(4)));
DEVI int pos32(int x) { return ((x >> 2) & 3) * 8 + (x >> 4) * 4 + (x & 3); }
DEVI unsigned cvtpk(float lo, float hi) { return pack2(lo, hi); }
DEVI s16x4 cvt4(const f32x4& v) { uint2 t; t.x = cvtpk(v[0], v[1]); t.y = cvtpk(v[2], v[3]); return __builtin_bit_cast(s16x4, t); }
DEVI bf16x8 cvt8(const f32x4& a, const f32x4& b) { uint4 t; t.x = cvtpk(a[0], a[1]); t.y = cvtpk(a[2], a[3]); t.z = cvtpk(b[0], b[1]); t.w = cvtpk(b[2], b[3]); return __builtin_bit_cast(bf16x8, t); }
DEVI f32x4 mfma16(const s16x4& a, const s16x4& b, const f32x4& c) { return __builtin_amdgcn_mfma_f32_16x16x16bf16_1k(a, b, c, 0, 0, 0); }
DEVI f32x4 mfma32(const bf16x8& a, const bf16x8& b, const f32x4& c) { return __builtin_amdgcn_mfma_f32_16x16x32_bf16(a, b, c, 0, 0, 0); }

DEVI s16x4 lds_tr_read(const unsigned char* p) { return __builtin_amdgcn_ds_read_tr16_b64_v4i16((__attribute__((address_space(3))) s16x4*)p); }
DEVI void lds_barrier() { asm volatile("s_waitcnt lgkmcnt(0)" ::: "memory"); __builtin_amdgcn_s_barrier(); asm volatile("" ::: "memory"); }
template <bool HAS_Q>
DEVI void dn_chunked(const Params& p, const bf16_t* Kg, const bf16_t* Vg, const bf16_t* Qg, int ld, const float* AB, int tokbase, int Tlen,
                     int head, int dir, const float* S0, float* Sout, bf16_t* O, unsigned char* lds) {
    constexpr int RS = 272, TS = 144, BS = 40;
    constexpr int KP_OFF = 0, QP_OFF = 17408, WP_OFF = 34816, KT_OFF = 52224, VT_OFF = 70656, AT_OFF = 89088, AB_OFF = 98304,
                  AF_OFF = 107520, TN_OFF = 111872, TSW_OFF = 114432, TSU_OFF = 116992, GT_OFF = 119552, OT_OFF = 120848;
    float* gt = (float*)(lds + GT_OFF);
    const int tid = threadIdx.x, lane = tid & 63, w = tid >> 6;
    const int m = lane & 15, q = lane >> 4;
    f32x4 S[8];
#pragma unroll
    for (int mt = 0; mt < 8; ++mt) {
        if (S0) {
#pragma unroll
            for (int r = 0; r < 4; ++r) S[mt][r] = S0[(size_t)(16 * mt + 4 * q + r) * 128 + 16 * w + m];
        } else S[mt] = (f32x4){0.f, 0.f, 0.f, 0.f};
    }
    const float aexp = expf(p.in[22][dir * 8 + head]);
    const float dtb = p.in[23][dir * 8 + head];
    const int nch = Tlen >> 6;
    uint4 rk0, rk1, rq0, rq1, rv0, rv1; float rg = 0.f, rb = 0.f;
    rq0 = make_uint4(0, 0, 0, 0); rq1 = rq0;
    auto gload = [&](int ci) {
        const int cb = dir ? (nch - 1 - ci) : ci;
        const size_t tok = (size_t)(tokbase + cb * 64 + (dir ? (63 - lane) : lane));
        const bf16_t* kp = Kg + tok * ld + 16 * w;
        const bf16_t* vp = Vg + tok * ld + 16 * w;
        rk0 = *(const uint4*)kp; rk1 = *(const uint4*)(kp + 8);
        rv0 = *(const uint4*)vp; rv1 = *(const uint4*)(vp + 8);
        if (HAS_Q) { const bf16_t* qp = Qg + tok * ld + 16 * w; rq0 = *(const uint4*)qp; rq1 = *(const uint4*)(qp + 8); }
        if (w == 0) { rg = AB[tok * 32 + (2 * dir) * 8 + head]; rb = AB[tok * 32 + (2 * dir + 1) * 8 + head]; }
    };
    gload(0);
    for (int ci = 0; ci < nch; ++ci) {
        for (int dup0_ = 0; dup0_ < (DN_DUP == 0 ? 2 : 1); ++dup0_)
        {
            const int Bk = w >> 1, tk = w & 1;
            unsigned char* kr = lds + KP_OFF + lane * RS + 2 * (32 * Bk + 4 * tk);
            *(uint2*)(kr + 0)  = make_uint2(rk0.x, rk0.y);
            *(uint2*)(kr + 16) = make_uint2(rk0.z, rk0.w);
            *(uint2*)(kr + 32) = make_uint2(rk1.x, rk1.y);
            *(uint2*)(kr + 48) = make_uint2(rk1.z, rk1.w);
            if (HAS_Q) {
                unsigned char* qr = lds + QP_OFF + lane * RS + 2 * (32 * Bk + 4 * tk);
                *(uint2*)(qr + 0)  = make_uint2(rq0.x, rq0.y);
                *(uint2*)(qr + 16) = make_uint2(rq0.z, rq0.w);
                *(uint2*)(qr + 32) = make_uint2(rq1.x, rq1.y);
                *(uint2*)(qr + 48) = make_uint2(rq1.z, rq1.w);
            }
            {
                unsigned char* vr = lds + VT_OFF + lane * RS + 32 * w;
                *(uint4*)(vr) = rv0; *(uint4*)(vr + 16) = rv1;
            }
            if (w == 0) {
                float g = -aexp * softplus_(rg + dtb);
#pragma unroll
                for (int d = 1; d < 64; d <<= 1) { const float t = __shfl_up(g, d); if (lane >= d) g += t; }
                const float glast = __shfl(g, 63);
                const float beta = sigmoid_(rb), eg = __expf(g);
                gt[lane] = g; gt[64 + lane] = eg; gt[128 + lane] = beta; gt[192 + lane] = __expf(glast - g); gt[256 + lane] = beta * eg;
                if (lane == 0) gt[320] = __expf(glast);
            }
        }
        if (ci + 1 < nch) gload(ci + 1);
        lds_barrier();
        auto gram_job = [&](int type, int t10) {
            const int ct = (t10 >= 6) ? 3 : (t10 >= 3) ? 2 : (t10 >= 1) ? 1 : 0;
            const int st = t10 - ct * (ct + 1) / 2;
            const unsigned char* xa = lds + (type ? QP_OFF : KP_OFF) + (16 * ct + m) * RS + 16 * q;
            const unsigned char* xb = lds + KP_OFF + (16 * st + m) * RS + 16 * q;
            bf16x8 fa[4], fb[4];
#pragma unroll
            for (int B = 0; B < 4; ++B) { fa[B] = *(const bf16x8*)(xa + 64 * B); fb[B] = *(const bf16x8*)(xb + 64 * B); }
            f32x4 acc = (f32x4){0.f, 0.f, 0.f, 0.f};
#pragma unroll
            for (int B = 0; B < 4; ++B) acc = mfma32(fa[B], fb[B], acc);
            const int sidx = 16 * st + m;
            const float gs = gt[sidx];
#pragma unroll
            for (int r = 0; r < 4; ++r) {
                const int c = 16 * ct + 4 * q + r;
                const float dec = __expf(fminf(gt[c] - gs, 0.f));
                if (type == 0) {
                    const float a = (sidx < c) ? gt[128 + c] * acc[r] * dec : 0.f;
                    *(unsigned short*)(lds + AB_OFF + c * TS + 2 * sidx) = f2bf(a);
                    if (ct == st) *(float*)(lds + AF_OFF + ((ct * 16 + (c & 15)) * 17 + m) * 4) = a;
                } else {
                    const float a = (sidx <= c) ? acc[r] * dec : 0.f;
                    *(unsigned short*)(lds + AT_OFF + c * TS + 2 * (32 * (sidx >> 5) + pos32(sidx & 31))) = f2bf(a);
                }
            }
        };
        for (int dup1_ = 0; dup1_ < (DN_DUP == 1 ? 2 : 1); ++dup1_) for (int j = w; j < 10; j += 8) gram_job(0, j);
        lds_barrier();
        if (w == 0) for (int dup2_ = 0; dup2_ < (DN_DUP == 2 ? 2 : 1); ++dup2_) {
            const int r = q, col = m;
            const float* af = (const float*)(lds + AF_OFF) + r * 16 * 17;
            float t[16];
#pragma unroll
            for (int i = 0; i < 16; ++i) t[i] = (i == col) ? 1.f : 0.f;
#pragma unroll
            for (int jj = 0; jj < 15; ++jj) {
#pragma unroll
                for (int i = jj + 1; i < 16; ++i) t[i] -= af[i * 17 + jj] * t[jj];
                if ((jj & 1) == 1) __builtin_amdgcn_sched_barrier(0);
            }
            const float sw = gt[256 + 16 * r + col], su = gt[128 + 16 * r + col];
#pragma unroll
            for (int i = 0; i < 16; ++i) {
                *(unsigned short*)(lds + TN_OFF + (r * 16 + i) * BS + 2 * col) = f2bf(-t[i]);
                *(unsigned short*)(lds + TSW_OFF + (r * 16 + i) * BS + 2 * col) = f2bf(t[i] * sw);
                *(unsigned short*)(lds + TSU_OFF + (r * 16 + i) * BS + 2 * col) = f2bf(t[i] * su);
            }
        } else if (HAS_Q) {
            for (int j = w - 1; j < 10; j += 7) gram_job(1, j);
            for (int idx = tid - 64; idx < 6 * 256; idx += NTHREADS - 64) {
                const int tile = idx >> 8, e = idx & 255;
                const int ct = (tile < 3) ? 0 : (tile < 5) ? 1 : 2;
                const int st = (tile < 3) ? tile + 1 : (tile < 5) ? tile - 1 : 3;
                const int c = 16 * ct + (e >> 4), sidx = 16 * st + (e & 15);
                *(unsigned short*)(lds + AT_OFF + c * TS + 2 * (32 * (sidx >> 5) + pos32(sidx & 31))) = 0;
            }
        }
        lds_barrier();
        f32x4 vn[4];
        for (int dup3_ = 0; dup3_ < (DN_DUP == 3 ? 2 : 1); ++dup3_) {
            const int tq = (lane & 15) >> 2, tp = lane & 3;
            const unsigned char* xtk = lds + KP_OFF + (4 * q + tq) * RS + 2 * (32 * (w >> 1) + 8 * tp + 4 * (w & 1));
            const unsigned char* xtv = lds + VT_OFF + (4 * q + tq) * RS + 2 * (16 * w + 4 * tp);
            s16x4 XbW[4], XbU[4];
            f32x4 XW[4];
#pragma unroll
            for (int r = 0; r < 4; ++r) {
                const s16x4 a_tw = *(const s16x4*)(lds + TSW_OFF + (r * 16 + m) * BS + 8 * q);
                const s16x4 a_tu = *(const s16x4*)(lds + TSU_OFF + (r * 16 + m) * BS + 8 * q);
                const s16x4 b_k = lds_tr_read(xtk + 16 * r * RS);
                const s16x4 b_v = lds_tr_read(xtv + 16 * r * RS);
                XW[r] = mfma16(a_tw, b_k, (f32x4){0.f, 0.f, 0.f, 0.f});
                vn[r] = mfma16(a_tu, b_v, (f32x4){0.f, 0.f, 0.f, 0.f});
                if (r > 0) {
                    f32x4 accW = (f32x4){0.f, 0.f, 0.f, 0.f}, accU = (f32x4){0.f, 0.f, 0.f, 0.f};
#pragma unroll
                    for (int c = 0; c < r; ++c) {
                        const s16x4 a_ab = *(const s16x4*)(lds + AB_OFF + (16 * r + m) * TS + 2 * (16 * c + 4 * q));
                        accW = mfma16(a_ab, XbW[c], accW);
                        accU = mfma16(a_ab, XbU[c], accU);
                    }
                    const s16x4 a_tn = *(const s16x4*)(lds + TN_OFF + (r * 16 + m) * BS + 8 * q);
                    XW[r] = mfma16(a_tn, cvt4(accW), XW[r]);
                    vn[r] = mfma16(a_tn, cvt4(accU), vn[r]);
                }
                XbW[r] = cvt4(XW[r]);
                XbU[r] = cvt4(vn[r]);
            }
            const int colpos = 32 * (w >> 1) + pos32(16 * (w & 1) + m);
#pragma unroll
            for (int r = 0; r < 4; ++r)
#pragma unroll
                for (int rr = 0; rr < 4; ++rr)
                    *(unsigned short*)(lds + WP_OFF + (16 * r + 4 * q + rr) * RS + 2 * colpos) = f2bf(-XW[r][rr]);
        }
        lds_barrier();
        bf16x8 Sf[4];
#pragma unroll
        for (int B = 0; B < 4; ++B) Sf[B] = cvt8(S[2 * B], S[2 * B + 1]);
#pragma unroll
        for (int r = 0; r < 4; ++r) {
            bf16x8 wf[4];
#pragma unroll
            for (int B = 0; B < 4; ++B) wf[B] = *(const bf16x8*)(lds + WP_OFF + (16 * r + m) * RS + 64 * B + 16 * q);
#pragma unroll
            for (int B = 0; B < 4; ++B) vn[r] = mfma32(wf[B], Sf[B], vn[r]);
        }
        if (HAS_Q) {
            const int cb = dir ? (nch - 1 - ci) : ci;
            f32x4 o[4];
#pragma unroll
            for (int r = 0; r < 4; ++r) o[r] = (f32x4){0.f, 0.f, 0.f, 0.f};
#pragma unroll
            for (int r = 0; r < 4; ++r) {
                bf16x8 qf[4];
#pragma unroll
                for (int B = 0; B < 4; ++B) qf[B] = *(const bf16x8*)(lds + QP_OFF + (16 * r + m) * RS + 64 * B + 16 * q);
#pragma unroll
                for (int B = 0; B < 4; ++B) o[r] = mfma32(qf[B], Sf[B], o[r]);
            }
            const bf16x8 Vn0 = cvt8(vn[0], vn[1]), Vn1 = cvt8(vn[2], vn[3]);
            bf16x8 af0[4], af1[2];
#pragma unroll
            for (int r = 0; r < 4; ++r) af0[r] = *(const bf16x8*)(lds + AT_OFF + (16 * r + m) * TS + 16 * q);
#pragma unroll
            for (int r = 2; r < 4; ++r) af1[r - 2] = *(const bf16x8*)(lds + AT_OFF + (16 * r + m) * TS + 64 + 16 * q);
#pragma unroll
            for (int r = 0; r < 4; ++r) {
                const f32x4 egv = *(const f32x4*)(gt + 64 + 16 * r + 4 * q);
                o[r] = o[r] * egv;
            }
#pragma unroll
            for (int r = 0; r < 4; ++r) o[r] = mfma32(af0[r], Vn0, o[r]);
#pragma unroll
            for (int r = 2; r < 4; ++r) o[r] = mfma32(af1[r - 2], Vn1, o[r]);
            unsigned char* ot = lds + OT_OFF + w * 2048;
#pragma unroll
            for (int r = 0; r < 4; ++r)
#pragma unroll
                for (int rr = 0; rr < 4; ++rr) *(unsigned short*)(ot + (16 * r + 4 * q + rr) * 32 + 2 * m) = f2bf(o[r][rr]);
            {
                const uint4 o0 = *(const uint4*)(ot + lane * 32), o1 = *(const uint4*)(ot + lane * 32 + 16);
                const size_t tok = (size_t)(tokbase + cb * 64 + (dir ? (63 - lane) : lane));
                bf16_t* op = O + tok * 1024 + head * 128 + 16 * w;
                *(uint4*)op = o0; *(uint4*)(op + 8) = o1;
            }
        }
        {
            f32x4 vk[4];
#pragma unroll
            for (int r = 0; r < 4; ++r) {
                const f32x4 kdv = *(const f32x4*)(gt + 192 + 16 * r + 4 * q);
                vk[r] = vn[r] * kdv;
            }
            const bf16x8 Vk0 = cvt8(vk[0], vk[1]), Vk1 = cvt8(vk[2], vk[3]);
            const float eS = gt[320];
#pragma unroll
            for (int mt = 0; mt < 8; ++mt) S[mt] = S[mt] * eS;
            const int tq = (lane & 15) >> 2, tp = lane & 3;
#pragma unroll
            for (int hh = 0; hh < 2; ++hh) {
                s16x4 kf[4][4];
#pragma unroll
                for (int mi = 0; mi < 4; ++mi) {
                    const int mt = 4 * hh + mi;
                    const unsigned char* kr = lds + KP_OFF + (4 * q + tq) * RS + 2 * (32 * (mt >> 1) + 8 * tp + 4 * (mt & 1));
                    kf[mi][0] = lds_tr_read(kr); kf[mi][1] = lds_tr_read(kr + 16 * RS); kf[mi][2] = lds_tr_read(kr + 32 * RS); kf[mi][3] = lds_tr_read(kr + 48 * RS);
                }
#pragma unroll
                for (int mi = 0; mi < 4; ++mi) {
                    const uint2 a0 = __builtin_bit_cast(uint2, kf[mi][0]), a1 = __builtin_bit_cast(uint2, kf[mi][1]);
                    S[4 * hh + mi] = mfma32(__builtin_bit_cast(bf16x8, make_uint4(a0.x, a0.y, a1.x, a1.y)), Vk0, S[4 * hh + mi]);
                }
#pragma unroll
                for (int mi = 0; mi < 4; ++mi) {
                    const uint2 a2 = __builtin_bit_cast(uint2, kf[mi][2]), a3 = __builtin_bit_cast(uint2, kf[mi][3]);
                    S[4 * hh + mi] = mfma32(__builtin_bit_cast(bf16x8, make_uint4(a2.x, a2.y, a3.x, a3.y)), Vk1, S[4 * hh + mi]);
                }
            }
        }
        lds_barrier();
    }
    if (Sout) {
#pragma unroll
        for (int mt = 0; mt < 8; ++mt)
#pragma unroll
            for (int r = 0; r < 4; ++r) Sout[(size_t)(16 * mt + 4 * q + r) * 128 + 16 * w + m] = S[mt][r];
    }
}

DEVI void cswap_desc(float& a, float& b) { const float hi = fmaxf(a, b), lo = fminf(a, b); a = hi; b = lo; }
DEVI void sort16_desc(float (&v)[16]) {
#pragma unroll
    for (int k = 2; k <= 16; k <<= 1)
#pragma unroll
        for (int j = k >> 1; j > 0; j >>= 1)
#pragma unroll
            for (int i = 0; i < 16; ++i) {
                const int l = i ^ j;
                if (l > i) {
                    if ((i & k) == 0) cswap_desc(v[i], v[l]); else cswap_desc(v[l], v[i]);
                }
            }
}
DEVI void merge16_desc(float (&a)[16], const float (&b)[16]) {
#pragma unroll
    for (int i = 0; i < 16; ++i) a[i] = fmaxf(a[i], b[15 - i]);
#pragma unroll
    for (int j = 8; j > 0; j >>= 1)
#pragma unroll
        for (int i = 0; i < 16; ++i) {
            const int l = i ^ j;
            if (l > i) cswap_desc(a[i], a[l]);
        }
}

DEVI void phase_topk(const Params& p, const bf16_t* QP, int* IDX, float* GV, unsigned char* lds) {
    constexpr int KST = 272;
    const int tid = threadIdx.x, lane = tid & 63, w = tid >> 6;
    const int nb = gridDim.x;
    const int head = blockIdx.x & 7;
    const int bsub = blockIdx.x >> 3, nsub = (nb + 7 - head) / 8;
    const float* sk = p.in[29] + (size_t)head * 2 * 128 * 128;
    __syncthreads();
    for (int i = tid; i < 256 * 32; i += NTHREADS) {
        const int row = i >> 5, d4 = (i & 31) * 4;
        const float4 v = *(const float4*)(sk + row * 128 + d4);
        uint2 o; o.x = pack2(v.x, v.y); o.y = pack2(v.z, v.w);
        *(uint2*)(lds + row * KST + d4 * 2) = o;
    }
    __syncthreads();
    const int hf = lane >> 5, tl = lane & 31;
    for (int tile = bsub * 8 + w; tile < NT / 32; tile += nsub * 8) {
        const int tok = tile * 32 + tl;
        float L[2][16];
#pragma unroll
        for (int jj = 0; jj < 2; ++jj) {
            const bf16_t* qrow = QP + (size_t)tok * 2048 + head * 256 + jj * 128 + 8 * hf;
            uint4 bq[8];
#pragma unroll
            for (int ks = 0; ks < 8; ++ks) bq[ks] = *(const uint4*)(qrow + ks * 16);
            f32x16 acc[4];
#pragma unroll
            for (int kt = 0; kt < 4; ++kt)
#pragma unroll
                for (int r = 0; r < 16; ++r) acc[kt][r] = 0.f;
#pragma unroll
            for (int ks = 0; ks < 8; ++ks) {
#pragma unroll
                for (int kt = 0; kt < 4; ++kt) {
                    const bf16x8 af = *(const bf16x8*)(lds + (jj * 128 + kt * 32 + tl) * KST + (ks * 16 + 8 * hf) * 2);
                    acc[kt] = __builtin_amdgcn_mfma_f32_32x32x16_bf16(af, __builtin_bit_cast(bf16x8, bq[ks]), acc[kt], 0, 0, 0);
                }
                __builtin_amdgcn_sched_barrier(0);
            }
            float g[4][16];
#pragma unroll
            for (int kt = 0; kt < 4; ++kt) {
#pragma unroll
                for (int r = 0; r < 16; ++r) {
                    const unsigned key = (unsigned)(32 * kt + (r & 3) + 8 * (r >> 2)) + 4u * (unsigned)hf;
                    g[kt][r] = __uint_as_float((__float_as_uint(acc[kt][r]) & 0xffffff80u) | key);
                }
                sort16_desc(g[kt]);
            }
            merge16_desc(g[0], g[1]);
            merge16_desc(g[2], g[3]);
            merge16_desc(g[0], g[2]);
            float o[16];
#pragma unroll
            for (int i = 0; i < 16; ++i) o[i] = __shfl_xor(g[0][i], 32);
            merge16_desc(g[0], o);
#pragma unroll
            for (int i = 0; i < 16; ++i) L[jj][i] = g[0][i];
        }
        float R0[16], G1[16], G2[16], G3a = 0.f, G3b = 0.f;
#pragma unroll
        for (int i = 0; i < 16; ++i) R0[i] = L[0][0] + L[1][i];
        {
            int n = 0;
#pragma unroll
            for (int a2 = 1; a2 < 16; ++a2) {
#pragma unroll
                for (int b2 = 0; b2 < 16 / (a2 + 1); ++b2) {
                    const float c = L[0][a2] + L[1][b2];
                    if (n < 16) G1[n] = c; else if (n < 32) G2[n - 16] = c; else if (n == 32) G3a = c; else G3b = c;
                    ++n;
                }
            }
        }
        sort16_desc(G1);
        sort16_desc(G2);
        merge16_desc(R0, G1);
        merge16_desc(R0, G2);
#pragma unroll
        for (int i = 0; i < 16; ++i) { cswap_desc(R0[i], G3a); }
#pragma unroll
        for (int i = 0; i < 16; ++i) { cswap_desc(R0[i], G3b); }
        const float tau = R0[15];
#pragma unroll
        for (int i = 0; i < 16; ++i) { asm volatile("" : "+v"(L[0][i])); asm volatile("" : "+v"(L[1][i])); }
        unsigned* dst = (hf ? (unsigned*)GV : (unsigned*)IDX) + (size_t)tok * 128 + head * 16;
        unsigned* slab = (unsigned*)(lds + 256 * KST + w * 4096) + lane;
        int pos = 0;
#pragma unroll
        for (int a2 = 0; a2 < 16; ++a2) {
            const unsigned i0 = (__float_as_uint(L[0][a2]) & 127u) << 7;
#pragma unroll
            for (int b2 = 0; b2 < 16 / (a2 + 1); ++b2) {
                const float c = L[0][a2] + L[1][b2];
                if (c >= tau && pos < 16) {
                    const unsigned code = i0 | (__float_as_uint(L[1][b2]) & 127u);
                    slab[pos * 64] = hf ? __float_as_uint(c) : code;
                    ++pos;
                }
            }
        }
        {
            unsigned o[16];
#pragma unroll
            for (int i = 0; i < 16; ++i) o[i] = slab[i * 64];
#pragma unroll
            for (int i = 0; i < 4; ++i) *(uint4*)(dst + 4 * i) = make_uint4(o[4 * i], o[4 * i + 1], o[4 * i + 2], o[4 * i + 3]);
        }
    }
}

typedef float float2_ __attribute__((ext_vector_type(2)));
DEVI float wave_sum_u(float v) {
    v = dpp_add<0xB1>(v); v = dpp_add<0x4E>(v); v = dpp_add<0x141>(v); v = dpp_add<0x140>(v);
    int t = __builtin_amdgcn_update_dpp(0, __float_as_int(v), 0x142, 0xA, 0xF, false); v += __int_as_float(t);
    t = __builtin_amdgcn_update_dpp(0, __float_as_int(v), 0x143, 0xC, 0xF, false); v += __int_as_float(t);
    return readlane_f(v, 63);
}

constexpr float PEER_USCALE = 256.f, PEER_VSCALE = 64.f;


DEVI void convert_table_fp8_sliced(const float* src, unsigned char* dst, float scale, int wid, int nwork) {
    const size_t n16 = (size_t)16384 * 1024 / 16;
    for (size_t i = (size_t)wid; i < n16; i += (size_t)nwork) {
        const size_t e = i >> 6; const int d0 = (int)(i & 63) * 16;
        float4 v[4];
#pragma unroll
        for (int j = 0; j < 4; ++j) v[j] = *(const float4*)(src + e * 1024 + d0 + j * 4);
        unsigned o[4];
#pragma unroll
        for (int j = 0; j < 4; ++j) {
            const float x0 = fminf(fmaxf(v[j].x * scale, -448.f), 448.f), x1 = fminf(fmaxf(v[j].y * scale, -448.f), 448.f);
            const float x2 = fminf(fmaxf(v[j].z * scale, -448.f), 448.f), x3 = fminf(fmaxf(v[j].w * scale, -448.f), 448.f);
            int pk = __builtin_amdgcn_cvt_pk_fp8_f32(x0, x1, 0, false);
            pk = __builtin_amdgcn_cvt_pk_fp8_f32(x2, x3, pk, true);
            o[j] = (unsigned)pk;
        }
        *(uint4*)(dst + ((size_t)(d0 >> 7) * 16384 + e) * 128 + (d0 & 127)) = make_uint4(o[0], o[1], o[2], o[3]);
    }
}
DEVI unsigned peer_xcc_id() { return (unsigned)__builtin_amdgcn_s_getreg((3 << 11) | 20) & 0xFu; }
constexpr int PEER_CHUNK_TOK = 512;
template <class F>
DEVI void peer_claim_loop(unsigned* ctr, unsigned char* lds, F body) {
    const unsigned xcc = peer_xcc_id() & 7u;
    volatile unsigned* bc = (volatile unsigned*)(lds + LDS_BYTES - 64);
    for (unsigned s = 0; s < 8; ++s) {
        const unsigned slice = (xcc + s) & 7u;
        for (;;) {
            __syncthreads();
            if (threadIdx.x == 0) bc[0] = __hip_atomic_fetch_add(&ctr[16 * slice], 1u, __ATOMIC_RELAXED, __HIP_MEMORY_SCOPE_AGENT);
            __syncthreads();
            const unsigned c = bc[0];
            if (c >= (unsigned)(NT / PEER_CHUNK_TOK)) break;
            body((int)slice, (int)c);
        }
    }
}
#define PEER_ISSUE(BUF, IDL, IDH, base) do { _Pragma("unroll") for (int r_ = 0; r_ < 16; ++r_) { \
    const int id_ = __shfl(r_ < 8 ? (IDL) : (IDH), (8 * r_ + es) & 63); \
    BUF[r_] = *(const uint4*)((base) + (size_t)id_ * 128); } } while (0)
typedef _Float16 f16x2_t __attribute__((ext_vector_type(2)));
DEVI float dot16_fp8_f16(const uint4& u, const f16x2_t* h) {
    float d = 0.f;
    const float sc = 1.f / PEER_USCALE;
    d = __builtin_amdgcn_fdot2(__builtin_amdgcn_cvt_scalef32_pk_f16_fp8((int)u.x, sc, false), h[0], d, false);
    d = __builtin_amdgcn_fdot2(__builtin_amdgcn_cvt_scalef32_pk_f16_fp8((int)u.x, sc, true), h[1], d, false);
    d = __builtin_amdgcn_fdot2(__builtin_amdgcn_cvt_scalef32_pk_f16_fp8((int)u.y, sc, false), h[2], d, false);
    d = __builtin_amdgcn_fdot2(__builtin_amdgcn_cvt_scalef32_pk_f16_fp8((int)u.y, sc, true), h[3], d, false);
    d = __builtin_amdgcn_fdot2(__builtin_amdgcn_cvt_scalef32_pk_f16_fp8((int)u.z, sc, false), h[4], d, false);
    d = __builtin_amdgcn_fdot2(__builtin_amdgcn_cvt_scalef32_pk_f16_fp8((int)u.z, sc, true), h[5], d, false);
    d = __builtin_amdgcn_fdot2(__builtin_amdgcn_cvt_scalef32_pk_f16_fp8((int)u.w, sc, false), h[6], d, false);
    d = __builtin_amdgcn_fdot2(__builtin_amdgcn_cvt_scalef32_pk_f16_fp8((int)u.w, sc, true), h[7], d, false);
    return d;
}
DEVI f16x2_t bfpair_to_f16(unsigned w) { return __builtin_bit_cast(f16x2_t, __builtin_amdgcn_cvt_pkrtz(__uint_as_float(w << 16), __uint_as_float(w & 0xffff0000u))); }
template <int CTRL>
DEVI float dpp_get(float v) { return __int_as_float(__builtin_amdgcn_update_dpp(0, __float_as_int(v), CTRL, 0xf, 0xf, true)); }
DEVI void phase_peer_u(const bf16_t* HX2, const int* IDX, float* PART, const unsigned char* U8, unsigned* ctr, unsigned char* lds) {
    const int lane = threadIdx.x & 63, w = threadIdx.x >> 6;
    const int es = lane >> 3, part = lane & 7;
    const bool p0 = lane & 1, p1 = lane & 2, p2 = lane & 4;
    const int rbase = (p0 ? 8 : 0) + (p1 ? 4 : 0) + (p2 ? 2 : 0);
    peer_claim_loop(ctr, lds, [=](int x, int chunk) {
        constexpr int NTW = PEER_CHUNK_TOK / 8;
        const unsigned char* ub = U8 + (size_t)x * 16384 * 128;
        const unsigned loff = 16u * (unsigned)part;
        const int t0 = chunk * PEER_CHUNK_TOK + w * NTW;
        const bf16_t* hb = HX2 + 128 * x + 16 * part;
        uint4 u[16];
        int ilA, ihA, ilB, ihB; uint4 hA0, hA1, hB0, hB1;
#define PU_META(T, IL, IH, H0, H1) do { const int tk_ = t0 + ((T) < NTW ? (T) : NTW - 1); \
        IL = IDX[(size_t)tk_ * 128 + lane] & 16383; IH = IDX[(size_t)tk_ * 128 + 64 + lane] & 16383; \
        H0 = *(const uint4*)(hb + (size_t)tk_ * 1024); H1 = *(const uint4*)(hb + (size_t)tk_ * 1024 + 8); } while (0)
        PU_META(0, ilA, ihA, hA0, hA1);
#pragma unroll
        for (int r = 0; r < 16; ++r) u[r] = *(const uint4*)(ub + ((unsigned)__shfl(r < 8 ? ilA : ihA, (16 * (r >> 1) + 2 * es + (r & 1)) & 63) * 128u + loff));
        PU_META(1, ilB, ihB, hB0, hB1);
#pragma unroll 1
        for (int i = 0; i < NTW; ++i) {
            f16x2_t h[8];
            h[0] = bfpair_to_f16(hA0.x); h[1] = bfpair_to_f16(hA0.y); h[2] = bfpair_to_f16(hA0.z); h[3] = bfpair_to_f16(hA0.w);
            h[4] = bfpair_to_f16(hA1.x); h[5] = bfpair_to_f16(hA1.y); h[6] = bfpair_to_f16(hA1.z); h[7] = bfpair_to_f16(hA1.w);
            float d[16];
#pragma unroll
            for (int r = 0; r < 16; ++r) {
                d[r] = dot16_fp8_f16(u[r], h);
                const unsigned id = (unsigned)__shfl(r < 8 ? ilB : ihB, (16 * (r >> 1) + 2 * es + (r & 1)) & 63);
                u[r] = *(const uint4*)(ub + (id * 128u + loff));
                if ((r & 1) == 1) __builtin_amdgcn_sched_barrier(0);
            }
            float k8[8], k4[4], k2[2];
#pragma unroll
            for (int j = 0; j < 8; ++j) { const float snd = p0 ? d[j] : d[j + 8]; const float kp = p0 ? d[j + 8] : d[j]; k8[j] = kp + dpp_get<0xB1>(snd); }
#pragma unroll
            for (int j = 0; j < 4; ++j) { const float snd = p1 ? k8[j] : k8[j + 4]; const float kp = p1 ? k8[j + 4] : k8[j]; k4[j] = kp + dpp_get<0x4E>(snd); }
#pragma unroll
            for (int j = 0; j < 2; ++j) { const float snd = p2 ? k4[j] : k4[j + 2]; const float kp = p2 ? k4[j + 2] : k4[j]; k2[j] = kp + __shfl_xor(snd, 4); }
            *(float2*)(PART + ((size_t)(t0 + i) * 8 + x) * 128 + 8 * rbase + 2 * es) = make_float2(k2[0], k2[1]);
            ilA = ilB; ihA = ihB; hA0 = hB0; hA1 = hB1;
            PU_META(i + 2, ilB, ihB, hB0, hB1);
        }
#undef PU_META
    });
}
DEVI void phase_peer_w(const float* PART, float* GW) {
    const int lane = threadIdx.x & 63, w = threadIdx.x >> 6;
    for (int tok = blockIdx.x * 8 + w; tok < NT; tok += gridDim.x * 8) {
        float d0 = 0.f, d1 = 0.f;
#pragma unroll
        for (int x = 0; x < 8; ++x) { d0 += PART[((size_t)tok * 8 + x) * 128 + lane]; d1 += PART[((size_t)tok * 8 + x) * 128 + 64 + lane]; }
        float g0 = GW[(size_t)tok * 128 + lane], g1 = GW[(size_t)tok * 128 + 64 + lane];
        float m0 = g0, m1 = g1;
#pragma unroll
        for (int m = 1; m <= 8; m <<= 1) { m0 = fmaxf(m0, __shfl_xor(m0, m)); m1 = fmaxf(m1, __shfl_xor(m1, m)); }
        g0 = __expf(g0 - m0); g1 = __expf(g1 - m1);
        float s0 = g0, s1 = g1;
#pragma unroll
        for (int m = 1; m <= 8; m <<= 1) { s0 += __shfl_xor(s0, m); s1 += __shfl_xor(s1, m); }
        GW[(size_t)tok * 128 + lane] = gelu_(d0) * g0 / s0;
        GW[(size_t)tok * 128 + 64 + lane] = gelu_(d1) * g1 / s1;
    }
}
DEVI void axpy16_fp8_f16(f16x2_t* acc, const uint4& v, f16x2_t w2) {
    const float sc = 1.f / PEER_VSCALE;
    acc[0] = __builtin_amdgcn_cvt_scalef32_pk_f16_fp8((int)v.x, sc, false) * w2 + acc[0];
    acc[1] = __builtin_amdgcn_cvt_scalef32_pk_f16_fp8((int)v.x, sc, true) * w2 + acc[1];
    acc[2] = __builtin_amdgcn_cvt_scalef32_pk_f16_fp8((int)v.y, sc, false) * w2 + acc[2];
    acc[3] = __builtin_amdgcn_cvt_scalef32_pk_f16_fp8((int)v.y, sc, true) * w2 + acc[3];
    acc[4] = __builtin_amdgcn_cvt_scalef32_pk_f16_fp8((int)v.z, sc, false) * w2 + acc[4];
    acc[5] = __builtin_amdgcn_cvt_scalef32_pk_f16_fp8((int)v.z, sc, true) * w2 + acc[5];
    acc[6] = __builtin_amdgcn_cvt_scalef32_pk_f16_fp8((int)v.w, sc, false) * w2 + acc[6];
    acc[7] = __builtin_amdgcn_cvt_scalef32_pk_f16_fp8((int)v.w, sc, true) * w2 + acc[7];
}
DEVI f16x2_t shfl_xor_h2(f16x2_t v, int m) { return __builtin_bit_cast(f16x2_t, __shfl_xor(__builtin_bit_cast(int, v), m)); }
DEVI void phase_peer_v(const int* IDX, const float* GW, bf16_t* PE, const unsigned char* V8, unsigned* ctr, unsigned char* lds) {
    const int lane = threadIdx.x & 63, w = threadIdx.x >> 6;
    const int es = lane >> 3, part = lane & 7;
    const bool b3 = lane & 8, b4 = lane & 16, b5 = lane & 32;
    const int o = (b3 ? 8 : 0) + (b4 ? 4 : 0) + (b5 ? 2 : 0);
    peer_claim_loop(ctr, lds, [=](int x, int chunk) {
        constexpr int NTW = PEER_CHUNK_TOK / 8;
        const unsigned char* vb = V8 + (size_t)x * 16384 * 128;
        const unsigned loff = 16u * (unsigned)part;
        const int t0 = chunk * PEER_CHUNK_TOK + w * NTW;
        uint4 v[8];
        int il, ih, iln; float wl, wh;
        il = IDX[(size_t)t0 * 128 + lane] & 16383; ih = IDX[(size_t)t0 * 128 + 64 + lane] & 16383;
        wl = GW[(size_t)t0 * 128 + lane]; wh = GW[(size_t)t0 * 128 + 64 + lane];
#pragma unroll
        for (int r = 0; r < 8; ++r) v[r] = *(const uint4*)(vb + ((unsigned)__shfl(il, 8 * r + es) * 128u + loff));
#pragma unroll 1
        for (int i = 0; i < NTW; ++i) {
            const int tn = t0 + (i + 1 < NTW ? i + 1 : i);
            iln = IDX[(size_t)tn * 128 + lane] & 16383;
            f16x2_t acc[8];
#pragma unroll
            for (int j = 0; j < 8; ++j) acc[j] = (f16x2_t){(_Float16)0.f, (_Float16)0.f};
#pragma unroll
            for (int r = 0; r < 8; ++r) {
                const float wr = __shfl(wl, 8 * r + es);
                axpy16_fp8_f16(acc, v[r], __builtin_bit_cast(f16x2_t, __builtin_amdgcn_cvt_pkrtz(wr, wr)));
                v[r] = *(const uint4*)(vb + ((unsigned)__shfl(ih, 8 * r + es) * 128u + loff));
            }
            const float wh_c = wh;
            const int ihn = IDX[(size_t)tn * 128 + 64 + lane] & 16383;
            wl = GW[(size_t)tn * 128 + lane]; wh = GW[(size_t)tn * 128 + 64 + lane];
#pragma unroll
            for (int r = 0; r < 8; ++r) {
                const float wr = __shfl(wh_c, 8 * r + es);
                axpy16_fp8_f16(acc, v[r], __builtin_bit_cast(f16x2_t, __builtin_amdgcn_cvt_pkrtz(wr, wr)));
                v[r] = *(const uint4*)(vb + ((unsigned)__shfl(iln, 8 * r + es) * 128u + loff));
            }
            il = iln; ih = ihn;
            f16x2_t k4[4], k2[2], k1;
#pragma unroll
            for (int j = 0; j < 4; ++j) { const f16x2_t snd = b3 ? acc[j] : acc[j + 4]; const f16x2_t kp = b3 ? acc[j + 4] : acc[j]; k4[j] = kp + shfl_xor_h2(snd, 8); }
#pragma unroll
            for (int j = 0; j < 2; ++j) { const f16x2_t snd = b4 ? k4[j] : k4[j + 2]; const f16x2_t kp = b4 ? k4[j + 2] : k4[j]; k2[j] = kp + shfl_xor_h2(snd, 16); }
            { const f16x2_t snd = b5 ? k2[0] : k2[1]; const f16x2_t kp = b5 ? k2[1] : k2[0]; k1 = kp + shfl_xor_h2(snd, 32); }
            *(unsigned*)(PE + (size_t)(t0 + i) * 1024 + 128 * x + 16 * part + o) = pack2((float)k1.x, (float)k1.y);
        }
    });
}
DEVI float4 bf4_to_f4(const uint2& t) { return make_float4(__uint_as_float(t.x << 16), __uint_as_float(t.x & 0xffff0000u), __uint_as_float(t.y << 16), __uint_as_float(t.y & 0xffff0000u)); }
DEVI void phase_peer_final(const Params& p, const bf16_t* X1b, const bf16_t* PE, const float* MOD, float* OUT) {
    const int lane = threadIdx.x & 63, w = threadIdx.x >> 6;
    const float* nw = p.in[9];
    for (int run = blockIdx.x * 8 + w; run < NT / 16; run += gridDim.x * 8) {
        const int row0 = run * 16;
        const float* gate2 = MOD + (size_t)(row0 / TL) * 6144 + 5 * 1024;
        float4 c[4];
#pragma unroll
        for (int i = 0; i < 4; ++i) {
            const int d = lane * 4 + 256 * i;
            const float4 g = *(const float4*)(gate2 + d), nwv = *(const float4*)(nw + d);
            c[i] = make_float4(g.x * nwv.x, g.y * nwv.y, g.z * nwv.z, g.w * nwv.w);
        }
        uint2 na[4], nx[4];
#pragma unroll
        for (int i = 0; i < 4; ++i) {
            na[i] = *(const uint2*)(PE + (size_t)row0 * 1024 + lane * 4 + 256 * i);
            nx[i] = *(const uint2*)(X1b + (size_t)row0 * 1024 + lane * 4 + 256 * i);
        }
#pragma unroll 1
        for (int rr = 0; rr < 16; ++rr) {
            const int tok = row0 + rr;
            float4 a[4], x1[4]; float ss = 0.f;
#pragma unroll
            for (int i = 0; i < 4; ++i) {
                a[i] = bf4_to_f4(na[i]); x1[i] = bf4_to_f4(nx[i]);
                ss += a[i].x * a[i].x + a[i].y * a[i].y + a[i].z * a[i].z + a[i].w * a[i].w;
            }
            if (rr + 1 < 16) {
#pragma unroll
                for (int i = 0; i < 4; ++i) {
                    na[i] = *(const uint2*)(PE + (size_t)(tok + 1) * 1024 + lane * 4 + 256 * i);
                    nx[i] = *(const uint2*)(X1b + (size_t)(tok + 1) * 1024 + lane * 4 + 256 * i);
                }
            }
            ss = wave_sum_u(ss);
            const float r = rsqrtf(ss * (1.f / 1024.f) + 1e-6f);
#pragma unroll
            for (int i = 0; i < 4; ++i) {
                const int d = lane * 4 + 256 * i;
                float4 o;
                o.x = x1[i].x + c[i].x * a[i].x * r; o.y = x1[i].y + c[i].y * a[i].y * r;
                o.z = x1[i].z + c[i].z * a[i].z * r; o.w = x1[i].w + c[i].w * a[i].w * r;
                *(float4*)(OUT + (size_t)tok * 1024 + d) = o;
            }
        }
    }
}

template <bool NORM>
DEVI void conv_wave(const bf16_t* src, int ld_src, int tok0, bool lo_ok, bool hi_ok, int scol,
                    bf16_t* dst, int ld_dst, int dcol, const float* cw, int wch, float oscale) {
    const int lane = threadIdx.x & 63;
    unsigned x[68];
    const bf16_t* sp = src + (size_t)tok0 * ld_src + scol + 2 * lane;
#pragma unroll
    for (int t = 0; t < 64; ++t) x[t + 2] = *(const unsigned*)(sp + (size_t)t * ld_src);
    x[0] = lo_ok ? *(const unsigned*)(sp - 2 * (size_t)ld_src) : 0u;
    x[1] = lo_ok ? *(const unsigned*)(sp - (size_t)ld_src) : 0u;
    x[66] = hi_ok ? *(const unsigned*)(sp + 64 * (size_t)ld_src) : 0u;
    x[67] = hi_ok ? *(const unsigned*)(sp + 65 * (size_t)ld_src) : 0u;
    float w0[5], w1[5];
#pragma unroll
    for (int j = 0; j < 5; ++j) { w0[j] = cw[j * 3072 + wch + 2 * lane]; w1[j] = cw[j * 3072 + wch + 2 * lane + 1]; }
    bf16_t* dp = dst + (size_t)tok0 * ld_dst + dcol + 2 * lane;
#pragma unroll
    for (int t = 0; t < 64; ++t) {
        float a0 = 0.f, a1 = 0.f;
#pragma unroll
        for (int j = 0; j < 5; ++j) {
            a0 += w0[j] * __uint_as_float(x[t + j] << 16);
            a1 += w1[j] * __uint_as_float(x[t + j] & 0xffff0000u);
        }
        a0 = silu_(a0); a1 = silu_(a1);
        float sc = oscale;
        if (NORM) sc = rsqrtf(wave_sum_u(a0 * a0 + a1 * a1) + 1e-6f) * oscale;
        *(unsigned*)(dp + (size_t)t * ld_dst) = pack2(a0 * sc, a1 * sc);
    }
}

namespace pg8 {
#define PG8_LAS __attribute__((address_space(3)))
typedef unsigned short bf16_t;
typedef short bf16x8 __attribute__((ext_vector_type(8)));
typedef float f32x4 __attribute__((ext_vector_type(4)));
typedef unsigned u32x4 __attribute__((ext_vector_type(4)));
constexpr int BM = 256, BK = 64, HALF = 128, HTB = HALF * BK * 2  , STAGE_BYTES = 8 * HTB, NXCD = 8, WGM = 8;

__host__ __device__ __forceinline__ int lds_byte(int r, int c) { const int st = (r >> 4) * 2 + (c >> 5), rr = r & 15, cc = c & 31, ob = rr * 64 + cc * 2; return st * 1024 + (ob ^ (((ob >> 9) & 1) << 5)); }
__host__ __device__ __forceinline__ void stage_rc(int b, int& R, int& C) { const int st = b / 1024, sb = b % 1024, swz = sb ^ (((sb >> 9) & 1) << 5); R = (st >> 1) * 16 + swz / 64; C = (st & 1) * 32 + (swz % 64) / 2; }
__host__ __device__ __forceinline__ int perm32(int rho) { const int n = rho >> 4, i = rho & 15; return 8 * (i >> 2) + 4 * n + (i & 3); }

struct Unit { int pm, pn; };
struct Gemm { const bf16_t* A; const bf16_t* Bt; int M, N, K; };

struct StaticOrder {
    int nM, nN, nwg, G, c;
    __host__ __device__ void init(int M, int N, int G_, int c_) { nM = M / BM; nN = N / BM; nwg = nM * nN; G = G_; c = c_; }
    __host__ __device__ bool next(int i, Unit& u) const {
        const long L = (long)i * G + c; if (L >= nwg) return false;
        int wgid = (int)L; { const int q = nwg / NXCD, r = nwg % NXCD, xcd = wgid % NXCD, off = wgid / NXCD; wgid = (xcd < r ? xcd * (q + 1) : r * (q + 1) + (xcd - r) * q) + off; }
        const int nig = WGM * nN, gid = wgid / nig, fm = gid * WGM, gsz = (nM - fm) < WGM ? (nM - fm) : WGM;
        u.pm = fm + ((wgid % nig) % gsz); u.pn = (wgid % nig) / gsz; return true;
    }
    __device__ __forceinline__ void a_ready(const Unit&) const {}
    __device__ __forceinline__ void done(const Unit&) const {}
};
__device__ __forceinline__ unsigned cvt_pk_bf16(float lo, float hi) { unsigned r; asm volatile("v_cvt_pk_bf16_f32 %0, %1, %2" : "=v"(r) : "v"(lo), "v"(hi)); return r; }
template <class Epi, class Sched, bool ALIGN_EPI = false, bool SP2 = false>
__device__ __forceinline__ void gemm_phase(PG8_LAS unsigned char* lds, const Gemm g, const Sched& S, const Epi& E) {
    const int tid = threadIdx.x, wid = __builtin_amdgcn_readfirstlane(tid >> 6), lane = tid & 63, wr = wid >> 2, wc = wid & 3, fr = lane & 15, fq = lane >> 4;
    const int K = g.K, nt = K / BK;
    unsigned voffA[2], voffB[2];
#pragma unroll
    for (int i = 0; i < 2; ++i) { int R, C; stage_rc(tid * 16 + i * 8192, R, C); const int Rb = Epi::PERM ? ((R & ~31) + perm32(R & 31)) : R;
        voffA[i] = (unsigned)(R * K + C) * 2u; voffB[i] = (unsigned)(Rb * K + C) * 2u; }
    const size_t kstep = (size_t)(BK * 2);
    const size_t hstep = (size_t)HALF * K * 2;
    const size_t tstep = 2 * hstep;
    const unsigned ldsw = (unsigned)wid * 1024u;
    const int aoff = lds_byte(wr * 64 + fr, fq * 8), boff = lds_byte(wc * 32 + fr, fq * 8);
#define PG8_SA(b, h) (((b) * 2 + (h)) * HTB)
#define PG8_SB(b, h) ((4 + (b) * 2 + (h)) * HTB)
#define PG8_STAGE(bufoff, gbase, voff) do { _Pragma("unroll") for (int _i = 0; _i < 2; ++_i) \
        __builtin_amdgcn_global_load_lds((const unsigned*)((const char*)(gbase) + (voff)[_i]), (PG8_LAS unsigned*)(lds + (bufoff) + ldsw + _i * 8192), 16, 0, 0); } while (0)
#define PG8_LDA(dst, b, h) do { _Pragma("unroll") for (int m = 0; m < 4; ++m) _Pragma("unroll") for (int k = 0; k < 2; ++k) dst[m][k] = *(const PG8_LAS bf16x8*)(lds + PG8_SA(b, h) + aoff + m * 2048 + k * 1024); } while (0)
#define PG8_LDB(dst, b, h) do { _Pragma("unroll") for (int n = 0; n < 2; ++n) _Pragma("unroll") for (int k = 0; k < 2; ++k) dst[n][k] = *(const PG8_LAS bf16x8*)(lds + PG8_SB(b, h) + boff + n * 2048 + k * 1024); } while (0)
#define PG8_MMA(ai, bj, At, Bt) do { __builtin_amdgcn_s_setprio(1); _Pragma("unroll") for (int m = 0; m < 4; ++m) _Pragma("unroll") for (int n = 0; n < 2; ++n) _Pragma("unroll") for (int k = 0; k < 2; ++k) \
        acc[ai][bj][m][n] = __builtin_amdgcn_mfma_f32_16x16x32_bf16(Bt[n][k], At[m][k], acc[ai][bj][m][n], 0, 0, 0); __builtin_amdgcn_s_setprio(0); } while (0)
#define PG8_WAIT_V(n) asm volatile("s_waitcnt vmcnt(" #n ")" ::: "memory")
#define PG8_WAIT_L(n) asm volatile("s_waitcnt lgkmcnt(" #n ")" ::: "memory")
#define PG8_BAR __builtin_amdgcn_s_barrier()
#define PG8_SCHED __builtin_amdgcn_sched_barrier(0)
    Unit cur, nxt; int ui = 0;
    if (!S.next(0, cur)) return;
    f32x4 acc[2][2][4][2];
#pragma unroll
    for (int a = 0; a < 2; ++a)
#pragma unroll
        for (int b = 0; b < 2; ++b)
#pragma unroll
            for (int m = 0; m < 4; ++m)
#pragma unroll
                for (int n = 0; n < 2; ++n) acc[a][b][m][n] = (f32x4){0.f, 0.f, 0.f, 0.f};
    bf16x8 At[4][2], B0[2][2], B1[2][2];
    const char* cA = (const char*)g.A + (size_t)cur.pm * tstep; const char* cB = (const char*)g.Bt + (size_t)cur.pn * tstep;
    S.a_ready(cur);
    if constexpr (SP2) {
        PG8_STAGE(PG8_SB(0, 0), cB, voffB); PG8_STAGE(PG8_SB(0, 1), cB + hstep, voffB); PG8_STAGE(PG8_SA(0, 0), cA, voffA); PG8_STAGE(PG8_SA(0, 1), cA + hstep, voffA);
        if (wr == 1) PG8_BAR;
        PG8_WAIT_V(2); PG8_BAR;
        PG8_STAGE(PG8_SB(1, 0), cB + kstep, voffB); PG8_STAGE(PG8_SA(1, 0), cA + kstep, voffA); PG8_STAGE(PG8_SB(1, 1), cB + hstep + kstep, voffB);
        PG8_WAIT_V(6); PG8_BAR;
    } else {
        PG8_STAGE(PG8_SB(0, 0), cB, voffB); PG8_STAGE(PG8_SA(0, 0), cA, voffA); PG8_STAGE(PG8_SB(0, 1), cB + hstep, voffB); PG8_STAGE(PG8_SA(0, 1), cA + hstep, voffA);
        if (wr == 1) PG8_BAR;
        PG8_WAIT_V(4); PG8_BAR;
        PG8_STAGE(PG8_SB(1, 0), cB + kstep, voffB); PG8_STAGE(PG8_SA(1, 0), cA + kstep, voffA); PG8_STAGE(PG8_SB(1, 1), cB + hstep + kstep, voffB);
        PG8_WAIT_V(6); PG8_BAR;
    }
    for (;;) {
        const bool has_next = S.next(ui + 1, nxt);
        const char* nA = has_next ? (const char*)g.A + (size_t)nxt.pm * tstep : cA; const char* nB = has_next ? (const char*)g.Bt + (size_t)nxt.pn * tstep : cB;
        for (int t = 0; t < nt; t += 2) {
            const bool last = (t == nt - 2);
            const char* a1 = cA + (size_t)(t + 1) * kstep;
            const char* a2 = last ? nA : cA + (size_t)(t + 2) * kstep; const char* b2 = last ? nB : cB + (size_t)(t + 2) * kstep;
            const char* a3 = a2 + kstep; const char* b3 = b2 + kstep;
            if (last && has_next) S.a_ready(nxt);
            if constexpr (SP2) {
            PG8_LDB(B0, 0, 0); PG8_LDB(B1, 0, 1); PG8_SCHED; PG8_LDA(At, 0, 0); PG8_STAGE(PG8_SA(1, 1), a1 + hstep, voffA);
            PG8_WAIT_V(8); PG8_WAIT_L(0); PG8_BAR; PG8_MMA(0, 0, At, B0); PG8_MMA(0, 1, At, B1); PG8_BAR; PG8_SCHED;
            PG8_LDA(At, 0, 1); PG8_STAGE(PG8_SB(0, 0), b2, voffB); PG8_STAGE(PG8_SB(0, 1), b2 + hstep, voffB); PG8_STAGE(PG8_SA(0, 0), a2, voffA);
            PG8_WAIT_V(8); PG8_WAIT_L(0); PG8_BAR; PG8_MMA(1, 0, At, B0); PG8_MMA(1, 1, At, B1); PG8_BAR; PG8_SCHED;
            PG8_LDB(B0, 1, 0); PG8_LDB(B1, 1, 1); PG8_SCHED; PG8_LDA(At, 1, 0); PG8_STAGE(PG8_SA(0, 1), a2 + hstep, voffA);
            PG8_WAIT_V(8); PG8_WAIT_L(0); PG8_BAR; PG8_MMA(0, 0, At, B0); PG8_MMA(0, 1, At, B1); PG8_BAR; PG8_SCHED;
            PG8_LDA(At, 1, 1); PG8_STAGE(PG8_SB(1, 0), b3, voffB); PG8_STAGE(PG8_SB(1, 1), b3 + hstep, voffB); PG8_STAGE(PG8_SA(1, 0), a3, voffA);
            PG8_WAIT_V(8); PG8_WAIT_L(0); PG8_BAR; PG8_MMA(1, 0, At, B0); PG8_MMA(1, 1, At, B1); PG8_BAR; PG8_SCHED;
            } else {
            PG8_LDB(B0, 0, 0); PG8_SCHED; PG8_LDA(At, 0, 0); PG8_STAGE(PG8_SA(1, 1), a1 + hstep, voffA);
            PG8_WAIT_L(8); PG8_BAR; PG8_WAIT_L(0); PG8_MMA(0, 0, At, B0); PG8_BAR; PG8_SCHED;
            PG8_LDB(B1, 0, 1); PG8_STAGE(PG8_SB(0, 0), b2, voffB);
            PG8_BAR; PG8_WAIT_L(0); PG8_MMA(0, 1, At, B1); PG8_BAR;
            PG8_LDA(At, 0, 1); PG8_STAGE(PG8_SA(0, 0), a2, voffA);
            PG8_BAR; PG8_WAIT_L(0); PG8_MMA(1, 0, At, B0); PG8_BAR; PG8_SCHED;
            PG8_STAGE(PG8_SB(0, 1), b2 + hstep, voffB);
            PG8_WAIT_V(6); PG8_BAR; PG8_MMA(1, 1, At, B1); PG8_BAR;
            PG8_LDB(B0, 1, 0); PG8_SCHED; PG8_LDA(At, 1, 0); PG8_STAGE(PG8_SA(0, 1), a2 + hstep, voffA);
            PG8_WAIT_L(8); PG8_BAR; PG8_WAIT_L(0); PG8_MMA(0, 0, At, B0); PG8_BAR; PG8_SCHED;
            PG8_LDB(B1, 1, 1); PG8_STAGE(PG8_SB(1, 0), b3, voffB);
            PG8_BAR; PG8_WAIT_L(0); PG8_MMA(0, 1, At, B1); PG8_BAR;
            PG8_LDA(At, 1, 1); PG8_STAGE(PG8_SA(1, 0), a3, voffA);
            PG8_BAR; PG8_WAIT_L(0); PG8_MMA(1, 0, At, B0); PG8_BAR; PG8_SCHED;
            PG8_STAGE(PG8_SB(1, 1), b3 + hstep, voffB);
            PG8_WAIT_V(6); PG8_BAR; PG8_MMA(1, 1, At, B1); PG8_BAR;
            }
        }
        if constexpr (ALIGN_EPI) { if (wr == 0) PG8_BAR; }
        if constexpr (!Epi::AFTER_DRAIN) { E(acc, cur, wr, wc, fr, fq); S.done(cur); }
        if (!has_next) break;
#pragma unroll
        for (int a = 0; a < 2; ++a)
#pragma unroll
            for (int b = 0; b < 2; ++b)
#pragma unroll
                for (int m = 0; m < 4; ++m)
#pragma unroll
                    for (int n = 0; n < 2; ++n) acc[a][b][m][n] = (f32x4){0.f, 0.f, 0.f, 0.f};
        cur = nxt; cA = nA; cB = nB; ++ui;
        if constexpr (ALIGN_EPI) { if (wr == 1) PG8_BAR; }
    }
    PG8_WAIT_V(0);
    if constexpr (!ALIGN_EPI) { if (wr == 0) PG8_BAR; }
    PG8_BAR;
    if constexpr (Epi::AFTER_DRAIN) { E.fused(acc, cur, wr, wc, fr, fq, lds, wid, lane); S.done(cur); }
#undef PG8_SA
#undef PG8_SB
#undef PG8_STAGE
#undef PG8_LDA
#undef PG8_LDB
#undef PG8_MMA
#undef PG8_WAIT_V
#undef PG8_WAIT_L
#undef PG8_BAR
#undef PG8_SCHED
}
__device__ __forceinline__ void unpack8(const u32x4& w, float* f) {
    f[0] = __uint_as_float(w.x << 16); f[1] = __uint_as_float(w.x & 0xffff0000u); f[2] = __uint_as_float(w.y << 16); f[3] = __uint_as_float(w.y & 0xffff0000u);
    f[4] = __uint_as_float(w.z << 16); f[5] = __uint_as_float(w.z & 0xffff0000u); f[6] = __uint_as_float(w.w << 16); f[7] = __uint_as_float(w.w & 0xffff0000u);
}
__device__ __forceinline__ float sigm(float x) { return 1.f / (1.f + __expf(-x)); }
struct EpiStore16 {
    static constexpr bool PERM = true, AFTER_DRAIN = false;
    bf16_t* O; int ldc;
    __device__ __forceinline__ void operator()(const f32x4 (&acc)[2][2][4][2], const Unit& u, int wr, int wc, int fr, int fq) const {
        const int row0 = u.pm * BM + wr * 64 + fr, col0 = u.pn * BM + wc * 32 + 8 * fq;
#pragma unroll
        for (int ai = 0; ai < 2; ++ai)
#pragma unroll
            for (int m = 0; m < 4; ++m) { bf16_t* rowp = O + (size_t)(row0 + ai * HALF + m * 16) * ldc + col0;
#pragma unroll
                for (int bj = 0; bj < 2; ++bj) { const f32x4 v0 = acc[ai][bj][m][0], v1 = acc[ai][bj][m][1];
                    u32x4 w; w.x = cvt_pk_bf16(v0[0], v0[1]); w.y = cvt_pk_bf16(v0[2], v0[3]); w.z = cvt_pk_bf16(v1[0], v1[1]); w.w = cvt_pk_bf16(v1[2], v1[3]);
                    *(u32x4*)(rowp + bj * HALF) = w; } }
    }
};
template <int MODE> struct EpiGate {
    static constexpr bool PERM = true, AFTER_DRAIN = false;
    bf16_t* O; int ldc; const bf16_t* G; int ldg; int goff; const float* bias;
    __device__ __forceinline__ void operator()(const f32x4 (&acc)[2][2][4][2], const Unit& u, int wr, int wc, int fr, int fq) const {
        const int row0 = u.pm * BM + wr * 64 + fr, col0 = u.pn * BM + wc * 32 + 8 * fq;
#pragma unroll
        for (int ai = 0; ai < 2; ++ai)
#pragma unroll
            for (int m = 0; m < 4; ++m) { const size_t row = (size_t)(row0 + ai * HALF + m * 16);
#pragma unroll
                for (int bj = 0; bj < 2; ++bj) { const int col = col0 + bj * HALF; const f32x4 v0 = acc[ai][bj][m][0], v1 = acc[ai][bj][m][1];
                    float a[8] = {v0[0], v0[1], v0[2], v0[3], v1[0], v1[1], v1[2], v1[3]}; float g[8], o[8];
                    unpack8(*(const u32x4*)(G + row * ldg + goff + col), g);
                    if (MODE == 0) {
                        const f32x4 b0 = *(const f32x4*)(bias + col), b1 = *(const f32x4*)(bias + col + 4);
                        const float bb[8] = {b0[0], b0[1], b0[2], b0[3], b1[0], b1[1], b1[2], b1[3]};
#pragma unroll
                        for (int j = 0; j < 8; ++j) o[j] = g[j] * sigm(a[j] + bb[j]);
                    } else if (MODE == 1) {
#pragma unroll
                        for (int j = 0; j < 8; ++j) o[j] = sigm(g[j]) * a[j];
                    } else {
                        float pv[8]; unpack8(*(const u32x4*)(O + row * ldc + col), pv);
#pragma unroll
                        for (int j = 0; j < 8; ++j) o[j] = pv[j] + sigm(g[j]) * a[j];
                    }
                    u32x4 w; w.x = cvt_pk_bf16(o[0], o[1]); w.y = cvt_pk_bf16(o[2], o[3]); w.z = cvt_pk_bf16(o[4], o[5]); w.w = cvt_pk_bf16(o[6], o[7]);
                    *(u32x4*)(O + row * ldc + col) = w; }
                asm volatile("" ::: "memory"); }
    }
};
struct EpiStoreF32 {
    static constexpr bool PERM = false, AFTER_DRAIN = false;
    float* C; int ldc;
    __device__ __forceinline__ void operator()(const f32x4 (&acc)[2][2][4][2], const Unit& u, int wr, int wc, int fr, int fq) const {
        const int row0 = u.pm * BM + wr * 64 + fr, col0 = u.pn * BM + wc * 32 + 4 * fq;
#pragma unroll
        for (int ai = 0; ai < 2; ++ai)
#pragma unroll
            for (int m = 0; m < 4; ++m) { float* rowp = C + (size_t)(row0 + ai * HALF + m * 16) * ldc + col0;
#pragma unroll
                for (int bj = 0; bj < 2; ++bj)
#pragma unroll
                    for (int n = 0; n < 2; ++n) *(f32x4*)(rowp + bj * HALF + n * 16) = acc[ai][bj][m][n]; }
    }
};
}

#define XB_TMO      128
#define XB_XCNT(j)  (256  + 64 * (j))
#define XB_XSUB(j)  (1280 + 64 * (j))
#define XB_XGEN(j)  (2304 + 64 * (j))
#define XB_TOP      3328
#define XB_TOPGEN   3392
#define XCD_BAR_WORDS 3456
#define XB_SPIN_CAP (1u << 22)
#define LAS __attribute__((address_space(3)))
DEVI unsigned xb_ld(unsigned* p)              { return __hip_atomic_load(p, __ATOMIC_RELAXED, __HIP_MEMORY_SCOPE_AGENT); }
DEVI unsigned xb_add(unsigned* p, unsigned v) { return __hip_atomic_fetch_add(p, v, __ATOMIC_RELAXED, __HIP_MEMORY_SCOPE_AGENT); }
DEVI unsigned xb_xcc_id() { return (unsigned)__builtin_amdgcn_s_getreg((3 << 11) | 20) & 0xFu; }
#define XB_SPIN(cond, bar) do { unsigned _sp = 0; while (cond) { __builtin_amdgcn_s_sleep(1); \
    if ((++_sp & 255u) == 0u) { if (xb_ld(&(bar)[XB_TMO])) break; if (_sp > XB_SPIN_CAP) { atomicAdd(&(bar)[XB_TMO], 1u); break; } } } } while (0)
struct XcdBarrier { unsigned* bar; unsigned x; volatile LAS unsigned* st; };
DEVI XcdBarrier xcd_barrier_post(unsigned* bar, volatile LAS unsigned* st) {
    XcdBarrier b; b.bar = bar; b.x = xb_xcc_id(); b.st = st;
    if (threadIdx.x == 0) (void)xb_add(&bar[XB_XCNT(b.x)], 1u);
    return b;
}
DEVI void xcd_barrier_complete(unsigned* bar, unsigned x, unsigned& nloc, unsigned& nx) {
    const unsigned G = gridDim.x * gridDim.y * gridDim.z;
    unsigned sum, cnt, mine, sp = 0u;
    for (;;) {
        sum = 0u; cnt = 0u; mine = 0u;
#pragma unroll
        for (unsigned j = 0; j < 16; ++j) { const unsigned c = xb_ld(&bar[XB_XCNT(j)]); sum += c; cnt += (c > 0u) ? 1u : 0u; mine = (j == x) ? c : mine; }
        if (sum == G) break;
        __builtin_amdgcn_s_sleep(1);
        if ((++sp & 255u) == 0u) { if (xb_ld(&bar[XB_TMO])) break; if (sp > XB_SPIN_CAP) { atomicAdd(&bar[XB_TMO], 1u); break; } }
    }
    nloc = mine > 0u ? mine : 1u; nx = cnt > 0u ? cnt : 1u;
}
DEVI void xcd_barrier(const XcdBarrier& b) {
    asm volatile("s_waitcnt vmcnt(0)" ::: "memory");
    __syncthreads();
    if (threadIdx.x == 0) {
        unsigned* bar = b.bar;
        __builtin_amdgcn_s_waitcnt(0);
        unsigned nloc = b.st[0], nx = b.st[1];
        if (nloc == 0u) { xcd_barrier_complete(bar, b.x, nloc, nx); b.st[0] = nloc; b.st[1] = nx; }
        const unsigned old = xb_add(&bar[XB_XSUB(b.x)], 1u);
        const unsigned gen = old / nloc;
        if (old + 1u == (gen + 1u) * nloc) {
            __builtin_amdgcn_fence(__ATOMIC_RELEASE, "agent");
            asm volatile("s_waitcnt vmcnt(0)" ::: "memory");
            const unsigned og = xb_add(&bar[XB_TOP], 1u);
            const unsigned tg = og / nx;
            if (og + 1u == (tg + 1u) * nx) xb_add(&bar[XB_TOPGEN], 1u);
            else XB_SPIN(xb_ld(&bar[XB_TOPGEN]) == tg, bar);
            __builtin_amdgcn_fence(__ATOMIC_ACQUIRE, "agent");
            xb_add(&bar[XB_XGEN(b.x)], 1u);
            asm volatile("s_waitcnt vmcnt(0)" ::: "memory");
        } else {
            XB_SPIN(xb_ld(&bar[XB_XGEN(b.x)]) == gen, bar);
            __builtin_amdgcn_fence(__ATOMIC_ACQUIRE, "agent");
            asm volatile("s_waitcnt vmcnt(0)" ::: "memory");
        }
    }
    __syncthreads();
}

__global__ void __launch_bounds__(NTHREADS) mega(Params p) {
    extern __shared__ __attribute__((aligned(16))) unsigned char lds[];
    unsigned char* ws = p.ws;
    {
        volatile LAS unsigned* stw = (volatile LAS unsigned*)(lds + LDS_BYTES - 16);
        if (threadIdx.x < 4) stw[threadIdx.x] = 0u;
    }
    __syncthreads();
    XcdBarrier gbar = xcd_barrier_post((unsigned*)(ws + OFF_BAR), (volatile LAS unsigned*)(lds + LDS_BYTES - 16));
    const int tid = threadIdx.x, lane = tid & 63, w = tid >> 6;
    const int nb = gridDim.x, bid = blockIdx.x;
#define MOD ((float*)(p.ws + OFF_MOD))
#define HX ((bf16_t*)((unsigned char*)p.out + DO_HX))
#define HC ((bf16_t*)((unsigned char*)p.out + DO_HC))
#define PROJ1 ((bf16_t*)(p.ws + OFF_PROJ1))
#define PROJC ((bf16_t*)(p.ws + OFF_PROJC))
#define CKV ((bf16_t*)(p.ws + OFF_CKV))
#define AB ((float*)(p.ws + OFF_AB))
#define ABC ((float*)(p.ws + OFF_ABC))
#define S5ST ((float*)(p.ws + OFF_S5ST))
#define DNST ((float*)(p.ws + OFF_DNST))
#define YF ((bf16_t*)(p.ws + OFF_YF))
#define YB ((bf16_t*)(p.ws + OFF_YB))
#define OF ((bf16_t*)(p.ws + OFF_OF))
#define OB ((bf16_t*)(p.ws + OFF_OB))
#define WIN1 ((const bf16_t*)(p.ws + OFF_WIN1))
#define WIN2 ((const bf16_t*)(p.ws + OFF_WIN2))
#ifndef PROBE_PHASE
#define PROBE_PHASE -1
#endif
#define NREP(k) ((k) == PROBE_PHASE ? 2 : 1)
#define IN(k) (p.ph_lo <= (k) && (k) < p.ph_hi)
#define SEAM(k) do { if (rep_ + 1 == NREP(k) && (k) + 1 < p.ph_hi) xcd_barrier(gbar); } while (0)

    if (IN(0)) for (int rep_ = 0; rep_ < NREP(0); ++rep_) {
        phase_adaln(p, MOD, lds);
        __syncthreads();
        phase_weights(p, lds);
        SEAM(0);
    }
    if (IN(1)) for (int rep_ = 0; rep_ < NREP(1); ++rep_) {
        modulate_rows<16>(p.in[0], NT, TL, p.in[6], MOD, MOD + 1024, 6144, HX);
        modulate_rows<2>(p.in[2], NC, TCX, p.in[6], MOD + 16 * 6144, MOD + 16 * 6144 + 1024, 0, HC);
        SEAM(1);
    }
    if (IN(2)) for (int rep_ = 0; rep_ < NREP(2); ++rep_) {
        {
            pg8::Gemm g{HX, WIN1, NT, 3584, 1024}; pg8::StaticOrder S; S.init(NT, 3584, nb, bid); pg8::EpiStore16 E{PROJ1, LD1};
            pg8::gemm_phase<pg8::EpiStore16, pg8::StaticOrder, true, true>((PG8_LAS unsigned char*)lds, g, S, E);
        }
        const int nctxb = nb >= 256 ? 160 : nb;
        if (bid < nctxb) {
            pg8::Gemm g{HC, WIN1, NC, 2560, 1024}; pg8::StaticOrder S; S.init(NC, 2560, nctxb, bid); pg8::EpiStore16 E{PROJC, LDC};
            pg8::gemm_phase<pg8::EpiStore16, pg8::StaticOrder, true, true>((PG8_LAS unsigned char*)lds, g, S, E);
        }
        __syncthreads();
        {
            const int nab = nb - nctxb;
            const int t0 = nab > 0 ? (bid >= nctxb ? bid - nctxb : 256 + 32) : bid;
            const int stride = nab > 0 ? nab : nb;
            for (int t = t0; t < 256 + 32; t += stride) {
                if (t < 256) gemm_tile(HX, 1024, WIN1, 1024, 1024, t * 128, 3584, lds, [=](int row, int col, float v) { if (col < 3584 + 32) AB[(size_t)row * 32 + (col - 3584)] = v; });
                else gemm_tile(HC, 1024, WIN1, 1024, 1024, (t - 256) * 128, 3584, lds, [=](int row, int col, float v) { if (col < 3584 + 32) ABC[(size_t)row * 32 + (col - 3584)] = v; });
            }
        }
        SEAM(2);
    }
    if (IN(3)) for (int rep_ = 0; rep_ < NREP(3); ++rep_) {
        if (w < 2) {
            for (int u = w * nb + bid; u < 512; u += nb * 2) {
                const int dir = u & 1, g = (u >> 1) & 31, bp = u >> 6;
                s5_mfma<false>(p, PROJC, LDC, TCX, bp, g, dir, nullptr, S5ST, nullptr, lds + w * 19456);
                s5_mfma<true>(p, PROJ1, LD1, TL, bp, g, dir, S5ST, nullptr, dir ? YB : YF, lds + w * 19456);
            }
        } else {
            const float* cw = p.in[21];
            const int nlat = NB * 32 * 3 * 8, nctx = NB * 4 * 2 * 8;
            for (int it = (w - 2) * nb + bid; it < nlat + nctx; it += nb * 6) {
                if (it < nlat) {
                    const int head = it & 7, type = (it >> 3) % 3, br = it / 24;
                    const int scol = (type == 0 ? 512 : (type == 1 ? 1536 : 2560)) + head * 128;
                    if (type == 1) conv_wave<false>(PROJ1, LD1, br * 64, false, false, scol, PROJ1, LD1, scol, cw, type * 1024 + head * 128, 1.f);
                    else conv_wave<true>(PROJ1, LD1, br * 64, false, false, scol, PROJ1, LD1, scol, cw, type * 1024 + head * 128, type == 2 ? 0.08838834764831845f : 1.f);
                } else {
                    const int i2 = it - nlat;
                    const int head = i2 & 7, type = (i2 >> 3) & 1, bt = i2 >> 4;
                    const int tt = bt & 3;
                    const int scol = (type == 0 ? 512 : 1536) + head * 128;
                    if (type == 1) conv_wave<false>(PROJC, LDC, bt * 64, tt > 0, tt < 3, scol, CKV, 2048, type * 1024 + head * 128, cw, type * 1024 + head * 128, 1.f);
                    else conv_wave<true>(PROJC, LDC, bt * 64, tt > 0, tt < 3, scol, CKV, 2048, type * 1024 + head * 128, cw, type * 1024 + head * 128, 1.f);
                }
            }
        }
        SEAM(3);
    }
    if (IN(5)) for (int rep_ = 0; rep_ < NREP(5); ++rep_) {
        for (int u = bid; u < 256; u += nb) {
            const int dir = u & 1, head = (u >> 1) & 7, b = u >> 4;
            dn_chunked<false>(p, CKV + head * 128, CKV + 1024 + head * 128, nullptr, 2048, ABC, b * TCX, TCX, head, dir, nullptr,
                   DNST + (size_t)u * 128 * 128, nullptr, lds);
        }
        __syncthreads();
        for (int u = bid; u < 256; u += nb) {
            const int dir = u & 1, head = (u >> 1) & 7, b = u >> 4;
            dn_chunked<true>(p, PROJ1 + 512 + head * 128, PROJ1 + 1536 + head * 128, PROJ1 + 2560 + head * 128, LD1, AB, b * TL, TL, head, dir,
                   DNST + (size_t)u * 128 * 128, nullptr, dir ? OB : OF, lds);
        }
        convert_table_fp8_sliced(p.in[30], (unsigned char*)p.out + DO_HC, PEER_USCALE, bid * NTHREADS + tid, nb * NTHREADS);
        convert_table_fp8_sliced(p.in[31], (unsigned char*)p.out + DO_HC + (size_t)16384 * 1024, PEER_VSCALE, bid * NTHREADS + tid, nb * NTHREADS);
        SEAM(5);
    }
#define PROJ2 ((bf16_t*)(p.ws + OFF_PROJ2))
#define Y5 ((bf16_t*)(p.ws + OFF_Y5))
    if (IN(6)) for (int rep_ = 0; rep_ < NREP(6); ++rep_) {
        {
            pg8::Gemm g{HX, WIN2, NT, 3072, 1024}; pg8::StaticOrder S; S.init(NT, 3072, nb, bid); pg8::EpiStore16 E{PROJ2, LD2};
            pg8::gemm_phase<pg8::EpiStore16, pg8::StaticOrder, true, true>((PG8_LAS unsigned char*)lds, g, S, E);
        }
        for (size_t i = (size_t)bid * NTHREADS + tid; i < (size_t)NT * 512 / 2; i += (size_t)nb * NTHREADS) {
            const unsigned a = ((const unsigned*)YF)[i], b2 = ((const unsigned*)YB)[i];
            const float y0 = __uint_as_float(a << 16) + __uint_as_float(b2 << 16);
            const float y1 = __uint_as_float(a & 0xffff0000u) + __uint_as_float(b2 & 0xffff0000u);
            ((unsigned*)Y5)[i] = pack2(gelu_(y0), gelu_(y1));
        }
        SEAM(6);
    }
#define Y5G ((bf16_t*)(p.ws + OFF_Y5G))
#define YDN ((bf16_t*)(p.ws + OFF_YDN))
    if (IN(7)) for (int rep_ = 0; rep_ < NREP(7); ++rep_) {
#define GLUW ((const bf16_t*)(p.ws + OFF_GLU))
        const float* glub = p.in[20];
        {
            pg8::Gemm g{Y5, GLUW, NT, 512, 512}; pg8::StaticOrder S; S.init(NT, 512, nb, bid); pg8::EpiGate<0> E{Y5G, 512, Y5, 512, 0, glub};
            pg8::gemm_phase<pg8::EpiGate<0>, pg8::StaticOrder, true, true>((PG8_LAS unsigned char*)lds, g, S, E);
        }
        const float* dnw = p.in[24];
        for (int tok = bid * 8 + w; tok < NT; tok += nb * 8) {
#pragma unroll
            for (int i = 0; i < 2; ++i) {
                const int col = i * 512 + lane * 8;
                const uint4 a = *(const uint4*)(OF + (size_t)tok * 1024 + col);
                const uint4 b2 = *(const uint4*)(OB + (size_t)tok * 1024 + col);
                const uint4 zz = *(const uint4*)(PROJ2 + (size_t)tok * LD2 + col);
                float o[8], z[8];
                o[0] = __uint_as_float(a.x << 16) + __uint_as_float(b2.x << 16); o[1] = __uint_as_float(a.x & 0xffff0000u) + __uint_as_float(b2.x & 0xffff0000u);
                o[2] = __uint_as_float(a.y << 16) + __uint_as_float(b2.y << 16); o[3] = __uint_as_float(a.y & 0xffff0000u) + __uint_as_float(b2.y & 0xffff0000u);
                o[4] = __uint_as_float(a.z << 16) + __uint_as_float(b2.z << 16); o[5] = __uint_as_float(a.z & 0xffff0000u) + __uint_as_float(b2.z & 0xffff0000u);
                o[6] = __uint_as_float(a.w << 16) + __uint_as_float(b2.w << 16); o[7] = __uint_as_float(a.w & 0xffff0000u) + __uint_as_float(b2.w & 0xffff0000u);
                z[0] = __uint_as_float(zz.x << 16); z[1] = __uint_as_float(zz.x & 0xffff0000u);
                z[2] = __uint_as_float(zz.y << 16); z[3] = __uint_as_float(zz.y & 0xffff0000u);
                z[4] = __uint_as_float(zz.z << 16); z[5] = __uint_as_float(zz.z & 0xffff0000u);
                z[6] = __uint_as_float(zz.w << 16); z[7] = __uint_as_float(zz.w & 0xffff0000u);
                float ss = 0.f;
#pragma unroll
                for (int c = 0; c < 8; ++c) ss += o[c] * o[c];
                ss += __shfl_xor(ss, 1); ss += __shfl_xor(ss, 2); ss += __shfl_xor(ss, 4); ss += __shfl_xor(ss, 8);
                const float r = rsqrtf(ss * (1.f / 128.f) + 1e-6f);
                float y[8];
#pragma unroll
                for (int c = 0; c < 8; ++c) y[c] = o[c] * r * dnw[(lane & 15) * 8 + c] * silu_(z[c]);
                uint4 ov;
                ov.x = pack2(y[0], y[1]); ov.y = pack2(y[2], y[3]); ov.z = pack2(y[4], y[5]); ov.w = pack2(y[6], y[7]);
                *(uint4*)(YDN + (size_t)tok * 1024 + col) = ov;
            }
        }
        SEAM(7);
    }
#define MERGED ((bf16_t*)(p.ws + OFF_MERGED))
    if (IN(8)) for (int rep_ = 0; rep_ < NREP(8); ++rep_) {
#define WB5 ((const bf16_t*)(p.ws + OFF_WB5))
#define WBDN ((const bf16_t*)(p.ws + OFF_WBDN))
        {
            pg8::Gemm g{Y5G, WB5, NT, 1024, 512}; pg8::StaticOrder S; S.init(NT, 1024, nb, bid); pg8::EpiGate<1> E{MERGED, 1024, PROJ2, LD2, 1024, nullptr};
            pg8::gemm_phase<pg8::EpiGate<1>, pg8::StaticOrder, true, true>((PG8_LAS unsigned char*)lds, g, S, E);
        }
        {
            pg8::Gemm g{YDN, WBDN, NT, 1024, 1024}; pg8::StaticOrder S; S.init(NT, 1024, nb, bid); pg8::EpiGate<2> E{MERGED, 1024, PROJ2, LD2, 2048, nullptr};
            pg8::gemm_phase<pg8::EpiGate<2>, pg8::StaticOrder, true, true>((PG8_LAS unsigned char*)lds, g, S, E);
        }
        SEAM(8);
    }
    bf16_t* XMIX = (bf16_t*)p.out;
    if (IN(9)) for (int rep_ = 0; rep_ < NREP(9); ++rep_) {
#define WOUT ((const bf16_t*)(p.ws + OFF_WOUT))
        {
            pg8::Gemm g{MERGED, WOUT, NT, 1024, 1024}; pg8::StaticOrder S; S.init(NT, 1024, nb, bid); pg8::EpiStore16 E{XMIX, 1024};
            pg8::gemm_phase<pg8::EpiStore16, pg8::StaticOrder, true, true>((PG8_LAS unsigned char*)lds, g, S, E);
        }
        SEAM(9);
    }
#define X1 ((bf16_t*)(p.ws + OFF_X1))
#define HX2 ((bf16_t*)(p.ws + OFF_HX2))
    if (IN(10)) for (int rep_ = 0; rep_ < NREP(10); ++rep_) {
        const float* x = p.in[0];
        const float* npm = p.in[7];
        const float* npf = p.in[8];
        for (int run = bid * 8 + w; run < NT / 16; run += nb * 8) {
            const int row0 = run * 16;
            const float* mb = MOD + (size_t)(row0 / TL) * 6144;
            float4 c1[4], c2[4], c3[4];
#pragma unroll
            for (int i = 0; i < 4; ++i) {
                const int d = lane * 4 + 256 * i;
                const float4 g = *(const float4*)(mb + 2 * 1024 + d), nw = *(const float4*)(npm + d);
                const float4 gn = *(const float4*)(npf + d), scl = *(const float4*)(mb + 4 * 1024 + d);
                c1[i] = make_float4(g.x * nw.x, g.y * nw.y, g.z * nw.z, g.w * nw.w);
                c2[i] = make_float4(gn.x * (1.f + scl.x), gn.y * (1.f + scl.y), gn.z * (1.f + scl.z), gn.w * (1.f + scl.w));
                c3[i] = *(const float4*)(mb + 3 * 1024 + d);
            }
            uint2 nm[4]; float4 nx[4];
#pragma unroll
            for (int i = 0; i < 4; ++i) {
                nm[i] = *(const uint2*)(XMIX + (size_t)row0 * 1024 + lane * 4 + 256 * i);
                nx[i] = *(const float4*)(x + (size_t)row0 * 1024 + lane * 4 + 256 * i);
            }
#pragma unroll 1
            for (int rr = 0; rr < 16; ++rr) {
                const int row = row0 + rr;
                float4 xm[4], xv[4];
                float ss = 0.f;
#pragma unroll
                for (int i = 0; i < 4; ++i) {
                    xm[i] = make_float4(__uint_as_float(nm[i].x << 16), __uint_as_float(nm[i].x & 0xffff0000u), __uint_as_float(nm[i].y << 16), __uint_as_float(nm[i].y & 0xffff0000u));
                    xv[i] = nx[i];
                    ss += xm[i].x * xm[i].x + xm[i].y * xm[i].y + xm[i].z * xm[i].z + xm[i].w * xm[i].w;
                }
                if (rr + 1 < 16) {
#pragma unroll
                    for (int i = 0; i < 4; ++i) {
                        nm[i] = *(const uint2*)(XMIX + (size_t)(row + 1) * 1024 + lane * 4 + 256 * i);
                        nx[i] = *(const float4*)(x + (size_t)(row + 1) * 1024 + lane * 4 + 256 * i);
                    }
                }
                ss = wave_sum_u(ss);
                const float r = rsqrtf(ss * (1.f / 1024.f) + 1e-6f);
                float4 x1[4];
                float s2 = 0.f;
#pragma unroll
                for (int i = 0; i < 4; ++i) {
                    const int d = lane * 4 + 256 * i;
                    x1[i].x = xv[i].x + c1[i].x * xm[i].x * r;
                    x1[i].y = xv[i].y + c1[i].y * xm[i].y * r;
                    x1[i].z = xv[i].z + c1[i].z * xm[i].z * r;
                    x1[i].w = xv[i].w + c1[i].w * xm[i].w * r;
                    s2 += x1[i].x * x1[i].x + x1[i].y * x1[i].y + x1[i].z * x1[i].z + x1[i].w * x1[i].w;
                    { uint2 t_; t_.x = pack2(x1[i].x, x1[i].y); t_.y = pack2(x1[i].z, x1[i].w); *(uint2*)(X1 + (size_t)row * 1024 + d) = t_; }
                }
                s2 = wave_sum_u(s2);
                const float r2 = rsqrtf(s2 * (1.f / 1024.f) + 1e-6f);
#pragma unroll
                for (int i = 0; i < 4; ++i) {
                    const int d = lane * 4 + 256 * i;
                    uint2 o;
                    o.x = pack2(x1[i].x * r2 * c2[i].x + c3[i].x, x1[i].y * r2 * c2[i].y + c3[i].y);
                    o.y = pack2(x1[i].z * r2 * c2[i].z + c3[i].z, x1[i].w * r2 * c2[i].w + c3[i].w);
                    *(uint2*)(HX2 + (size_t)row * 1024 + d) = o;
                }
            }
        }
        SEAM(10);
    }
#define QP ((bf16_t*)(p.ws + OFF_QP))
    if (IN(11)) for (int rep_ = 0; rep_ < NREP(11); ++rep_) {
#define WQ ((const bf16_t*)(p.ws + OFF_WQ))
        {
            pg8::Gemm g{HX2, WQ, NT, 2048, 1024}; pg8::StaticOrder S; S.init(NT, 2048, nb, bid); pg8::EpiStore16 E{QP, 2048};
            pg8::gemm_phase<pg8::EpiStore16, pg8::StaticOrder, true, true>((PG8_LAS unsigned char*)lds, g, S, E);
        }
        SEAM(11);
    }
#define IDX ((int*)(p.ws + OFF_IDX))
#define GATE ((float*)(p.ws + OFF_GATE))
    if (IN(12)) for (int rep_ = 0; rep_ < NREP(12); ++rep_) {
        phase_topk(p, QP, IDX, GATE, lds);
        SEAM(12);
    }
#define PART ((float*)(p.ws + OFF_QP))
#define pctr ((unsigned*)(p.ws + OFF_BAR))
    if (IN(13)) for (int rep_ = 0; rep_ < NREP(13); ++rep_) {
        phase_peer_u(HX2, IDX, PART, (unsigned char*)p.out + DO_HC, pctr, lds);
        SEAM(13);
    }
    if (IN(14)) for (int rep_ = 0; rep_ < NREP(14); ++rep_) {
        phase_peer_w(PART, GATE);
        SEAM(14);
    }
    if (IN(15)) for (int rep_ = 0; rep_ < NREP(15); ++rep_) {
        phase_peer_v(IDX, GATE, (bf16_t*)(ws + OFF_QP), (unsigned char*)p.out + DO_HC + (size_t)16384 * 1024, pctr + 8, lds);
        SEAM(15);
    }
    if (IN(16)) for (int rep_ = 0; rep_ < NREP(16); ++rep_) {
        phase_peer_final(p, X1, (const bf16_t*)(ws + OFF_QP), MOD, p.out);
    }
}

constexpr int NPHASES = 17;

extern "C" void kernel_launch(void* const* d_in, const int* in_sizes, int n_in, void* d_out, int out_size, void* d_ws, size_t ws_size,
                              hipStream_t stream) {
    static int grid_blocks = 0;
    if (grid_blocks == 0) {
        if (n_in != 32 || ws_size < WS_END || out_size != NT * DM) {
            fprintf(stderr, "kernel_launch: unexpected sizes n_in=%d ws=%zu (need %zu) out=%d\n", n_in, ws_size, (size_t)WS_END, out_size);
            grid_blocks = -1;
            return;
        }
        int dev = 0, cus = 0, per_cu = 0;
        hipGetDevice(&dev);
        hipDeviceGetAttribute(&cus, hipDeviceAttributeMultiprocessorCount, dev);
        hipFuncSetAttribute((const void*)mega, hipFuncAttributeMaxDynamicSharedMemorySize, LDS_BYTES);
        hipOccupancyMaxActiveBlocksPerMultiprocessor(&per_cu, (const void*)mega, NTHREADS, LDS_BYTES);
        if (per_cu < 1) { fprintf(stderr, "kernel_launch: occupancy query says %d blocks/CU\n", per_cu); per_cu = 1; }
        grid_blocks = cus;
        fprintf(stderr, "kernel_launch: cus=%d per_cu=%d grid=%d ws=%zu need=%zu\n", cus, per_cu, grid_blocks, ws_size, (size_t)WS_END);
    }
    if (grid_blocks < 0) return;
    Params p{};
    for (int i = 0; i < 32; ++i) p.in[i] = (const float*)d_in[i];
    p.out = (float*)d_out;
    p.ws = (unsigned char*)d_ws;
    p.ph_lo = 0; p.ph_hi = NPHASES;
    void* args[] = {&p};
    if (hipMemsetAsync((unsigned char*)d_ws + OFF_BAR, 0, (size_t)XCD_BAR_WORDS * 4, stream) != hipSuccess) { fprintf(stderr, "kernel_launch: memset of barrier words failed\n"); return; }
    hipError_t e = hipLaunchCooperativeKernel((const void*)mega, dim3(grid_blocks), dim3(NTHREADS), args, LDS_BYTES, stream);
    if (e != hipSuccess) fprintf(stderr, "cooperative launch failed: %s (grid %d)\n", hipGetErrorString(e), grid_blocks);
#if defined(PROBE_EXTRA_PHASE)
    {
        Params q = p; q.ph_lo = PROBE_EXTRA_PHASE; q.ph_hi = PROBE_EXTRA_PHASE + 1;
        void* args2[] = {&q};
        hipLaunchCooperativeKernel((const void*)mega, dim3(grid_blocks), dim3(NTHREADS), args2, LDS_BYTES, stream);
    }
#endif
}
```
